# Optimizing an MI355X kernel written in HIP

```python
import math
import jax, jax.numpy as jnp
from jax import lax
import numpy as np

D_MODEL = 1024
BATCH = 4
SEQ = 8192
DEPTH = 1

D_SSM = D_MODEL // 2
D_CONV = D_MODEL - D_SSM
SSM_GROUP = 16
N_SSM_GROUPS = D_SSM // SSM_GROUP
SSM_STATE = 64
CONV_WIDTH = 31
D_IN = D_SSM + 2 * D_CONV
N_EXPERTS = 32
TOP_K = 4
D_FF = D_MODEL
SWIGLU_ALPHA = 1.702
SWIGLU_LIMIT = 7.0
ROW_BLOCK = 128
DT_MIN = 1e-3
DT_MAX = 1e-1
RMS_EPS = 1e-6
LN_EPS = 1e-5

kernel_name = "hybrid_s5_conformer_moe_adaln"


def rmsnorm(x, g, eps=RMS_EPS):
    xf = x.astype(jnp.float32)
    y = xf * lax.rsqrt(jnp.mean(xf * xf, axis=-1, keepdims=True) + eps)
    return (y * g.astype(jnp.float32)).astype(x.dtype)


def layernorm(x, g, b, eps=LN_EPS):
    xf = x.astype(jnp.float32)
    mu = jnp.mean(xf, axis=-1, keepdims=True)
    xc = xf - mu
    y = xc * lax.rsqrt(jnp.mean(xc * xc, axis=-1, keepdims=True) + eps)
    return (y * g.astype(jnp.float32) + b.astype(jnp.float32)).astype(x.dtype)


def s5_mixer(u, lam_re, lam_im, log_dt, b_re, b_im, c_re, c_im, d_skip, w_glu, b_glu):
    bsz, seq, _ = u.shape
    dtype = u.dtype
    f32 = jnp.float32
    ug = u.astype(f32).reshape(bsz, seq, N_SSM_GROUPS, SSM_GROUP)
    lr = lam_re.astype(f32)
    li = lam_im.astype(f32)
    dt = jnp.exp(log_dt.astype(f32))[:, None]
    mag = jnp.exp(lr * dt)
    ab_re = mag * jnp.cos(li * dt)
    ab_im = mag * jnp.sin(li * dt)
    den = lr * lr + li * li
    nr = ab_re - 1.0
    q_re = (nr * lr + ab_im * li) / den
    q_im = (ab_im * lr - nr * li) / den
    br = b_re.astype(f32)
    bi = b_im.astype(f32)
    bb_re = q_re[..., None] * br - q_im[..., None] * bi
    bb_im = q_re[..., None] * bi + q_im[..., None] * br
    bu_re = jnp.einsum('blgh,gph->blgp', ug, bb_re)
    bu_im = jnp.einsum('blgh,gph->blgp', ug, bb_im)
    a_re = jnp.broadcast_to(ab_re, bu_re.shape)
    a_im = jnp.broadcast_to(ab_im, bu_im.shape)

    def combine(e1, e2):
        a1r, a1i, b1r, b1i = e1
        a2r, a2i, b2r, b2i = e2
        return (a1r * a2r - a1i * a2i,
                a1r * a2i + a1i * a2r,
                a2r * b1r - a2i * b1i + b2r,
                a2r * b1i + a2i * b1r + b2i)

    _, _, xr, xi = lax.associative_scan(combine, (a_re, a_im, bu_re, bu_im), axis=1)
    y = (jnp.einsum('blgp,ghp->blgh', xr, c_re.astype(f32))
         - jnp.einsum('blgp,ghp->blgh', xi, c_im.astype(f32)))
    y = y + d_skip.astype(f32).reshape(N_SSM_GROUPS, SSM_GROUP) * ug
    y = jax.nn.gelu(y.reshape(bsz, seq, D_SSM)).astype(dtype)
    return y * jax.nn.sigmoid(y @ w_glu + b_glu)


def conformer_conv(v, g, conv_w, conv_b, ln_g, ln_b):
    z = v * jax.nn.sigmoid(g)
    kern = conv_w[:, None, :].astype(z.dtype)
    z = lax.conv_general_dilated(z, kern, window_strides=(1,),
                                 padding=[(CONV_WIDTH - 1, 0)],
                                 dimension_numbers=('NWC', 'WIO', 'NWC'),
                                 feature_group_count=D_CONV) + conv_b
    return jax.nn.silu(layernorm(z, ln_g, ln_b))


def moe_ffn(h, router_w, router_b, w_gate, b_gate, w_up, b_up, w_down, b_down):
    bsz, seq, d = h.shape
    n_tok = bsz * seq
    hf = h.reshape(n_tok, d)
    logits = (hf @ router_w + router_b).astype(jnp.float32)
    top_val, top_idx = lax.top_k(logits, TOP_K)
    top_w = jax.nn.softmax(top_val, axis=-1).astype(h.dtype)
    n_assign = n_tok * TOP_K
    n_blocks = -(-n_assign // ROW_BLOCK) + N_EXPERTS
    n_rows = n_blocks * ROW_BLOCK
    flat_e = top_idx.reshape(-1)
    flat_tok = jnp.repeat(jnp.arange(n_tok, dtype=jnp.int32), TOP_K)
    flat_w = top_w.reshape(-1)
    order = jnp.argsort(flat_e)
    se = flat_e[order]
    counts = jnp.bincount(flat_e, length=N_EXPERTS)
    padded = (counts + ROW_BLOCK - 1) // ROW_BLOCK * ROW_BLOCK
    start = jnp.cumsum(counts) - counts
    pend = jnp.cumsum(padded)
    pstart = pend - padded
    dest = pstart[se] + (jnp.arange(n_assign, dtype=jnp.int32) - start[se])
    row_tok = jnp.full((n_rows,), n_tok, jnp.int32).at[dest].set(flat_tok[order])
    row_w = jnp.zeros((n_rows,), h.dtype).at[dest].set(flat_w[order])
    block_e = jnp.minimum(
        jnp.searchsorted(pend, jnp.arange(n_blocks, dtype=jnp.int32) * ROW_BLOCK, side='right'),
        N_EXPERTS - 1)
    h_pad = jnp.concatenate([hf, jnp.zeros((1, d), hf.dtype)], axis=0)
    xs = h_pad[row_tok].reshape(n_blocks, ROW_BLOCK, d)

    def expert_block(args):
        xb, e = args
        gate = jnp.minimum(xb @ w_gate[e] + b_gate[e], SWIGLU_LIMIT)
        up = jnp.clip(xb @ w_up[e] + b_up[e], -SWIGLU_LIMIT, SWIGLU_LIMIT)
        glu = gate * jax.nn.sigmoid(SWIGLU_ALPHA * gate)
        return ((up + 1.0) * glu) @ w_down[e] + b_down[e]

    ys = lax.map(expert_block, (xs, block_e)).reshape(n_rows, d)
    out = jax.ops.segment_sum(ys * row_w[:, None], row_tok, num_segments=n_tok + 1)[:n_tok]
    return out.reshape(bsz, seq, d)


def setup_inputs(seed: int = 0) -> dict:
    key = jax.random.key(seed)
    ks = jax.random.split(key, 32)
    f32 = jnp.float32

    def nrm(k, shape, scale):
        return jax.random.normal(k, shape, f32) * scale

    L, D, G, P, H = DEPTH, D_MODEL, N_SSM_GROUPS, SSM_STATE, SSM_GROUP
    E, F = N_EXPERTS, D_FF
    lam_im_base = jnp.broadcast_to(math.pi * jnp.arange(P, dtype=f32), (L, G, P))
    return {
        "x": nrm(ks[0], (BATCH, SEQ, D), 1.0),
        "c": nrm(ks[1], (BATCH, D), 1.0),
        "ada_w": nrm(ks[2], (L, D, 6 * D), 0.5 * D ** -0.5),
        "ada_b": nrm(ks[3], (L, 6 * D), 0.01),
        "norm1_g": 1.0 + nrm(ks[4], (L, D), 0.02),
        "w_in": nrm(ks[5], (L, D, D_IN), D ** -0.5),
        "lam_re": -0.5 + nrm(ks[6], (L, G, P), 0.01),
        "lam_im": lam_im_base + nrm(ks[7], (L, G, P), 0.01),
        "log_dt": jax.random.uniform(ks[8], (L, G), f32, math.log(DT_MIN), math.log(DT_MAX)),
        "b_re": nrm(ks[9], (L, G, P, H), (2 * H) ** -0.5),
        "b_im": nrm(ks[10], (L, G, P, H), (2 * H) ** -0.5),
        "c_re": nrm(ks[11], (L, G, H, P), (2 * P) ** -0.5),
        "c_im": nrm(ks[12], (L, G, H, P), (2 * P) ** -0.5),
        "d_skip": nrm(ks[13], (L, D_SSM), 1.0),
        "w_glu": nrm(ks[14], (L, D_SSM, D_SSM), D_SSM ** -0.5),
        "b_glu": nrm(ks[15], (L, D_SSM), 0.01),
        "conv_w": nrm(ks[16], (L, CONV_WIDTH, D_CONV), CONV_WIDTH ** -0.5),
        "conv_b": nrm(ks[17], (L, D_CONV), 0.01),
        "ln_g": 1.0 + nrm(ks[18], (L, D_CONV), 0.02),
        "ln_b": nrm(ks[19], (L, D_CONV), 0.01),
        "out_norm_g": 1.0 + nrm(ks[20], (L, D), 0.02),
        "w_out": nrm(ks[21], (L, D, D), D ** -0.5),
        "norm2_g": 1.0 + nrm(ks[22], (L, D), 0.02),
        "router_w": nrm(ks[23], (L, D, E), D ** -0.5),
        "router_b": nrm(ks[24], (L, E), 0.01),
        "w_gate": nrm(ks[25], (L, E, D, F), D ** -0.5),
        "b_gate": nrm(ks[26], (L, E, F), 0.01),
        "w_up": nrm(ks[27], (L, E, D, F), D ** -0.5),
        "b_up": nrm(ks[28], (L, E, F), 0.01),
        "w_down": nrm(ks[29], (L, E, F, D), F ** -0.5),
        "b_down": nrm(ks[30], (L, E, D), 0.01),
        "final_g": 1.0 + nrm(ks[31], (D,), 0.02),
    }


def reference(x, c, ada_w, ada_b, norm1_g, w_in, lam_re, lam_im, log_dt, b_re, b_im,
              c_re, c_im, d_skip, w_glu, b_glu, conv_w, conv_b, ln_g, ln_b, out_norm_g,
              w_out, norm2_g, router_w, router_b, w_gate, b_gate, w_up, b_up, w_down,
              b_down, final_g):
    cond = jax.nn.silu(c)
    for i in range(DEPTH):
        mod = cond @ ada_w[i] + ada_b[i]
        sh1, sc1, g1, sh2, sc2, g2 = [m[:, None, :] for m in jnp.split(mod, 6, axis=-1)]
        h = rmsnorm(x, norm1_g[i]) * (1.0 + sc1) + sh1
        proj = h @ w_in[i]
        u = proj[..., :D_SSM]
        v = proj[..., D_SSM:D_SSM + D_CONV]
        gt = proj[..., D_SSM + D_CONV:]
        y_ssm = s5_mixer(u, lam_re[i], lam_im[i], log_dt[i], b_re[i], b_im[i], c_re[i],
                         c_im[i], d_skip[i], w_glu[i], b_glu[i])
        y_conv = conformer_conv(v, gt, conv_w[i], conv_b[i], ln_g[i], ln_b[i])
        merged = jnp.concatenate([rmsnorm(y_ssm, out_norm_g[i, :D_SSM]),
                                  rmsnorm(y_conv, out_norm_g[i, D_SSM:])], axis=-1)
        x = x + g1 * (merged @ w_out[i])
        h = rmsnorm(x, norm2_g[i]) * (1.0 + sc2) + sh2
        x = x + g2 * moe_ffn(h, router_w[i], router_b[i], w_gate[i], b_gate[i], w_up[i],
                             b_up[i], w_down[i], b_down[i])
    return rmsnorm(x, final_g)
```

```cpp
#include <hip/hip_runtime.h>
#include <hip/hip_cooperative_groups.h>
#include <cstdio>
#include <cstdint>
namespace cg = cooperative_groups;
#ifndef FAST_P2
#define FAST_P2 1
#endif
#ifndef FAST_P3D
#define FAST_P3D 1
#endif
#ifndef FAST_P4
#define FAST_P4 1
#endif
#ifndef FAST_S5
#define FAST_S5 1
#endif
#ifndef FAST_MOE
#define FAST_MOE 1
#endif

#define GAS __attribute__((address_space(1)))
#define LAS __attribute__((address_space(3)))
typedef unsigned short bf16;
typedef unsigned v4u __attribute__((ext_vector_type(4)));
typedef unsigned v2u __attribute__((ext_vector_type(2)));
typedef float f32x4 __attribute__((ext_vector_type(4)));
typedef float f32x2 __attribute__((ext_vector_type(2)));
typedef short bf16x8 __attribute__((ext_vector_type(8)));

constexpr int NB = 4, SEQ = 8192, D = 1024, NTOK = NB * SEQ;
constexpr int DSSM = 512, DCONV = 512, NG = 32, GH = 16, NP = 64, DIN = 1536, CW = 31;
constexpr int NE = 32, TOPK = 4, FF = 1024;
constexpr int TCH = 32, NCH = SEQ / TCH, NROW2 = NB * NCH, U2G = 640, U2LD = NG * U2G;
constexpr int NWAVES = 8, NTHR = 512;
constexpr int LDS_BYTES = 147456;
constexpr int CAP = NTOK;

enum { I_X = 0, I_C, I_ADAW, I_ADAB, I_N1G, I_WIN, I_LRE, I_LIM, I_LDT, I_BRE, I_BIM, I_CRE, I_CIM, I_DSK, I_WGLU, I_BGLU, I_CONVW, I_CONVB, I_LNG, I_LNB,
       I_ONG, I_WOUT, I_N2G, I_RW, I_RB, I_WG, I_BG, I_WU, I_BU, I_WD, I_BD, I_FG };

constexpr size_t MiB = 1u << 20;
constexpr size_t WS_WIN = 0 * MiB;
constexpr size_t WS_WGLU = 3 * MiB;
constexpr size_t WS_WOUT = 4 * MiB;
constexpr size_t WS_BTS = 6 * MiB;
constexpr size_t WS_BTY = 14 * MiB;
constexpr size_t WS_H2 = 0 * MiB;
constexpr size_t WS_YS3 = 0 * MiB;
constexpr size_t WS_CTL = 64 * MiB;
constexpr size_t WS_MOD = 64 * MiB + 65536;
constexpr size_t WS_TOPW = 65 * MiB;
constexpr size_t WS_TOKK = 66 * MiB;
constexpr size_t WS_ACT = 72 * MiB;
constexpr size_t WS_H1 = 72 * MiB;
constexpr size_t WS_U2 = 136 * MiB;
constexpr size_t WS_Z = 176 * MiB;
constexpr size_t WS_SLOC = 208 * MiB;
constexpr size_t WS_YG = 224 * MiB;
constexpr size_t WS_MRG = 256 * MiB;
constexpr size_t WS_WD = 328 * MiB;
constexpr size_t WS_WGU = 392 * MiB;
constexpr size_t WS_YS12 = 392 * MiB;
constexpr size_t WS_END = 520 * MiB;
constexpr int CW_CNT = 0;

struct Args { const float* in[32]; float* out; unsigned char* ws; int ph_lo, ph_hi; };

__device__ __forceinline__ float bf2f(unsigned v) { return __builtin_bit_cast(float, v << 16); }
__device__ __forceinline__ unsigned f2bf(float f) { unsigned u = __builtin_bit_cast(unsigned, f); return (u + 0x7fffu + ((u >> 16) & 1u)) >> 16; }
__device__ __forceinline__ unsigned pk2(float lo, float hi) { return f2bf(lo) | (f2bf(hi) << 16); }
__device__ __forceinline__ float bflo(unsigned w) { return __builtin_bit_cast(float, w << 16); }
__device__ __forceinline__ float bfhi(unsigned w) { return __builtin_bit_cast(float, w & 0xffff0000u); }
__device__ __forceinline__ float sigmoidf_(float x) { return 1.0f / (1.0f + __expf(-x)); }
__device__ __forceinline__ float siluf_(float x) { return x * sigmoidf_(x); }
__device__ __forceinline__ float gelu_tanh(float x) { const float u = 0.7978845608028654f * (x + 0.044715f * x * x * x); return x * sigmoidf_(2.0f * u); }
__device__ __forceinline__ float wave_sum(float v) {
#pragma unroll
    for (int o = 1; o < 64; o <<= 1) v += __shfl_xor(v, o);
    return v;
}
#define LDS_WAIT() asm volatile("s_waitcnt lgkmcnt(0)" ::: "memory")

template <class FA, class FB>
__device__ __forceinline__ void slow_tile(LAS float* sm, int K, const FA& fa, const FB& fb, float (&acc)[2][4]) {
    const int t = threadIdx.x, ty = t >> 4, tx = t & 15;
    LAS float* As = sm; LAS float* Bs = sm + 16 * 65;
#pragma unroll
    for (int i = 0; i < 2; ++i)
#pragma unroll
        for (int j = 0; j < 4; ++j) acc[i][j] = 0.f;
    for (int k0 = 0; k0 < K; k0 += 16) {
#pragma unroll
        for (int i = 0; i < 2; ++i) { const int r = (t >> 4) + 32 * i, kk = t & 15; As[kk * 65 + r] = fa(r, k0 + kk); }
#pragma unroll
        for (int i = 0; i < 2; ++i) { const int idx = t + 512 * i, kk = idx >> 6, c = idx & 63; Bs[kk * 65 + c] = fb(k0 + kk, c); }
        __syncthreads();
#pragma unroll
        for (int kk = 0; kk < 16; ++kk) {
            const float a0 = As[kk * 65 + 2 * ty], a1 = As[kk * 65 + 2 * ty + 1];
#pragma unroll
            for (int j = 0; j < 4; ++j) { const float bv = Bs[kk * 65 + 4 * tx + j]; acc[0][j] += a0 * bv; acc[1][j] += a1 * bv; }
        }
        __syncthreads();
    }
}

__device__ __forceinline__ void p0_mod(const Args& a, LAS float* sm) {
    const float* c = a.in[I_C]; const float* W = a.in[I_ADAW]; const float* bias = a.in[I_ADAB];
    float* mod = (float*)(a.ws + WS_MOD);
    const int t = threadIdx.x, cl = t & 31, kq = t >> 5;
    for (int item = blockIdx.x; item < 192; item += gridDim.x) {
        const int col = item * 32 + cl;
        float a0 = 0.f, a1 = 0.f, a2 = 0.f, a3 = 0.f;
        for (int k = kq; k < D; k += 16) {
            const float w = W[(size_t)k * (6 * D) + col];
            a0 += siluf_(c[k]) * w; a1 += siluf_(c[D + k]) * w; a2 += siluf_(c[2 * D + k]) * w; a3 += siluf_(c[3 * D + k]) * w;
        }
        sm[(kq * 32 + cl) * 4 + 0] = a0; sm[(kq * 32 + cl) * 4 + 1] = a1; sm[(kq * 32 + cl) * 4 + 2] = a2; sm[(kq * 32 + cl) * 4 + 3] = a3;
        __syncthreads();
        if (t < 128) { const int b = t >> 5; float s = 0.f;
#pragma unroll
            for (int q = 0; q < 16; ++q) s += sm[(q * 32 + cl) * 4 + b];
            mod[b * 6 * D + col] = s + bias[col]; }
        __syncthreads();
    }
}

__device__ __forceinline__ void p1_h1(const Args& a, int gw, int ngw, int lane) {
    const float* x = a.in[I_X]; const float* g = a.in[I_N1G]; const float* mod = (const float*)(a.ws + WS_MOD);
    bf16* h1 = (bf16*)(a.ws + WS_H1);
    for (int m = gw; m < NTOK; m += ngw) {
        const int b = m >> 13;
        const f32x4* xr = (const f32x4*)(x + (size_t)m * D) + lane;
        f32x4 v[4]; float s = 0.f;
#pragma unroll
        for (int j = 0; j < 4; ++j) { v[j] = xr[64 * j]; s += (v[j].x * v[j].x + v[j].y * v[j].y) + (v[j].z * v[j].z + v[j].w * v[j].w); }
        const float rstd = rsqrtf(wave_sum(s) * (1.f / D) + 1e-6f);
        unsigned long long* o8 = (unsigned long long*)(h1 + (size_t)m * D) + lane;
#pragma unroll
        for (int j = 0; j < 4; ++j) {
            const int k = 4 * lane + 256 * j;
            const f32x4 gg = *(const f32x4*)(g + k), sh = *(const f32x4*)(mod + b * 6 * D + k), sc = *(const f32x4*)(mod + b * 6 * D + D + k);
            const f32x4 h = v[j] * rstd * gg * (sc + 1.0f) + sh;
            o8[64 * j] = (unsigned long long)pk2(h.x, h.y) | ((unsigned long long)pk2(h.z, h.w) << 32);
        }
    }
}

__device__ __forceinline__ void p2_slow(const Args& a, LAS float* sm) {
    const bf16* h1 = (const bf16*)(a.ws + WS_H1); const float* W = a.in[I_WIN];
    bf16* U2 = (bf16*)(a.ws + WS_U2); bf16* Z = (bf16*)(a.ws + WS_Z);
    const int t = threadIdx.x, ty = t >> 4, tx = t & 15;
    for (int it = blockIdx.x; it < 512 * 16; it += gridDim.x) {
        const int rt = it >> 4, ct = it & 15, row0 = rt * 64;
        auto fa = [&](int r, int k) -> float { return bf2f(h1[(size_t)(row0 + r) * D + k]); };
        float acc[2][4];
        if (ct < 8) {
            const int c0 = ct * 64;
            auto fb = [&](int k, int c) -> float { return W[(size_t)k * DIN + c0 + c]; };
            slow_tile(sm, D, fa, fb, acc);
#pragma unroll
            for (int i = 0; i < 2; ++i)
#pragma unroll
                for (int j = 0; j < 4; ++j) {
                    const int tok = row0 + 2 * ty + i, n = c0 + 4 * tx + j, b = tok >> 13, l = tok & 8191;
                    U2[(size_t)(b * NCH + (l >> 5)) * U2LD + (n >> 4) * U2G + (l & 31) * 16 + (n & 15)] = (bf16)f2bf(acc[i][j]);
                }
        } else {
            const int j0 = (ct - 8) * 64;
            float accg[2][4];
            auto fbv = [&](int k, int c) -> float { return W[(size_t)k * DIN + 512 + j0 + c]; };
            auto fbg = [&](int k, int c) -> float { return W[(size_t)k * DIN + 1024 + j0 + c]; };
            slow_tile(sm, D, fa, fbv, acc);
            slow_tile(sm, D, fa, fbg, accg);
#pragma unroll
            for (int i = 0; i < 2; ++i)
#pragma unroll
                for (int j = 0; j < 4; ++j) {
                    const int tok = row0 + 2 * ty + i, n = j0 + 4 * tx + j;
                    Z[(size_t)tok * DCONV + n] = (bf16)f2bf(acc[i][j] * sigmoidf_(accg[i][j]));
                }
        }
    }
}

__device__ __forceinline__ void p3_slow_s5(const Args& a, int gw, int ngw, int lane) {
    const bf16* U2 = (const bf16*)(a.ws + WS_U2); bf16* YG = (bf16*)(a.ws + WS_YG);
    for (int task = gw; task < NB * NG; task += ngw) {
        const int b = task / NG, g = task % NG, p = lane;
        const float lr = a.in[I_LRE][g * NP + p], li = a.in[I_LIM][g * NP + p], dt = expf(a.in[I_LDT][g]);
        const float mag = expf(lr * dt); float sn, cs; sincosf(li * dt, &sn, &cs);
        const float ar = mag * cs, ai = mag * sn, den = lr * lr + li * li, nr = ar - 1.f;
        const float qr = (nr * lr + ai * li) / den, qi = (ai * lr - nr * li) / den;
        float Br[16], Bi[16], Cr[16], Ci[16];
#pragma unroll
        for (int h = 0; h < 16; ++h) {
            const float br = a.in[I_BRE][(g * NP + p) * GH + h], bi = a.in[I_BIM][(g * NP + p) * GH + h];
            Br[h] = qr * br - qi * bi; Bi[h] = qr * bi + qi * br;
            Cr[h] = a.in[I_CRE][(g * GH + h) * NP + p]; Ci[h] = a.in[I_CIM][(g * GH + h) * NP + p];
        }
        const float dsk = a.in[I_DSK][g * GH + (lane & 15)];
        float xr = 0.f, xi = 0.f;
        for (int t = 0; t < SEQ; ++t) {
            const bf16* up = U2 + (size_t)(b * NCH + (t >> 5)) * U2LD + g * U2G + (t & 31) * 16;
            const v4u u0 = *(const v4u*)up, u1 = *(const v4u*)(up + 8);
            float u[16];
            u[0] = bflo(u0.x); u[1] = bfhi(u0.x); u[2] = bflo(u0.y); u[3] = bfhi(u0.y); u[4] = bflo(u0.z); u[5] = bfhi(u0.z); u[6] = bflo(u0.w); u[7] = bfhi(u0.w);
            u[8] = bflo(u1.x); u[9] = bfhi(u1.x); u[10] = bflo(u1.y); u[11] = bfhi(u1.y); u[12] = bflo(u1.z); u[13] = bfhi(u1.z); u[14] = bflo(u1.w); u[15] = bfhi(u1.w);
            float bur = 0.f, bui = 0.f;
#pragma unroll
            for (int h = 0; h < 16; ++h) { bur += Br[h] * u[h]; bui += Bi[h] * u[h]; }
            const float nxr = ar * xr - ai * xi + bur, nxi = ar * xi + ai * xr + bui; xr = nxr; xi = nxi;
            float yv = 0.f, ul = 0.f;
#pragma unroll
            for (int h = 0; h < 16; ++h) { const float s = wave_sum(Cr[h] * xr - Ci[h] * xi); if ((lane & 15) == h) { yv = s; ul = u[h]; } }
            yv += dsk * ul;
            if (lane < 16) YG[(size_t)(b * SEQ + t) * DSSM + g * GH + lane] = (bf16)f2bf(gelu_tanh(yv));
        }
    }
}

__device__ __forceinline__ void p3d_slow(const Args& a, LAS float* sm) {
    const bf16* YG = (const bf16*)(a.ws + WS_YG); const float* W = a.in[I_WGLU]; const float* bg = a.in[I_BGLU];
    bf16* MRG = (bf16*)(a.ws + WS_MRG);
    const int t = threadIdx.x, ty = t >> 4, tx = t & 15;
    for (int it = blockIdx.x; it < 512 * 8; it += gridDim.x) {
        const int rt = it >> 3, ct = it & 7, row0 = rt * 64, c0 = ct * 64;
        auto fa = [&](int r, int k) -> float { return bf2f(YG[(size_t)(row0 + r) * DSSM + k]); };
        auto fb = [&](int k, int c) -> float { return W[(size_t)k * DSSM + c0 + c]; };
        float acc[2][4];
        slow_tile(sm, DSSM, fa, fb, acc);
#pragma unroll
        for (int i = 0; i < 2; ++i)
#pragma unroll
            for (int j = 0; j < 4; ++j) {
                const int tok = row0 + 2 * ty + i, n = c0 + 4 * tx + j;
                const float yv = bf2f(YG[(size_t)tok * DSSM + n]);
                MRG[(size_t)tok * D + n] = (bf16)f2bf(yv * sigmoidf_(acc[i][j] + bg[n]));
            }
    }
}

__device__ __forceinline__ void unpack8(const v4u w, float (&f)[8]) {
    f[0] = bflo(w.x); f[1] = bfhi(w.x); f[2] = bflo(w.y); f[3] = bfhi(w.y); f[4] = bflo(w.z); f[5] = bfhi(w.z); f[6] = bflo(w.w); f[7] = bfhi(w.w);
}
__device__ __forceinline__ void p3e_conv_norm(const Args& a, int gw, int ngw, int lane) {
    const bf16* Z = (const bf16*)(a.ws + WS_Z); bf16* MRG = (bf16*)(a.ws + WS_MRG);
    const float* cw = a.in[I_CONVW]; const float* cb = a.in[I_CONVB]; const float* lng = a.in[I_LNG]; const float* lnb = a.in[I_LNB]; const float* ong = a.in[I_ONG];
    const int ch = lane * 8;
    for (int it = gw; it < NTOK / 8; it += ngw) {
        const int t0 = it * 8, l0 = t0 & (SEQ - 1);
        float acc[8][8];
        { const f32x4 b0 = *(const f32x4*)(cb + ch), b1 = *(const f32x4*)(cb + ch + 4);
#pragma unroll
          for (int i = 0; i < 8; ++i) { acc[i][0] = b0.x; acc[i][1] = b0.y; acc[i][2] = b0.z; acc[i][3] = b0.w; acc[i][4] = b1.x; acc[i][5] = b1.y; acc[i][6] = b1.z; acc[i][7] = b1.w; } }
        for (int w = 0; w < CW; ++w) {
            const f32x4 w0 = *(const f32x4*)(cw + w * DCONV + ch), w1 = *(const f32x4*)(cw + w * DCONV + ch + 4);
            const float wv[8] = {w0.x, w0.y, w0.z, w0.w, w1.x, w1.y, w1.z, w1.w};
#pragma unroll
            for (int i = 0; i < 8; ++i) {
                const int l = l0 + i - (CW - 1) + w;
                if (l >= 0) {
                    const v4u zr = *(const v4u*)(Z + (size_t)(t0 + i - (CW - 1) + w) * DCONV + ch);
                    float zf[8]; unpack8(zr, zf);
#pragma unroll
                    for (int c = 0; c < 8; ++c) acc[i][c] += zf[c] * wv[c];
                }
            }
        }
        const f32x4 g0 = *(const f32x4*)(lng + ch), g1 = *(const f32x4*)(lng + ch + 4), be0 = *(const f32x4*)(lnb + ch), be1 = *(const f32x4*)(lnb + ch + 4);
        const f32x4 o0 = *(const f32x4*)(ong + DSSM + ch), o1 = *(const f32x4*)(ong + DSSM + ch + 4);
        const float gv[8] = {g0.x, g0.y, g0.z, g0.w, g1.x, g1.y, g1.z, g1.w}, bv[8] = {be0.x, be0.y, be0.z, be0.w, be1.x, be1.y, be1.z, be1.w};
        const float ov[8] = {o0.x, o0.y, o0.z, o0.w, o1.x, o1.y, o1.z, o1.w};
#pragma unroll
        for (int i = 0; i < 8; ++i) {
            float s = 0.f;
#pragma unroll
            for (int c = 0; c < 8; ++c) s += acc[i][c];
            const float mean = wave_sum(s) * (1.f / DCONV);
            float q = 0.f;
#pragma unroll
            for (int c = 0; c < 8; ++c) { const float d = acc[i][c] - mean; q += d * d; }
            const float rstd = rsqrtf(wave_sum(q) * (1.f / DCONV) + 1e-5f);
            float y[8], ss = 0.f;
#pragma unroll
            for (int c = 0; c < 8; ++c) { y[c] = siluf_((acc[i][c] - mean) * rstd * gv[c] + bv[c]); ss += y[c] * y[c]; }
            const float r2 = rsqrtf(wave_sum(ss) * (1.f / DCONV) + 1e-6f);
            v4u o; o.x = pk2(y[0] * r2 * ov[0], y[1] * r2 * ov[1]); o.y = pk2(y[2] * r2 * ov[2], y[3] * r2 * ov[3]);
            o.z = pk2(y[4] * r2 * ov[4], y[5] * r2 * ov[5]); o.w = pk2(y[6] * r2 * ov[6], y[7] * r2 * ov[7]);
            *(v4u*)(MRG + (size_t)(t0 + i) * D + DSSM + ch) = o;
        }
    }
    { const f32x4 o0 = *(const f32x4*)(ong + ch), o1 = *(const f32x4*)(ong + ch + 4);
      const float ov[8] = {o0.x, o0.y, o0.z, o0.w, o1.x, o1.y, o1.z, o1.w};
      for (int m = gw; m < NTOK; m += ngw) {
          v4u* p = (v4u*)(MRG + (size_t)m * D + ch);
          float f[8]; unpack8(*p, f);
          float ss = 0.f;
#pragma unroll
          for (int c = 0; c < 8; ++c) ss += f[c] * f[c];
          const float r2 = rsqrtf(wave_sum(ss) * (1.f / DSSM) + 1e-6f);
          v4u o; o.x = pk2(f[0] * r2 * ov[0], f[1] * r2 * ov[1]); o.y = pk2(f[2] * r2 * ov[2], f[3] * r2 * ov[3]);
          o.z = pk2(f[4] * r2 * ov[4], f[5] * r2 * ov[5]); o.w = pk2(f[6] * r2 * ov[6], f[7] * r2 * ov[7]);
          *p = o;
      } }
}

__device__ __forceinline__ void p4_slow(const Args& a, LAS float* sm) {
    const bf16* MRG = (const bf16*)(a.ws + WS_MRG); const float* W = a.in[I_WOUT]; const float* x = a.in[I_X]; const float* mod = (const float*)(a.ws + WS_MOD);
    const int t = threadIdx.x, ty = t >> 4, tx = t & 15;
    for (int it = blockIdx.x; it < 512 * 16; it += gridDim.x) {
        const int rt = it >> 4, ct = it & 15, row0 = rt * 64, c0 = ct * 64;
        auto fa = [&](int r, int k) -> float { return bf2f(MRG[(size_t)(row0 + r) * D + k]); };
        auto fb = [&](int k, int c) -> float { return W[(size_t)k * D + c0 + c]; };
        float acc[2][4];
        slow_tile(sm, D, fa, fb, acc);
#pragma unroll
        for (int i = 0; i < 2; ++i)
#pragma unroll
            for (int j = 0; j < 4; ++j) {
                const int tok = row0 + 2 * ty + i, n = c0 + 4 * tx + j, b = tok >> 13;
                a.out[(size_t)tok * D + n] = x[(size_t)tok * D + n] + mod[b * 6 * D + 2 * D + n] * acc[i][j];
            }
    }
}

__device__ __forceinline__ void p5_slow(const Args& a, LAS unsigned char* lds, int gw, int ngw, int lane, int wave) {
    const float* g = a.in[I_N2G]; const float* mod = (const float*)(a.ws + WS_MOD); const float* rw = a.in[I_RW]; const float* rb = a.in[I_RB];
    bf16* H2 = (bf16*)(a.ws + WS_H2); float* topw = (float*)(a.ws + WS_TOPW); int* tokk = (int*)(a.ws + WS_TOKK); unsigned* cnt = (unsigned*)(a.ws + WS_CTL) + CW_CNT;
    LAS float* hrow = (LAS float*)(lds + wave * 4096);
    for (int tok = gw; tok < NTOK; tok += ngw) {
        const int b = tok >> 13;
        const f32x4* xr = (const f32x4*)(a.out + (size_t)tok * D) + lane;
        f32x4 v[4]; float s = 0.f;
#pragma unroll
        for (int j = 0; j < 4; ++j) { v[j] = xr[64 * j]; s += (v[j].x * v[j].x + v[j].y * v[j].y) + (v[j].z * v[j].z + v[j].w * v[j].w); }
        const float rstd = rsqrtf(wave_sum(s) * (1.f / D) + 1e-6f);
        unsigned long long* h8 = (unsigned long long*)(H2 + (size_t)tok * D) + lane;
        unsigned long long* x8 = (unsigned long long*)((bf16*)(a.out + (size_t)tok * D) + D) + lane;
#pragma unroll
        for (int j = 0; j < 4; ++j) {
            const int k = 4 * lane + 256 * j;
            const f32x4 gg = *(const f32x4*)(g + k), sh = *(const f32x4*)(mod + b * 6 * D + 3 * D + k), sc = *(const f32x4*)(mod + b * 6 * D + 4 * D + k);
            const f32x4 h = v[j] * rstd * gg * (sc + 1.0f) + sh;
            *(LAS f32x4*)(hrow + k) = h;
            h8[64 * j] = (unsigned long long)pk2(h.x, h.y) | ((unsigned long long)pk2(h.z, h.w) << 32);
            x8[64 * j] = (unsigned long long)pk2(v[j].x, v[j].y) | ((unsigned long long)pk2(v[j].z, v[j].w) << 32);
        }
        LDS_WAIT();
        const int e = lane & 31, half = lane >> 5;
        float acc = 0.f;
        for (int k = half * 512; k < half * 512 + 512; k += 4) {
            const f32x4 hv = *(const LAS f32x4*)(hrow + k);
            acc += hv.x * rw[(k + 0) * NE + e]; acc += hv.y * rw[(k + 1) * NE + e]; acc += hv.z * rw[(k + 2) * NE + e]; acc += hv.w * rw[(k + 3) * NE + e];
        }
        acc += __shfl_xor(acc, 32);
        LDS_WAIT();
        float val = acc + rb[e]; const int idx = e;
        float tv[4]; int ti[4];
#pragma unroll
        for (int r = 0; r < 4; ++r) {
            float mv = val; int mi = idx;
#pragma unroll
            for (int off = 16; off >= 1; off >>= 1) { const float ov = __shfl_xor(mv, off); const int oi = __shfl_xor(mi, off); if (ov > mv || (ov == mv && oi < mi)) { mv = ov; mi = oi; } }
            tv[r] = mv; ti[r] = mi; if (idx == mi) val = -3.0e38f;
        }
        const float e1 = __expf(tv[1] - tv[0]), e2 = __expf(tv[2] - tv[0]), e3 = __expf(tv[3] - tv[0]), inv = 1.f / (1.f + e1 + e2 + e3);
        if (lane < 4) {
            const int es = lane == 0 ? ti[0] : lane == 1 ? ti[1] : lane == 2 ? ti[2] : ti[3];
            const float ws_ = (lane == 0 ? 1.f : lane == 1 ? e1 : lane == 2 ? e2 : e3) * inv;
            const unsigned slot = atomicAdd(cnt + es, 1u);
            tokk[(size_t)es * CAP + slot] = tok * 4 + lane;
            topw[tok * 4 + lane] = ws_;
        }
    }
}

__device__ __forceinline__ void moe_tables(const Args& a, LAS int* T) {
    const unsigned* cnt = (const unsigned*)(a.ws + WS_CTL) + CW_CNT;
    if (threadIdx.x < 32) T[threadIdx.x] = (int)__hip_atomic_load(cnt + threadIdx.x, __ATOMIC_RELAXED, __HIP_MEMORY_SCOPE_AGENT);
    __syncthreads();
    if (threadIdx.x == 0) { int rb = 0, t64 = 0, t256 = 0;
        for (int e = 0; e < NE; ++e) { T[32 + e] = rb; T[65 + e] = t64; T[98 + e] = t256; const int c = T[e]; rb += c; t64 += (c + 63) >> 6; t256 += (c + 255) >> 8; }
        T[32 + NE] = rb; T[65 + NE] = t64; T[98 + NE] = t256; }
    __syncthreads();
}

__device__ __forceinline__ void p7_slow(const Args& a, LAS float* sm, LAS int* T) {
    const bf16* H2 = (const bf16*)(a.ws + WS_H2); const int* tokk = (const int*)(a.ws + WS_TOKK); bf16* ACT = (bf16*)(a.ws + WS_ACT);
    const int t = threadIdx.x, ty = t >> 4, tx = t & 15;
    const int nitems = T[65 + NE] * 16;
    for (int it = blockIdx.x; it < nitems; it += gridDim.x) {
        const int tile = it >> 4, ct = it & 15; int e = 0;
        for (int q = 1; q < NE; ++q) if (T[65 + q] <= tile) e = q;
        const int rt = tile - T[65 + e], cnt = T[e], rowbase = T[32 + e], f0 = ct * 64;
        auto fa = [&](int r, int k) -> float { const int slot = rt * 64 + r; if (slot >= cnt) return 0.f; const int tok = tokk[(size_t)e * CAP + slot] >> 2; return bf2f(H2[(size_t)tok * D + k]); };
        const float* Wg = a.in[I_WG] + (size_t)e * D * FF; const float* Wu = a.in[I_WU] + (size_t)e * D * FF;
        auto fbg = [&](int k, int c) -> float { return Wg[(size_t)k * FF + f0 + c]; };
        auto fbu = [&](int k, int c) -> float { return Wu[(size_t)k * FF + f0 + c]; };
        float ag[2][4], au[2][4];
        slow_tile(sm, D, fa, fbg, ag);
        slow_tile(sm, D, fa, fbu, au);
#pragma unroll
        for (int i = 0; i < 2; ++i)
#pragma unroll
            for (int j = 0; j < 4; ++j) {
                const int slot = rt * 64 + 2 * ty + i, f = f0 + 4 * tx + j;
                if (slot < cnt) {
                    const float gate = fminf(ag[i][j] + a.in[I_BG][e * FF + f], 7.0f);
                    const float up = fminf(fmaxf(au[i][j] + a.in[I_BU][e * FF + f], -7.0f), 7.0f);
                    const float glu = gate * sigmoidf_(1.702f * gate);
                    ACT[(size_t)(rowbase + slot) * FF + f] = (bf16)f2bf((up + 1.0f) * glu);
                }
            }
    }
}

__device__ __forceinline__ bf16* ys_ptr(const Args& a, int tok, int k) {
    if (k == 0) return (bf16*)(a.out + (size_t)tok * D);
    if (k == 3) return (bf16*)(a.ws + WS_YS3) + (size_t)tok * D;
    return (bf16*)(a.ws + WS_YS12) + ((size_t)(k - 1) * NTOK + tok) * D;
}

__device__ __forceinline__ void p8_slow(const Args& a, LAS float* sm, LAS int* T) {
    const int* tokk = (const int*)(a.ws + WS_TOKK); const bf16* ACT = (const bf16*)(a.ws + WS_ACT);
    const int t = threadIdx.x, ty = t >> 4, tx = t & 15;
    const int nitems = T[65 + NE] * 16;
    for (int it = blockIdx.x; it < nitems; it += gridDim.x) {
        const int tile = it >> 4, ct = it & 15; int e = 0;
        for (int q = 1; q < NE; ++q) if (T[65 + q] <= tile) e = q;
        const int rt = tile - T[65 + e], cnt = T[e], rowbase = T[32 + e], c0 = ct * 64;
        auto fa = [&](int r, int k) -> float { const int slot = rt * 64 + r; if (slot >= cnt) return 0.f; return bf2f(ACT[(size_t)(rowbase + slot) * FF + k]); };
        const float* Wd = a.in[I_WD] + (size_t)e * FF * D;
        auto fb = [&](int k, int c) -> float { return Wd[(size_t)k * D + c0 + c]; };
        float acc[2][4];
        slow_tile(sm, FF, fa, fb, acc);
#pragma unroll
        for (int i = 0; i < 2; ++i) {
            const int slot = rt * 64 + 2 * ty + i;
            if (slot < cnt) {
                const int tk = tokk[(size_t)e * CAP + slot]; bf16* dst = ys_ptr(a, tk >> 2, tk & 3);
#pragma unroll
                for (int j = 0; j < 4; ++j) { const int n = c0 + 4 * tx + j; dst[n] = (bf16)f2bf(acc[i][j] + a.in[I_BD][e * D + n]); }
            }
        }
    }
}

__device__ __forceinline__ void p9_final(const Args& a, int gw, int ngw, int lane) {
    const float* mod = (const float*)(a.ws + WS_MOD); const float* topw = (const float*)(a.ws + WS_TOPW); const float* fg = a.in[I_FG];
    for (int tok = gw; tok < NTOK; tok += ngw) {
        const int b = tok >> 13;
        const f32x4 w4 = *(const f32x4*)(topw + tok * 4);
        float xo[2][8], ss = 0.f;
#pragma unroll
        for (int q = 0; q < 2; ++q) {
            const int ch = lane * 8 + 512 * q;
            float x1[8], y0[8], y1[8], y2[8], y3[8];
            unpack8(*(const v4u*)((const bf16*)(a.out + (size_t)tok * D) + D + ch), x1);
            unpack8(*(const v4u*)(ys_ptr(a, tok, 0) + ch), y0); unpack8(*(const v4u*)(ys_ptr(a, tok, 1) + ch), y1);
            unpack8(*(const v4u*)(ys_ptr(a, tok, 2) + ch), y2); unpack8(*(const v4u*)(ys_ptr(a, tok, 3) + ch), y3);
            const f32x4 g0 = *(const f32x4*)(mod + b * 6 * D + 5 * D + ch), g1 = *(const f32x4*)(mod + b * 6 * D + 5 * D + ch + 4);
            const float g2[8] = {g0.x, g0.y, g0.z, g0.w, g1.x, g1.y, g1.z, g1.w};
#pragma unroll
            for (int c = 0; c < 8; ++c) { xo[q][c] = x1[c] + g2[c] * (((w4.x * y0[c] + w4.y * y1[c]) + w4.z * y2[c]) + w4.w * y3[c]); ss += xo[q][c] * xo[q][c]; }
        }
        const float rstd = rsqrtf(wave_sum(ss) * (1.f / D) + 1e-6f);
#pragma unroll
        for (int q = 0; q < 2; ++q) {
            const int ch = lane * 8 + 512 * q;
            const f32x4 f0 = *(const f32x4*)(fg + ch), f1 = *(const f32x4*)(fg + ch + 4);
            f32x4 o0, o1;
            o0.x = xo[q][0] * rstd * f0.x; o0.y = xo[q][1] * rstd * f0.y; o0.z = xo[q][2] * rstd * f0.z; o0.w = xo[q][3] * rstd * f0.w;
            o1.x = xo[q][4] * rstd * f1.x; o1.y = xo[q][5] * rstd * f1.y; o1.z = xo[q][6] * rstd * f1.z; o1.w = xo[q][7] * rstd * f1.w;
            f32x4* op = (f32x4*)(a.out + (size_t)tok * D + ch);
            op[0] = o0; op[1] = o1;
        }
    }
}


namespace pg8 {
constexpr int BM = 256, BK = 64, HALF = 128, HTB = HALF * BK * 2  , STAGE_BYTES = 8 * HTB, NXCD = 8, WGM = 8;
__host__ __device__ __forceinline__ int lds_byte(int r, int c) { const int st = (r >> 4) * 2 + (c >> 5), rr = r & 15, cc = c & 31, ob = rr * 64 + cc * 2; return st * 1024 + (ob ^ (((ob >> 9) & 1) << 5)); }
__host__ __device__ __forceinline__ void stage_rc(int b, int& R, int& C) { const int st = b / 1024, sb = b % 1024, swz = sb ^ (((sb >> 9) & 1) << 5); R = (st >> 1) * 16 + swz / 64; C = (st & 1) * 32 + (swz % 64) / 2; }
__host__ __device__ __forceinline__ int perm32(int rho) { const int n = rho >> 4, i = rho & 15; return 8 * (i >> 2) + 4 * n + (i & 3); }
struct Unit { int pm, pn, e, row0, slot0, nvalid; };
__device__ __forceinline__ unsigned cvt_pk_bf16(float lo, float hi) { unsigned r; asm volatile("v_cvt_pk_bf16_f32 %0, %1, %2" : "=v"(r) : "v"(lo), "v"(hi)); return r; }

template <class Epi, class Sched, bool ALIGN_EPI>
__device__ __forceinline__ void gemm_phase(LAS unsigned char* lds, const Sched& S, const Epi& E) {
    const int tid = threadIdx.x, wid = __builtin_amdgcn_readfirstlane(tid >> 6), lane = tid & 63, wr = wid >> 2, wc = wid & 3, fr = lane & 15, fq = lane >> 4;
    const int nt = S.K / BK;
    int R[2], C[2]; unsigned voffB[2];
#pragma unroll
    for (int i = 0; i < 2; ++i) { stage_rc(tid * 16 + i * 8192, R[i], C[i]); const int Rb = Epi::PERM ? ((R[i] & ~31) + perm32(R[i] & 31)) : R[i]; voffB[i] = (unsigned)(Rb * S.ldb + C[i]) * 2u; }
    const size_t kstep = (size_t)(BK * 2);
    const size_t bhstep = (size_t)HALF * S.ldb * 2;
    const unsigned ldsw = (unsigned)wid * 1024u;
    const int aoff = lds_byte(wr * 64 + fr, fq * 8), boff = lds_byte(wc * 32 + fr, fq * 8);
#define PG8_SA(b, h) (((b) * 2 + (h)) * HTB)
#define PG8_SB(b, h) ((4 + (b) * 2 + (h)) * HTB)
#define PG8_STAGE(bufoff, gbase, voff) do { _Pragma("unroll") for (int _i = 0; _i < 2; ++_i) \
        __builtin_amdgcn_global_load_lds((const unsigned*)((const char*)(gbase) + (voff)[_i]), (LAS unsigned*)(lds + (bufoff) + ldsw + _i * 8192), 16, 0, 0); } while (0)
#define PG8_LDA(dst, b, h) do { _Pragma("unroll") for (int m = 0; m < 4; ++m) _Pragma("unroll") for (int k = 0; k < 2; ++k) dst[m][k] = *(const LAS bf16x8*)(lds + PG8_SA(b, h) + aoff + m * 2048 + k * 1024); } while (0)
#define PG8_LDB(dst, b, h) do { _Pragma("unroll") for (int n = 0; n < 2; ++n) _Pragma("unroll") for (int k = 0; k < 2; ++k) dst[n][k] = *(const LAS bf16x8*)(lds + PG8_SB(b, h) + boff + n * 2048 + k * 1024); } while (0)
#define PG8_MMA(ai, bj, At, Bt) do { __builtin_amdgcn_s_setprio(1); _Pragma("unroll") for (int m = 0; m < 4; ++m) _Pragma("unroll") for (int n = 0; n < 2; ++n) _Pragma("unroll") for (int k = 0; k < 2; ++k) \
        acc[ai][bj][m][n] = __builtin_amdgcn_mfma_f32_16x16x32_bf16(Bt[n][k], At[m][k], acc[ai][bj][m][n], 0, 0, 0); __builtin_amdgcn_s_setprio(0); } while (0)
#define PG8_WAIT_V(n) asm volatile("s_waitcnt vmcnt(" #n ")" ::: "memory")
#define PG8_WAIT_L(n) asm volatile("s_waitcnt lgkmcnt(" #n ")" ::: "memory")
#define PG8_BAR __builtin_amdgcn_s_barrier()
#define PG8_SCHED __builtin_amdgcn_sched_barrier(0)
    Unit cur, nxt; int ui = 0;
    if (!S.next(0, cur)) return;
    f32x4 acc[2][2][4][2];
#pragma unroll
    for (int a = 0; a < 2; ++a)
#pragma unroll
        for (int b = 0; b < 2; ++b)
#pragma unroll
            for (int m = 0; m < 4; ++m)
#pragma unroll
                for (int n = 0; n < 2; ++n) acc[a][b][m][n] = (f32x4){0.f, 0.f, 0.f, 0.f};
    bf16x8 At[4][2], B0[2][2], B1[2][2];
    unsigned ao[2][2], an[2][2];
    S.a_offsets(cur, R, C, ao);
    const char* cA = S.a_base(cur); const char* cB = S.b_base(cur);
    PG8_STAGE(PG8_SB(0, 0), cB, voffB); PG8_STAGE(PG8_SB(0, 1), cB + bhstep, voffB); PG8_STAGE(PG8_SA(0, 0), cA, ao[0]); PG8_STAGE(PG8_SA(0, 1), cA, ao[1]);
    if (wr == 1) PG8_BAR;
    PG8_WAIT_V(2); PG8_BAR;
    PG8_STAGE(PG8_SB(1, 0), cB + kstep, voffB); PG8_STAGE(PG8_SA(1, 0), cA + kstep, ao[0]); PG8_STAGE(PG8_SB(1, 1), cB + bhstep + kstep, voffB);
    PG8_WAIT_V(6); PG8_BAR;
    for (;;) {
        const bool has_next = S.next(ui + 1, nxt);
        const char* nA = cA; const char* nB = cB;
#pragma unroll
        for (int h = 0; h < 2; ++h)
#pragma unroll
            for (int i = 0; i < 2; ++i) an[h][i] = ao[h][i];
        if (has_next) { nA = S.a_base(nxt); nB = S.b_base(nxt); S.a_offsets(nxt, R, C, an); }
        for (int t = 0; t < nt; t += 2) {
            const bool last = (t == nt - 2);
            const char* a1 = cA + (size_t)(t + 1) * kstep;
            const char* a2 = last ? nA : cA + (size_t)(t + 2) * kstep; const char* b2 = last ? nB : cB + (size_t)(t + 2) * kstep;
            const char* a3 = a2 + kstep; const char* b3 = b2 + kstep;
            unsigned o2[2][2];
#pragma unroll
            for (int h = 0; h < 2; ++h)
#pragma unroll
                for (int i = 0; i < 2; ++i) o2[h][i] = last ? an[h][i] : ao[h][i];
            PG8_LDB(B0, 0, 0); PG8_LDB(B1, 0, 1); PG8_SCHED; PG8_LDA(At, 0, 0); PG8_STAGE(PG8_SA(1, 1), a1, ao[1]);
            PG8_WAIT_V(8); PG8_WAIT_L(0); PG8_BAR; PG8_MMA(0, 0, At, B0); PG8_MMA(0, 1, At, B1); PG8_BAR; PG8_SCHED;
            PG8_LDA(At, 0, 1); PG8_STAGE(PG8_SB(0, 0), b2, voffB); PG8_STAGE(PG8_SB(0, 1), b2 + bhstep, voffB); PG8_STAGE(PG8_SA(0, 0), a2, o2[0]);
            PG8_WAIT_V(8); PG8_WAIT_L(0); PG8_BAR; PG8_MMA(1, 0, At, B0); PG8_MMA(1, 1, At, B1); PG8_BAR; PG8_SCHED;
            PG8_LDB(B0, 1, 0); PG8_LDB(B1, 1, 1); PG8_SCHED; PG8_LDA(At, 1, 0); PG8_STAGE(PG8_SA(0, 1), a2, o2[1]);
            PG8_WAIT_V(8); PG8_WAIT_L(0); PG8_BAR; PG8_MMA(0, 0, At, B0); PG8_MMA(0, 1, At, B1); PG8_BAR; PG8_SCHED;
            PG8_LDA(At, 1, 1); PG8_STAGE(PG8_SB(1, 0), b3, voffB); PG8_STAGE(PG8_SB(1, 1), b3 + bhstep, voffB); PG8_STAGE(PG8_SA(1, 0), a3, o2[0]);
            PG8_WAIT_V(8); PG8_WAIT_L(0); PG8_BAR; PG8_MMA(1, 0, At, B0); PG8_MMA(1, 1, At, B1); PG8_BAR; PG8_SCHED;
        }
        if constexpr (ALIGN_EPI) { if (wr == 0) PG8_BAR; }
        E(acc, cur, wr, wc, fr, fq);
        if (!has_next) break;
#pragma unroll
        for (int a = 0; a < 2; ++a)
#pragma unroll
            for (int b = 0; b < 2; ++b)
#pragma unroll
                for (int m = 0; m < 4; ++m)
#pragma unroll
                    for (int n = 0; n < 2; ++n) acc[a][b][m][n] = (f32x4){0.f, 0.f, 0.f, 0.f};
        cur = nxt; cA = nA; cB = nB; ++ui;
#pragma unroll
        for (int h = 0; h < 2; ++h)
#pragma unroll
            for (int i = 0; i < 2; ++i) ao[h][i] = an[h][i];
        if constexpr (ALIGN_EPI) { if (wr == 1) PG8_BAR; }
    }
    PG8_WAIT_V(0);
    if constexpr (!ALIGN_EPI) { if (wr == 0) PG8_BAR; }
    PG8_BAR;
#undef PG8_SA
#undef PG8_SB
#undef PG8_STAGE
#undef PG8_LDA
#undef PG8_LDB
#undef PG8_MMA
#undef PG8_WAIT_V
#undef PG8_WAIT_L
#undef PG8_BAR
#undef PG8_SCHED
}

struct SchedDense {
    const bf16* A; const bf16* Bt; int K, lda, ldb; int nM, nN, nwg, G, c;
    __device__ __forceinline__ void init(const bf16* A_, const bf16* Bt_, int M, int N, int K_, int lda_, int ldb_, int G_, int c_) { A = A_; Bt = Bt_; K = K_; lda = lda_; ldb = ldb_; nM = M / BM; nN = N / BM; nwg = nM * nN; G = G_; c = c_; }
    __device__ __forceinline__ bool next(int i, Unit& u) const {
        const long L = (long)i * G + c; if (L >= nwg) return false;
        int wgid = (int)L; { const int q = nwg / NXCD, r = nwg % NXCD, xcd = wgid % NXCD, off = wgid / NXCD; wgid = (xcd < r ? xcd * (q + 1) : r * (q + 1) + (xcd - r) * q) + off; }
        const int nig = WGM * nN, gid = wgid / nig, fm = gid * WGM, gsz = (nM - fm) < WGM ? (nM - fm) : WGM;
        u.pm = fm + ((wgid % nig) % gsz); u.pn = (wgid % nig) / gsz; u.e = 0; u.row0 = u.pm * BM; u.slot0 = 0; u.nvalid = BM; return true;
    }
    __device__ __forceinline__ const char* a_base(const Unit& u) const { return (const char*)A + (size_t)u.pm * BM * lda * 2; }
    __device__ __forceinline__ const char* b_base(const Unit& u) const { return (const char*)Bt + (size_t)u.pn * BM * ldb * 2; }
    __device__ __forceinline__ void a_offsets(const Unit&, const int (&R)[2], const int (&C)[2], unsigned (&off)[2][2]) const {
#pragma unroll
        for (int h = 0; h < 2; ++h)
#pragma unroll
            for (int i = 0; i < 2; ++i) off[h][i] = (unsigned)((R[i] + HALF * h) * lda + C[i]) * 2u;
    }
};
struct SchedGroup {
    const bf16* A; const bf16* Bt; int K, lda, ldb; int nM, nN, ng, G, c; size_t astride, bstride;
    __device__ __forceinline__ bool next(int i, Unit& u) const {
        const int L = i * G + c; if (L >= ng * nM * nN) return false;
        const int g = L / (nM * nN), rem = L % (nM * nN);
        u.e = g; u.pm = rem % nM; u.pn = rem / nM; u.row0 = u.pm * BM; u.slot0 = 0; u.nvalid = BM; return true;
    }
    __device__ __forceinline__ const char* a_base(const Unit& u) const { return (const char*)(A + (size_t)u.e * astride) + (size_t)u.pm * BM * lda * 2; }
    __device__ __forceinline__ const char* b_base(const Unit& u) const { return (const char*)(Bt + (size_t)u.e * bstride) + (size_t)u.pn * BM * ldb * 2; }
    __device__ __forceinline__ void a_offsets(const Unit&, const int (&R)[2], const int (&C)[2], unsigned (&off)[2][2]) const {
#pragma unroll
        for (int h = 0; h < 2; ++h)
#pragma unroll
            for (int i = 0; i < 2; ++i) off[h][i] = (unsigned)((R[i] + HALF * h) * lda + C[i]) * 2u;
    }
};
}

__device__ __forceinline__ void transpose_item(const float* W, int K, int N, bf16* WT, int k0, int n0, int drow0, LAS float* scr, int lane) {
#pragma unroll 8
    for (int i = 0; i < 32; ++i) { const int kk = 2 * i + (lane >> 5); scr[kk * 33 + (lane & 31)] = W[(size_t)(k0 + kk) * N + n0 + (lane & 31)]; }
    LDS_WAIT();
    const int c = lane & 7;
#pragma unroll
    for (int j = 0; j < 4; ++j) { const int n = (lane >> 3) + 8 * j; const LAS float* s = scr + (8 * c) * 33 + n;
        v4u o; o.x = pk2(s[0 * 33], s[1 * 33]); o.y = pk2(s[2 * 33], s[3 * 33]); o.z = pk2(s[4 * 33], s[5 * 33]); o.w = pk2(s[6 * 33], s[7 * 33]);
        *(v4u*)(WT + (size_t)(drow0 + n) * K + k0 + 8 * c) = o; }
    LDS_WAIT();
}
__device__ __forceinline__ void p0_convert(const Args& a, LAS unsigned char* lds, int gw, int ngw, int lane, int wave) {
    LAS float* scr = (LAS float*)(lds + wave * 16384);
    constexpr int I_IN = 16 * 48, I_GLU = 8 * 16, I_OUT = 16 * 32, I_EXP = 16 * 32;
    constexpr int NITEMS = I_IN + I_GLU + I_OUT + 3 * NE * I_EXP;
    for (int it = gw; it < NITEMS; it += ngw) {
        int r = it;
        if (r < I_IN) { const int kb = r / 48, nb = r % 48, n0 = nb * 32; int drow;
            if (n0 < 512) drow = n0; else if (n0 < 1024) { const int j = n0 - 512; drow = 512 + (j >> 7) * 256 + (j & 127); } else { const int j = n0 - 1024; drow = 512 + (j >> 7) * 256 + 128 + (j & 127); }
            transpose_item(a.in[I_WIN], D, DIN, (bf16*)(a.ws + WS_WIN), kb * 64, n0, drow, scr, lane); continue; } r -= I_IN;
        if (r < I_GLU) { const int kb = r / 16, nb = r % 16; transpose_item(a.in[I_WGLU], DSSM, DSSM, (bf16*)(a.ws + WS_WGLU), kb * 64, nb * 32, nb * 32, scr, lane); continue; } r -= I_GLU;
        if (r < I_OUT) { const int kb = r / 32, nb = r % 32; transpose_item(a.in[I_WOUT], D, D, (bf16*)(a.ws + WS_WOUT), kb * 64, nb * 32, nb * 32, scr, lane); continue; } r -= I_OUT;
        const int e = r / (3 * I_EXP), q = r % (3 * I_EXP), which = q / I_EXP, s = q % I_EXP, kb = s / 32, nb = s % 32, n0 = nb * 32;
        if (which == 0) transpose_item(a.in[I_WG] + (size_t)e * D * FF, D, FF, (bf16*)(a.ws + WS_WGU) + (size_t)e * 2048 * D, kb * 64, n0, (n0 >> 7) * 256 + (n0 & 127), scr, lane);
        else if (which == 1) transpose_item(a.in[I_WU] + (size_t)e * D * FF, D, FF, (bf16*)(a.ws + WS_WGU) + (size_t)e * 2048 * D, kb * 64, n0, (n0 >> 7) * 256 + 128 + (n0 & 127), scr, lane);
        else transpose_item(a.in[I_WD] + (size_t)e * FF * D, FF, D, (bf16*)(a.ws + WS_WD) + (size_t)e * D * FF, kb * 64, n0, n0, scr, lane);
    }
}
__device__ __forceinline__ void p0_s5_mats(const Args& a, LAS float* sm) {
    LAS float* Ptau = sm; LAS float* Pt1 = sm + 128; LAS float* Ps = sm + 256; LAS float* Bb = sm + 512; LAS float* Kt = sm + 512 + 2048;
    bf16* BTS = (bf16*)(a.ws + WS_BTS); bf16* BTY = (bf16*)(a.ws + WS_BTY);
    const int t = threadIdx.x;
    for (int it = blockIdx.x; it < NG * TCH; it += gridDim.x) {
        const int g = it >> 5, tau = it & 31;
        if (t < 64) {
            const int p = t;
            const float lr = a.in[I_LRE][g * NP + p], li = a.in[I_LIM][g * NP + p], dt = expf(a.in[I_LDT][g]);
            const float mag = expf(lr * dt); float sn, cs; sincosf(li * dt, &sn, &cs);
            const float ar = mag * cs, ai = mag * sn, den = lr * lr + li * li, nr = ar - 1.f;
            const float qr = (nr * lr + ai * li) / den, qi = (ai * lr - nr * li) / den;
            { const float e = (float)tau; const float m = expf(e * lr * dt); float s2, c2; sincosf(e * li * dt, &s2, &c2); Ptau[2 * p] = m * c2; Ptau[2 * p + 1] = m * s2; }
            { const float e = (float)(tau + 1); const float m = expf(e * lr * dt); float s2, c2; sincosf(e * li * dt, &s2, &c2); Pt1[2 * p] = m * c2; Pt1[2 * p + 1] = m * s2; }
            { const float e = (float)(31 - tau); const float m = expf(e * lr * dt); float s2, c2; sincosf(e * li * dt, &s2, &c2); Ps[2 * p] = m * c2; Ps[2 * p + 1] = m * s2; }
#pragma unroll
            for (int h = 0; h < 16; ++h) {
                const float br = a.in[I_BRE][(g * NP + p) * GH + h], bi = a.in[I_BIM][(g * NP + p) * GH + h];
                Bb[(p * 16 + h) * 2] = qr * br - qi * bi; Bb[(p * 16 + h) * 2 + 1] = qr * bi + qi * br;
            }
        }
        __syncthreads();
        if (t < 256) {
            const int h = t >> 4, h2 = t & 15; float s = 0.f;
            for (int p = 0; p < NP; ++p) {
                const float cr = a.in[I_CRE][(g * GH + h) * NP + p], ci = a.in[I_CIM][(g * GH + h) * NP + p];
                const float pr = Ptau[2 * p], pi = Ptau[2 * p + 1], br = Bb[(p * 16 + h2) * 2], bi = Bb[(p * 16 + h2) * 2 + 1];
                const float xr = pr * br - pi * bi, xi = pr * bi + pi * br;
                s += cr * xr - ci * xi;
            }
            if (tau == 0 && h == h2) s += a.in[I_DSK][g * GH + h];
            Kt[t] = s;
        }
        __syncthreads();
        bf16* by = BTY + (size_t)g * 512 * U2G;
        for (int idx = t; idx < (TCH - tau) * 32; idx += NTHR) {
            const int j = idx >> 5, h = (idx >> 1) & 15, half = idx & 1, tt = tau + j, s = j;
            const LAS float* k = Kt + h * 16 + half * 8;
            v4u o; o.x = pk2(k[0], k[1]); o.y = pk2(k[2], k[3]); o.z = pk2(k[4], k[5]); o.w = pk2(k[6], k[7]);
            *(v4u*)(by + (size_t)(tt * 16 + h) * U2G + s * 16 + half * 8) = o;
        }
        if (tau >= 1) for (int idx = t; idx < (TCH - tau) * 32; idx += NTHR) {
            const int j = idx >> 5, h = (idx >> 1) & 15, half = idx & 1, tt = j, s = tau + j;
            *(v4u*)(by + (size_t)(tt * 16 + h) * U2G + s * 16 + half * 8) = (v4u){0u, 0u, 0u, 0u};
        }
        if (t < 256) {
            const int h = t >> 4, piece = t & 15; float v[8];
#pragma unroll
            for (int q = 0; q < 8; ++q) { const int pp = piece * 8 + q, p = pp & 63;
                const float cr = a.in[I_CRE][(g * GH + h) * NP + p], ci = a.in[I_CIM][(g * GH + h) * NP + p], pr = Pt1[2 * p], pi = Pt1[2 * p + 1];
                v[q] = (pp < 64) ? (cr * pr - ci * pi) : -(cr * pi + ci * pr); }
            v4u o; o.x = pk2(v[0], v[1]); o.y = pk2(v[2], v[3]); o.z = pk2(v[4], v[5]); o.w = pk2(v[6], v[7]);
            *(v4u*)(by + (size_t)(tau * 16 + h) * U2G + 512 + piece * 8) = o;
        } else {
            const int u = t - 256, n = u >> 1, half = u & 1, p = n & 63; float v[8];
#pragma unroll
            for (int q = 0; q < 8; ++q) { const int h = half * 8 + q; const float pr = Ps[2 * p], pi = Ps[2 * p + 1], br = Bb[(p * 16 + h) * 2], bi = Bb[(p * 16 + h) * 2 + 1];
                v[q] = (n < 64) ? (pr * br - pi * bi) : (pr * bi + pi * br); }
            v4u o; o.x = pk2(v[0], v[1]); o.y = pk2(v[2], v[3]); o.z = pk2(v[4], v[5]); o.w = pk2(v[6], v[7]);
            bf16* bs = BTS + (size_t)g * 256 * 512;
            *(v4u*)(bs + (size_t)n * 512 + tau * 16 + half * 8) = o;
            *(v4u*)(bs + (size_t)(128 + n) * 512 + tau * 16 + half * 8) = (v4u){0u, 0u, 0u, 0u};
        }
        __syncthreads();
    }
}

using pg8::Unit; using pg8::cvt_pk_bf16;
struct EpiInProj {
    static constexpr bool PERM = true;
    bf16* U2; bf16* Z;
    __device__ __forceinline__ void operator()(const f32x4 (&acc)[2][2][4][2], const Unit& u, int wr, int wc, int fr, int fq) const {
#pragma unroll
        for (int ai = 0; ai < 2; ++ai)
#pragma unroll
            for (int m = 0; m < 4; ++m) {
                const int tok = u.pm * 256 + ai * 128 + wr * 64 + m * 16 + fr;
                if (u.pn < 2) {
                    const int b = tok >> 13, l = tok & 8191;
                    bf16* rowp = U2 + (size_t)(b * NCH + (l >> 5)) * U2LD + (l & 31) * 16;
#pragma unroll
                    for (int bj = 0; bj < 2; ++bj) { const int c0 = u.pn * 256 + bj * 128 + wc * 32 + 8 * fq; const f32x4 v0 = acc[ai][bj][m][0], v1 = acc[ai][bj][m][1];
                        v4u w; w.x = cvt_pk_bf16(v0[0], v0[1]); w.y = cvt_pk_bf16(v0[2], v0[3]); w.z = cvt_pk_bf16(v1[0], v1[1]); w.w = cvt_pk_bf16(v1[2], v1[3]);
                        *(v4u*)(rowp + (c0 >> 4) * U2G + (c0 & 15)) = w; }
                } else {
                    const int j0 = (u.pn - 2) * 128 + wc * 32 + 8 * fq;
                    const f32x4 a0 = acc[ai][0][m][0], a1 = acc[ai][0][m][1], g0 = acc[ai][1][m][0], g1 = acc[ai][1][m][1];
                    v4u w; w.x = cvt_pk_bf16(a0[0] * sigmoidf_(g0[0]), a0[1] * sigmoidf_(g0[1])); w.y = cvt_pk_bf16(a0[2] * sigmoidf_(g0[2]), a0[3] * sigmoidf_(g0[3]));
                    w.z = cvt_pk_bf16(a1[0] * sigmoidf_(g1[0]), a1[1] * sigmoidf_(g1[1])); w.w = cvt_pk_bf16(a1[2] * sigmoidf_(g1[2]), a1[3] * sigmoidf_(g1[3]));
                    *(v4u*)(Z + (size_t)tok * DCONV + j0) = w;
                }
            }
    }
};
struct EpiGlu {
    static constexpr bool PERM = true;
    const bf16* YG; bf16* MRG; const float* bias;
    __device__ __forceinline__ void operator()(const f32x4 (&acc)[2][2][4][2], const Unit& u, int wr, int wc, int fr, int fq) const {
#pragma unroll
        for (int bj = 0; bj < 2; ++bj) {
            const int c0 = u.pn * 256 + bj * 128 + wc * 32 + 8 * fq;
            const f32x4 b0 = *(const f32x4*)(bias + c0), b1 = *(const f32x4*)(bias + c0 + 4);
#pragma unroll
            for (int ai = 0; ai < 2; ++ai)
#pragma unroll
                for (int m = 0; m < 4; ++m) {
                    const int tok = u.pm * 256 + ai * 128 + wr * 64 + m * 16 + fr;
                    float y[8]; unpack8(*(const v4u*)(YG + (size_t)tok * DSSM + c0), y);
                    const f32x4 v0 = acc[ai][bj][m][0] + b0, v1 = acc[ai][bj][m][1] + b1;
                    v4u w; w.x = cvt_pk_bf16(y[0] * sigmoidf_(v0[0]), y[1] * sigmoidf_(v0[1])); w.y = cvt_pk_bf16(y[2] * sigmoidf_(v0[2]), y[3] * sigmoidf_(v0[3]));
                    w.z = cvt_pk_bf16(y[4] * sigmoidf_(v1[0]), y[5] * sigmoidf_(v1[1])); w.w = cvt_pk_bf16(y[6] * sigmoidf_(v1[2]), y[7] * sigmoidf_(v1[3]));
                    *(v4u*)(MRG + (size_t)tok * D + c0) = w;
                }
        }
    }
};
struct EpiOut {
    static constexpr bool PERM = false;
    const float* x; float* out; const float* mod;
    __device__ __forceinline__ void operator()(const f32x4 (&acc)[2][2][4][2], const Unit& u, int wr, int wc, int fr, int fq) const {
        const int b = (u.pm * 256) >> 13;
#pragma unroll
        for (int bj = 0; bj < 2; ++bj)
#pragma unroll
            for (int n = 0; n < 2; ++n) {
                const int c0 = u.pn * 256 + bj * 128 + wc * 32 + n * 16 + 4 * fq;
                const f32x4 g1 = *(const f32x4*)(mod + b * 6 * D + 2 * D + c0);
#pragma unroll
                for (int ai = 0; ai < 2; ++ai)
#pragma unroll
                    for (int m = 0; m < 4; ++m) {
                        const size_t off = (size_t)(u.pm * 256 + ai * 128 + wr * 64 + m * 16 + fr) * D + c0;
                        *(f32x4*)(out + off) = *(const f32x4*)(x + off) + g1 * acc[ai][bj][m][n];
                    }
            }
    }
};

__device__ __forceinline__ void p2_fast(const Args& a, LAS unsigned char* lds) {
    pg8::SchedDense S; S.init((const bf16*)(a.ws + WS_H1), (const bf16*)(a.ws + WS_WIN), NTOK, DIN, D, D, D, gridDim.x, blockIdx.x);
    EpiInProj E{(bf16*)(a.ws + WS_U2), (bf16*)(a.ws + WS_Z)};
    pg8::gemm_phase<EpiInProj, pg8::SchedDense, true>(lds, S, E);
}
__device__ __forceinline__ void p3d_fast(const Args& a, LAS unsigned char* lds) {
    pg8::SchedDense S; S.init((const bf16*)(a.ws + WS_YG), (const bf16*)(a.ws + WS_WGLU), NTOK, DSSM, DSSM, DSSM, DSSM, gridDim.x, blockIdx.x);
    EpiGlu E{(const bf16*)(a.ws + WS_YG), (bf16*)(a.ws + WS_MRG), a.in[I_BGLU]};
    pg8::gemm_phase<EpiGlu, pg8::SchedDense, true>(lds, S, E);
}
__device__ __forceinline__ void p4_fast(const Args& a, LAS unsigned char* lds) {
    pg8::SchedDense S; S.init((const bf16*)(a.ws + WS_MRG), (const bf16*)(a.ws + WS_WOUT), NTOK, D, D, D, D, gridDim.x, blockIdx.x);
    EpiOut E{a.in[I_X], a.out, (const float*)(a.ws + WS_MOD)};
    pg8::gemm_phase<EpiOut, pg8::SchedDense, true>(lds, S, E);
}

template <bool GATHER>
struct SchedMoE {
    const LAS int* T; const char* Abase; const bf16* Bt; const int* tokk; int K, lda, ldb, nN, G, c; size_t bstride;
    __device__ __forceinline__ bool next(int i, Unit& u) const {
        const int NT = __builtin_amdgcn_readfirstlane(T[98 + NE]); int Tt, pn;
        if ((G & 7) == 0 && ((G >> 3) % nN) == 0) {
            const int x = c & 7, j = c >> 3, rtpr = (G >> 3) / nN, Ts = (x * NT) >> 3, Te = ((x + 1) * NT) >> 3;
            pn = j / rtpr; Tt = Ts + i * rtpr + (j % rtpr); if (Tt >= Te) return false;
        } else { const int L = i * G + c; Tt = L / nN; pn = L % nN; if (Tt >= NT) return false; }
        int e = 0;
        for (int q = 1; q < NE; ++q) if (__builtin_amdgcn_readfirstlane(T[98 + q]) <= Tt) e = q;
        e = __builtin_amdgcn_readfirstlane(e);
        u.e = e; u.pn = pn; u.pm = Tt; u.slot0 = __builtin_amdgcn_readfirstlane((Tt - T[98 + e]) * 256); u.row0 = __builtin_amdgcn_readfirstlane(T[32 + e] + u.slot0);
        const int left = __builtin_amdgcn_readfirstlane(T[e] - u.slot0); u.nvalid = left < 256 ? left : 256; return true;
    }
    __device__ __forceinline__ const char* a_base(const Unit& u) const { return GATHER ? Abase : Abase + (size_t)u.row0 * lda * 2; }
    __device__ __forceinline__ const char* b_base(const Unit& u) const { return (const char*)(Bt + (size_t)u.e * bstride) + (size_t)u.pn * 256 * ldb * 2; }
    __device__ __forceinline__ void a_offsets(const Unit& u, const int (&R)[2], const int (&C)[2], unsigned (&off)[2][2]) const {
#pragma unroll
        for (int h = 0; h < 2; ++h)
#pragma unroll
            for (int i = 0; i < 2; ++i) {
                const int row = R[i] + 128 * h;
                if (GATHER) { int tok = 0; if (row < u.nvalid) tok = tokk[(size_t)u.e * CAP + u.slot0 + row] >> 2; off[h][i] = (unsigned)tok * (unsigned)(lda * 2) + (unsigned)C[i] * 2u; }
                else off[h][i] = (unsigned)(row * lda + C[i]) * 2u;
            }
    }
};
struct EpiMoe1 {
    static constexpr bool PERM = true;
    bf16* ACT; const float* bg; const float* bu;
    __device__ __forceinline__ void operator()(const f32x4 (&acc)[2][2][4][2], const Unit& u, int wr, int wc, int fr, int fq) const {
        const int f0 = u.pn * 128 + wc * 32 + 8 * fq;
        const f32x4 g0 = *(const f32x4*)(bg + u.e * FF + f0), g1 = *(const f32x4*)(bg + u.e * FF + f0 + 4), u0 = *(const f32x4*)(bu + u.e * FF + f0), u1 = *(const f32x4*)(bu + u.e * FF + f0 + 4);
#pragma unroll
        for (int ai = 0; ai < 2; ++ai)
#pragma unroll
            for (int m = 0; m < 4; ++m) {
                const int rl = ai * 128 + wr * 64 + m * 16 + fr;
                if (rl < u.nvalid) {
                    float o[8];
#pragma unroll
                    for (int n = 0; n < 2; ++n) {
                        const f32x4 gv = acc[ai][0][m][n] + (n ? g1 : g0), uv = acc[ai][1][m][n] + (n ? u1 : u0);
#pragma unroll
                        for (int q = 0; q < 4; ++q) { const float gate = fminf(gv[q], 7.0f), up = fminf(fmaxf(uv[q], -7.0f), 7.0f); o[n * 4 + q] = (up + 1.0f) * gate * sigmoidf_(1.702f * gate); }
                    }
                    v4u w; w.x = cvt_pk_bf16(o[0], o[1]); w.y = cvt_pk_bf16(o[2], o[3]); w.z = cvt_pk_bf16(o[4], o[5]); w.w = cvt_pk_bf16(o[6], o[7]);
                    *(v4u*)(ACT + (size_t)(u.row0 + rl) * FF + f0) = w;
                }
            }
    }
};
struct EpiMoe2 {
    static constexpr bool PERM = true;
    float* out; unsigned char* ws; const int* tokk; const float* bd;
    __device__ __forceinline__ void operator()(const f32x4 (&acc)[2][2][4][2], const Unit& u, int wr, int wc, int fr, int fq) const {
        const int c0 = u.pn * 256 + wc * 32 + 8 * fq;
        f32x4 bv[2][2];
#pragma unroll
        for (int bj = 0; bj < 2; ++bj)
#pragma unroll
            for (int n = 0; n < 2; ++n) bv[bj][n] = *(const f32x4*)(bd + u.e * D + c0 + bj * 128 + 4 * n);
#pragma unroll
        for (int ai = 0; ai < 2; ++ai)
#pragma unroll
            for (int m = 0; m < 4; ++m) {
                const int rl = ai * 128 + wr * 64 + m * 16 + fr;
                if (rl < u.nvalid) {
                    const int tk = tokk[(size_t)u.e * CAP + u.slot0 + rl], tok = tk >> 2, k = tk & 3;
                    bf16* dst = (k == 0) ? (bf16*)(out + (size_t)tok * D) : (k == 3) ? (bf16*)(ws + WS_YS3) + (size_t)tok * D : (bf16*)(ws + WS_YS12) + ((size_t)(k - 1) * NTOK + tok) * D;
#pragma unroll
                    for (int bj = 0; bj < 2; ++bj) { const f32x4 v0 = acc[ai][bj][m][0] + bv[bj][0], v1 = acc[ai][bj][m][1] + bv[bj][1];
                        v4u w; w.x = cvt_pk_bf16(v0[0], v0[1]); w.y = cvt_pk_bf16(v0[2], v0[3]); w.z = cvt_pk_bf16(v1[0], v1[1]); w.w = cvt_pk_bf16(v1[2], v1[3]);
                        *(v4u*)(dst + c0 + bj * 128) = w; }
                }
            }
    }
};
__device__ __forceinline__ void p7_fast(const Args& a, LAS unsigned char* lds, LAS int* T) {
    SchedMoE<true> S{T, (const char*)(a.ws + WS_H2), (const bf16*)(a.ws + WS_WGU), (const int*)(a.ws + WS_TOKK), D, D, D, 8, (int)gridDim.x, (int)blockIdx.x, (size_t)2048 * D};
    EpiMoe1 E{(bf16*)(a.ws + WS_ACT), a.in[I_BG], a.in[I_BU]};
    pg8::gemm_phase<EpiMoe1, SchedMoE<true>, true>(lds, S, E);
}
__device__ __forceinline__ void p8_fast(const Args& a, LAS unsigned char* lds, LAS int* T) {
    SchedMoE<false> S{T, (const char*)(a.ws + WS_ACT), (const bf16*)(a.ws + WS_WD), (const int*)(a.ws + WS_TOKK), FF, FF, FF, 4, (int)gridDim.x, (int)blockIdx.x, (size_t)D * FF};
    EpiMoe2 E{a.out, a.ws, (const int*)(a.ws + WS_TOKK), a.in[I_BD]};
    pg8::gemm_phase<EpiMoe2, SchedMoE<false>, true>(lds, S, E);
}

struct EpiSloc {
    static constexpr bool PERM = false;
    float* SL;
    __device__ __forceinline__ void operator()(const f32x4 (&acc)[2][2][4][2], const Unit& u, int wr, int wc, int fr, int fq) const {
#pragma unroll
        for (int ai = 0; ai < 2; ++ai)
#pragma unroll
            for (int m = 0; m < 4; ++m) {
                float* rowp = SL + (size_t)(u.pm * 256 + ai * 128 + wr * 64 + m * 16 + fr) * (NG * 128) + u.e * 128 + wc * 32 + 4 * fq;
#pragma unroll
                for (int n = 0; n < 2; ++n) *(f32x4*)(rowp + n * 16) = acc[ai][0][m][n];
            }
    }
};
struct EpiY {
    static constexpr bool PERM = true;
    bf16* YG;
    __device__ __forceinline__ void operator()(const f32x4 (&acc)[2][2][4][2], const Unit& u, int wr, int wc, int fr, int fq) const {
#pragma unroll
        for (int ai = 0; ai < 2; ++ai)
#pragma unroll
            for (int m = 0; m < 4; ++m) {
                const int r = u.pm * 256 + ai * 128 + wr * 64 + m * 16 + fr;
#pragma unroll
                for (int bj = 0; bj < 2; ++bj) {
                    const int c0 = u.pn * 256 + bj * 128 + wc * 32 + 8 * fq, t = c0 >> 4, h0 = c0 & 15;
                    const f32x4 v0 = acc[ai][bj][m][0], v1 = acc[ai][bj][m][1];
                    v4u w; w.x = cvt_pk_bf16(gelu_tanh(v0[0]), gelu_tanh(v0[1])); w.y = cvt_pk_bf16(gelu_tanh(v0[2]), gelu_tanh(v0[3]));
                    w.z = cvt_pk_bf16(gelu_tanh(v1[0]), gelu_tanh(v1[1])); w.w = cvt_pk_bf16(gelu_tanh(v1[2]), gelu_tanh(v1[3]));
                    *(v4u*)(YG + (size_t)(r * 32 + t) * DSSM + u.e * GH + h0) = w;
                }
            }
    }
};
__device__ __forceinline__ void p3a_fast(const Args& a, LAS unsigned char* lds) {
    pg8::SchedGroup S{(const bf16*)(a.ws + WS_U2), (const bf16*)(a.ws + WS_BTS), 512, U2LD, 512, NROW2 / 256, 1, NG, (int)gridDim.x, (int)blockIdx.x, (size_t)U2G, (size_t)256 * 512};
    EpiSloc E{(float*)(a.ws + WS_SLOC)};
    pg8::gemm_phase<EpiSloc, pg8::SchedGroup, true>(lds, S, E);
}
__device__ __forceinline__ void p3c_fast(const Args& a, LAS unsigned char* lds) {
    pg8::SchedGroup S{(const bf16*)(a.ws + WS_U2), (const bf16*)(a.ws + WS_BTY), U2G, U2LD, U2G, NROW2 / 256, 2, NG, (int)gridDim.x, (int)blockIdx.x, (size_t)U2G, (size_t)512 * U2G};
    EpiY E{(bf16*)(a.ws + WS_YG)};
    pg8::gemm_phase<EpiY, pg8::SchedGroup, true>(lds, S, E);
}
__device__ __forceinline__ void p3b_scan(const Args& a, LAS float* sm) {
    const float* SL = (const float*)(a.ws + WS_SLOC); bf16* U2 = (bf16*)(a.ws + WS_U2);
    const int t = threadIdx.x, p = t & 63, seg = t >> 6;
    for (int task = blockIdx.x; task < NB * NG; task += gridDim.x) {
        const int b = task / NG, g = task % NG;
        const float lr = a.in[I_LRE][g * NP + p], li = a.in[I_LIM][g * NP + p], dt = expf(a.in[I_LDT][g]);
        float ar, ai, br, bi;
        { const float m = expf(32.f * lr * dt); float s2, c2; sincosf(32.f * li * dt, &s2, &c2); ar = m * c2; ai = m * s2; }
        { const float m = expf(1024.f * lr * dt); float s2, c2; sincosf(1024.f * li * dt, &s2, &c2); br = m * c2; bi = m * s2; }
        const float* sl = SL + (size_t)(b * NCH + seg * 32) * (NG * 128) + g * 128 + p;
        float sr = 0.f, si = 0.f;
#pragma unroll 8
        for (int c = 0; c < 32; ++c) { const float lre = sl[(size_t)c * (NG * 128)], lim = sl[(size_t)c * (NG * 128) + 64]; const float nr = ar * sr - ai * si + lre, ni = ar * si + ai * sr + lim; sr = nr; si = ni; }
        sm[(seg * 64 + p) * 2] = sr; sm[(seg * 64 + p) * 2 + 1] = si;
        __syncthreads();
        float cr = 0.f, ci = 0.f;
        for (int s = 0; s < seg; ++s) { const float er = sm[(s * 64 + p) * 2], ei = sm[(s * 64 + p) * 2 + 1]; const float nr = br * cr - bi * ci + er, ni = br * ci + bi * cr + ei; cr = nr; ci = ni; }
        bf16* up = U2 + (size_t)(b * NCH + seg * 32) * U2LD + g * U2G + 512 + p;
        sr = cr; si = ci;
#pragma unroll 8
        for (int c = 0; c < 32; ++c) {
            up[(size_t)c * U2LD] = (bf16)f2bf(sr); up[(size_t)c * U2LD + 64] = (bf16)f2bf(si);
            const float lre = sl[(size_t)c * (NG * 128)], lim = sl[(size_t)c * (NG * 128) + 64]; const float nr = ar * sr - ai * si + lre, ni = ar * si + ai * sr + lim; sr = nr; si = ni;
        }
        __syncthreads();
    }
}

__device__ __forceinline__ void p9_debug(const Args& a, int gw, int ngw, int lane, const float* src) {
    const float* fg = a.in[I_FG];
    for (int tok = gw; tok < NTOK; tok += ngw) {
        const f32x4* xr = (const f32x4*)(src + (size_t)tok * D) + lane;
        f32x4 v[4]; float s = 0.f;
#pragma unroll
        for (int j = 0; j < 4; ++j) { v[j] = xr[64 * j]; s += (v[j].x * v[j].x + v[j].y * v[j].y) + (v[j].z * v[j].z + v[j].w * v[j].w); }
        const float rstd = rsqrtf(wave_sum(s) * (1.f / D) + 1e-6f);
        f32x4* o = (f32x4*)(a.out + (size_t)tok * D) + lane;
#pragma unroll
        for (int j = 0; j < 4; ++j) { const f32x4 g = *(const f32x4*)(fg + 4 * lane + 256 * j); o[64 * j] = v[j] * rstd * g; }
    }
}

constexpr int NPHASE = 13;
__global__ void __launch_bounds__(NTHR, 2) fwd_kernel(Args a) {
    extern __shared__ __attribute__((aligned(16))) unsigned char lds_raw[];
    LAS unsigned char* lds = (LAS unsigned char*)lds_raw;
    LAS float* sm = (LAS float*)lds;
    LAS int* T = (LAS int*)(lds + 131072);
    cg::grid_group grid = cg::this_grid();
    const int tid = threadIdx.x, lane = tid & 63, wave = __builtin_amdgcn_readfirstlane(tid >> 6);
    const int gw = blockIdx.x * NWAVES + wave, ngw = gridDim.x * NWAVES;
    const int lo = a.ph_lo, hi = a.ph_hi;
#define IN(k) (lo <= (k) && (k) < hi)
#define SEAM(k) do { if (IN(k) && IN((k) + 1)) grid.sync(); } while (0)
    if (IN(0)) { p0_mod(a, sm); p0_s5_mats(a, sm); __syncthreads(); p0_convert(a, lds, gw, ngw, lane, wave); } SEAM(0);
    if (IN(1)) { p1_h1(a, gw, ngw, lane); } SEAM(1);
#if FAST_P2
    if (IN(2)) { p2_fast(a, lds); } SEAM(2);
#else
    if (IN(2)) { p2_slow(a, sm); } SEAM(2);
#endif
#if FAST_S5
    if (IN(3)) { p3a_fast(a, lds); } SEAM(3);
    if (IN(4)) { p3b_scan(a, sm); } SEAM(4);
    if (IN(5)) { p3c_fast(a, lds); } SEAM(5);
#else
    if (IN(3)) { p3_slow_s5(a, gw, ngw, lane); } SEAM(3);
    SEAM(4);
    SEAM(5);
#endif
#if FAST_P3D
    if (IN(6)) { p3d_fast(a, lds); } SEAM(6);
#else
    if (IN(6)) { p3d_slow(a, sm); } SEAM(6);
#endif
    if (IN(7)) { p3e_conv_norm(a, gw, ngw, lane); } SEAM(7);
#if FAST_P4
    if (IN(8)) { p4_fast(a, lds); } SEAM(8);
#else
    if (IN(8)) { p4_slow(a, sm); } SEAM(8);
#endif
#if !defined(DEBUG_MODE)
    if (IN(9)) { p5_slow(a, lds, gw, ngw, lane, wave); } SEAM(9);
#if FAST_MOE == 1
    if (IN(10)) { moe_tables(a, T); p7_fast(a, lds, T); } SEAM(10);
    if (IN(11)) { moe_tables(a, T); p8_fast(a, lds, T); } SEAM(11);
#elif FAST_MOE == 2
    if (IN(10)) { moe_tables(a, T); p7_fast(a, lds, T); } SEAM(10);
    if (IN(11)) { moe_tables(a, T); p8_slow(a, sm, T); } SEAM(11);
#elif FAST_MOE == 3
    if (IN(10)) { moe_tables(a, T); p7_slow(a, sm, T); } SEAM(10);
    if (IN(11)) { moe_tables(a, T); p8_fast(a, lds, T); } SEAM(11);
#else
    if (IN(10)) { moe_tables(a, T); p7_slow(a, sm, T); } SEAM(10);
    if (IN(11)) { moe_tables(a, T); p8_slow(a, sm, T); } SEAM(11);
#endif
    if (IN(12)) { p9_final(a, gw, ngw, lane); }
#elif DEBUG_MODE == 3
    if (IN(9)) { p5_slow(a, lds, gw, ngw, lane, wave); } SEAM(9);
    SEAM(10); SEAM(11);
    if (IN(12)) { p9_final(a, gw, ngw, lane); }
#else
    SEAM(9); SEAM(10); SEAM(11);
    if (IN(12)) { p9_debug(a, gw, ngw, lane, DEBUG_MODE == 1 ? a.in[I_X] : a.out); }
#endif
#undef IN
#undef SEAM
}

#ifndef N_LAUNCHES
#define N_LAUNCHES 1
#endif
extern "C" void kernel_launch(void* const* d_in, const int* in_sizes, int n_in, void* d_out, int out_size, void* d_ws, size_t ws_size, hipStream_t stream) {
    static int grid = 0;
    if (grid == 0) {
        if (n_in != 32 || out_size != NTOK * D || ws_size < WS_END) { fprintf(stderr, "kernel_launch: unexpected problem (n_in %d out %d ws %zu)\n", n_in, out_size, ws_size); grid = -1; return; }
        int dev = 0, cus = 0, per_cu = 0;
        if (hipGetDevice(&dev) != hipSuccess || hipDeviceGetAttribute(&cus, hipDeviceAttributeMultiprocessorCount, dev) != hipSuccess) { grid = -1; return; }
        if (hipFuncSetAttribute((const void*)fwd_kernel, hipFuncAttributeMaxDynamicSharedMemorySize, LDS_BYTES) != hipSuccess) { fprintf(stderr, "kernel_launch: hipFuncSetAttribute failed\n"); grid = -1; return; }
        if (hipOccupancyMaxActiveBlocksPerMultiprocessor(&per_cu, (const void*)fwd_kernel, NTHR, LDS_BYTES) != hipSuccess || per_cu < 1) { fprintf(stderr, "kernel_launch: occupancy query says %d\n", per_cu); (void)hipGetLastError(); per_cu = 1; }
        grid = cus;
    }
    if (grid < 0) return;
    (void)hipMemsetAsync((char*)d_ws + WS_CTL, 0, 65536, stream);
    Args a{};
    for (int i = 0; i < 32; ++i) a.in[i] = (const float*)d_in[i];
    a.out = (float*)d_out; a.ws = (unsigned char*)d_ws;
    for (int li = 0; li < N_LAUNCHES; ++li) {
        a.ph_lo = (N_LAUNCHES == 1) ? 0 : li; a.ph_hi = (N_LAUNCHES == 1) ? NPHASE : li + 1;
        if (N_LAUNCHES != 1 && (li == 4 || li == 5)) continue;
        void* args[] = {&a};
        hipError_t e = hipLaunchCooperativeKernel((const void*)fwd_kernel, dim3(grid), dim3(NTHR), args, LDS_BYTES, stream);
        if (e != hipSuccess) { fprintf(stderr, "kernel_launch: launch %d failed: %s\n", li, hipGetErrorString(e)); break; }
    }
}
```

```cpp
#include <hip/hip_runtime.h>
#include <hip/hip_cooperative_groups.h>
#include <cstdio>
#include <cstdint>
namespace cg = cooperative_groups;
#define MOE2_WIDE (MOE2_F8 && YS_F8)
#define MOE1_WIDE (MOE1_F8 && MOE2_F8)
#ifndef USE_CG_SYNC
#define USE_CG_SYNC 0
#endif
#ifndef YS_F8
#define YS_F8 1
#endif
#ifndef MOE2_F8
#define MOE2_F8 1
#endif
#ifndef MOE1_F8
#define MOE1_F8 1
#endif
#ifndef TIME_PHASE
#define TIME_PHASE -1
#endif
#ifndef TIME_A
#define TIME_A (TIME_PHASE)
#define TIME_B (TIME_PHASE + 1)
#endif
#ifndef ALIGN_P4
#define ALIGN_P4 true
#endif
#ifndef ALIGN_MOE
#define ALIGN_MOE true
#endif
#ifndef TSTAMP_GEMM
#define TSTAMP_GEMM 0
#endif
#ifndef REP_EPI
#define REP_EPI 0
#endif
#ifndef REP_GEMM
#define REP_GEMM 0
#endif
#ifndef REP_MASK
#define REP_MASK 0
#endif

#define GAS __attribute__((address_space(1)))
#define LAS __attribute__((address_space(3)))
typedef unsigned short bf16;
typedef unsigned v4u __attribute__((ext_vector_type(4)));
typedef unsigned v2u __attribute__((ext_vector_type(2)));
typedef float f32x4 __attribute__((ext_vector_type(4)));
typedef float f32x2 __attribute__((ext_vector_type(2)));
typedef short bf16x8 __attribute__((ext_vector_type(8)));

constexpr int NB = 4, SEQ = 8192, D = 1024, NTOK = NB * SEQ;
constexpr int DSSM = 512, DCONV = 512, NG = 32, GH = 16, NP = 64, DIN = 1536, CW = 31;
constexpr int NE = 32, TOPK = 4, FF = 1024;
constexpr int TCH = 32, NCH = SEQ / TCH, NROW2 = NB * NCH, U2G = 640, U2LD = NG * U2G;
constexpr int NWAVES = 8, NTHR = 512;
constexpr int LDS_BYTES = 147456;
constexpr int CAP = NTOK;

enum { I_X = 0, I_C, I_ADAW, I_ADAB, I_N1G, I_WIN, I_LRE, I_LIM, I_LDT, I_BRE, I_BIM, I_CRE, I_CIM, I_DSK, I_WGLU, I_BGLU, I_CONVW, I_CONVB, I_LNG, I_LNB,
       I_ONG, I_WOUT, I_N2G, I_RW, I_RB, I_WG, I_BG, I_WU, I_BU, I_WD, I_BD, I_FG };

constexpr size_t MiB = 1u << 20;
constexpr size_t WS_WIN = 0 * MiB;
constexpr size_t WS_WGLU = 3 * MiB;
constexpr size_t WS_WOUT = 4 * MiB;
constexpr size_t WS_BTS = 6 * MiB;
constexpr size_t WS_BTY = 14 * MiB;
constexpr size_t WS_H2 = 0 * MiB;
constexpr size_t WS_YS3 = 0 * MiB;
constexpr size_t WS_CTL = 64 * MiB;
constexpr size_t WS_MOD = 64 * MiB + 65536;
constexpr size_t WS_TOPW = 65 * MiB;
constexpr size_t WS_TOKK = 66 * MiB;
constexpr size_t WS_RWT = 70 * MiB;
constexpr size_t WS_ACT = 72 * MiB;
constexpr size_t WS_SSQ = 72 * MiB;
constexpr size_t WS_H1 = 72 * MiB;
constexpr size_t WS_U2 = 136 * MiB;
constexpr size_t WS_Z = 176 * MiB;
constexpr size_t WS_SLOC = 208 * MiB;
constexpr size_t WS_YG = 224 * MiB;
constexpr size_t WS_MRG = 256 * MiB;
constexpr size_t WS_WD = 328 * MiB;
constexpr size_t WS_WGU = 392 * MiB;
constexpr size_t WS_YS12 = 392 * MiB;
constexpr size_t WS_END = 520 * MiB;
constexpr int CW_CNT = 0, CW_CONV = 64  , CW_MOD = 640, CW_P1 = 4608  , CW_CONVW = 5120  , CW_BAR = 1024;

struct Args { const float* in[32]; float* out; unsigned char* ws; int ph_lo, ph_hi, rep_mask, pad; };

__device__ __forceinline__ float bf2f(unsigned v) { return __builtin_bit_cast(float, v << 16); }
__device__ __forceinline__ unsigned f2bf(float f) { unsigned u = __builtin_bit_cast(unsigned, f); return (u + 0x7fffu + ((u >> 16) & 1u)) >> 16; }
__device__ __forceinline__ unsigned pk2(float lo, float hi) { unsigned r; asm("v_cvt_pk_bf16_f32 %0, %1, %2" : "=v"(r) : "v"(lo), "v"(hi)); return r; }
__device__ __forceinline__ float bflo(unsigned w) { return __builtin_bit_cast(float, w << 16); }
__device__ __forceinline__ float bfhi(unsigned w) { return __builtin_bit_cast(float, w & 0xffff0000u); }
__device__ __forceinline__ float sigmoidf_(float x) { return __builtin_amdgcn_rcpf(1.0f + __expf(-x)); }
__device__ __forceinline__ float siluf_(float x) { return x * sigmoidf_(x); }
__device__ __forceinline__ float gelu_tanh(float x) { const float u = 0.7978845608028654f * (x + 0.044715f * x * x * x); return x * sigmoidf_(2.0f * u); }
__device__ __forceinline__ f32x2 sig2(const f32x2 x, const float k  ) {
    const f32x2 t = x * k; f32x2 e; e.x = __builtin_amdgcn_exp2f(t.x); e.y = __builtin_amdgcn_exp2f(t.y);
    const f32x2 d = e + 1.0f; f32x2 r; r.x = __builtin_amdgcn_rcpf(d.x); r.y = __builtin_amdgcn_rcpf(d.y); return r; }
__device__ __forceinline__ f32x2 gelu2(const f32x2 x) {
    const f32x2 p = (x * x) * 0.044715f + 1.0f; return x * sig2(x * p, -1.4426950408889634f * 2.0f * 0.7978845608028654f); }
#define WS_DPP(v, ctrl, rmask) ((v) + __builtin_bit_cast(float, __builtin_amdgcn_update_dpp(0, __builtin_bit_cast(int, (v)), (ctrl), (rmask), 0xf, false)))
__device__ __forceinline__ float wave_sum(float v) {
    v = WS_DPP(v, 0x128, 0xf);
    v = WS_DPP(v, 0x124, 0xf);
    v = WS_DPP(v, 0x122, 0xf);
    v = WS_DPP(v, 0x121, 0xf);
    v = WS_DPP(v, 0x142, 0xa);
    v = WS_DPP(v, 0x143, 0xc);
    return __builtin_bit_cast(float, __builtin_amdgcn_readlane(__builtin_bit_cast(int, v), 63));
}
#define LDS_WAIT() asm volatile("s_waitcnt lgkmcnt(0)" ::: "memory")
#ifndef TIME_PHASE
#define TIME_PHASE -1
#endif
#if TIME_PHASE >= 0
extern __shared__ __attribute__((aligned(16))) unsigned char lds_raw_ts[];
#define STAMP(k) do { if (threadIdx.x == 0) ((LAS unsigned long long*)((LAS unsigned char*)lds_raw_ts + 131072 + 4096))[k] = __builtin_amdgcn_s_memrealtime(); } while (0)
#else
#define STAMP(k) do { } while (0)
#endif

__device__ __forceinline__ void p0_mod(const Args& a, LAS float* sm) {
    const float* c = a.in[I_C]; const float* W = a.in[I_ADAW]; const float* bias = a.in[I_ADAB];
    float* mod = (float*)(a.ws + WS_MOD);
    const int t = threadIdx.x, cl = t & 31, kq = t >> 5;
    if (blockIdx.x >= 192) return;
    LAS float* sc = sm + 2048;
    for (int i = t; i < NB * D; i += NTHR) sc[i] = siluf_(c[i]);
    __syncthreads();
    for (int item = blockIdx.x; item < 192; item += gridDim.x) {
        const int col = item * 32 + cl;
        float a0 = 0.f, a1 = 0.f, a2 = 0.f, a3 = 0.f;
#pragma unroll 16
        for (int k = kq; k < D; k += 16) {
            const float w = W[(size_t)k * (6 * D) + col];
            a0 += sc[k] * w; a1 += sc[D + k] * w; a2 += sc[2 * D + k] * w; a3 += sc[3 * D + k] * w;
        }
        sm[(kq * 32 + cl) * 4 + 0] = a0; sm[(kq * 32 + cl) * 4 + 1] = a1; sm[(kq * 32 + cl) * 4 + 2] = a2; sm[(kq * 32 + cl) * 4 + 3] = a3;
        __syncthreads();
        if (t < 128) { const int b = t >> 5; float s = 0.f;
#pragma unroll
            for (int q = 0; q < 16; ++q) s += sm[(q * 32 + cl) * 4 + b];
            mod[b * 6 * D + col] = s + bias[col]; }
        __syncthreads();
        if (t == 0) {
            __builtin_amdgcn_fence(__ATOMIC_RELEASE, "agent"); asm volatile("s_waitcnt vmcnt(0)" ::: "memory");
            __hip_atomic_fetch_add((unsigned*)(a.ws + WS_CTL) + CW_MOD, 1u, __ATOMIC_RELAXED, __HIP_MEMORY_SCOPE_AGENT);
        }
    }
}
__device__ __forceinline__ void mod_wait(const Args& a) {
    if (threadIdx.x == 0) {
        unsigned* f = (unsigned*)(a.ws + WS_CTL) + CW_MOD; unsigned sp = 0;
        while (__hip_atomic_load(f, __ATOMIC_RELAXED, __HIP_MEMORY_SCOPE_AGENT) < 192u) { __builtin_amdgcn_s_sleep(2); if (++sp > (1u << 24)) break; }
        __builtin_amdgcn_fence(__ATOMIC_ACQUIRE, "agent"); asm volatile("s_waitcnt vmcnt(0)" ::: "memory");
    }
    __syncthreads();
}

__device__ __forceinline__ void p1_router_item(const Args& a, int it, int lane);
__device__ __forceinline__ void p1_dynamic(const Args& a, int lane) {
    const float* x = a.in[I_X]; const float* g = a.in[I_N1G]; const float* mod = (const float*)(a.ws + WS_MOD); bf16* h1 = (bf16*)(a.ws + WS_H1);
    constexpr int NIT = NB * NE + NTOK / 4;
    const int xq = blockIdx.x & 7, lo = (int)(((long)NIT * xq) >> 3), hi = (int)(((long)NIT * (xq + 1)) >> 3);
    unsigned* ctr = (unsigned*)(a.ws + WS_CTL) + CW_P1 + 64 * xq;
    for (;;) {
        int it0 = 0; if (lane == 0) it0 = (int)atomicAdd(ctr, 2u); it0 = __builtin_amdgcn_readfirstlane(it0) + lo;
        if (it0 >= hi) break;
#pragma unroll 1
        for (int it = it0; it < it0 + 2 && it < hi; ++it) {
        if (it < NB * NE) { p1_router_item(a, it, lane); continue; }
        const int m0 = (it - NB * NE) * 4;
        f32x4 v[4][4];
#pragma unroll
        for (int u = 0; u < 4; ++u)
#pragma unroll
            for (int j = 0; j < 4; ++j) v[u][j] = __builtin_nontemporal_load((const f32x4*)(x + (size_t)(m0 + u) * D) + lane + 64 * j);
#pragma unroll
        for (int u = 0; u < 4; ++u) {
            const int m = m0 + u, b = m >> 13; float s = 0.f;
#pragma unroll
            for (int j = 0; j < 4; ++j) s += (v[u][j].x * v[u][j].x + v[u][j].y * v[u][j].y) + (v[u][j].z * v[u][j].z + v[u][j].w * v[u][j].w);
            const float rstd = rsqrtf(wave_sum(s) * (1.f / D) + 1e-6f);
            unsigned long long* o8 = (unsigned long long*)(h1 + (size_t)m * D) + lane;
#pragma unroll
            for (int j = 0; j < 4; ++j) {
                const int k = 4 * lane + 256 * j;
                const f32x4 gg = *(const f32x4*)(g + k), sh = *(const f32x4*)(mod + b * 6 * D + k), sc = *(const f32x4*)(mod + b * 6 * D + D + k);
                const f32x4 h = v[u][j] * rstd * gg * (sc + 1.0f) + sh;
                o8[64 * j] = (unsigned long long)pk2(h.x, h.y) | ((unsigned long long)pk2(h.z, h.w) << 32);
            }
        }
        }
    }
}

__device__ __forceinline__ void unpack8(const v4u w, float (&f)[8]) {
    f[0] = bflo(w.x); f[1] = bfhi(w.x); f[2] = bflo(w.y); f[3] = bfhi(w.y); f[4] = bflo(w.z); f[5] = bfhi(w.z); f[6] = bflo(w.w); f[7] = bfhi(w.w);
}
__device__ __forceinline__ void p3e_conv(const Args& a, LAS float* sm, int lane) {
    constexpr int CT = 4;
    for (int i = threadIdx.x; i < CW * DCONV / 4; i += NTHR) { const int w = i >> 7, c4 = i & 127, ln = c4 >> 1, hf = c4 & 1;
        *(LAS f32x4*)(sm + ((w * 2 + hf) * 64 + ln) * 4) = *(const f32x4*)(a.in[I_CONVW] + w * DCONV + c4 * 4); }
    __syncthreads();
    const bf16* Z = (const bf16*)(a.ws + WS_Z); bf16* MRG = (bf16*)(a.ws + WS_MRG);
    const float* cw = a.in[I_CONVW]; const float* cb = a.in[I_CONVB]; const float* lng = a.in[I_LNG]; const float* lnb = a.in[I_LNB]; const float* ong = a.in[I_ONG];
    const int ch = lane * 8;
    const int xq = blockIdx.x & 7, ilo = (int)(((long)(NTOK / CT) * xq) >> 3), ihi = (int)(((long)(NTOK / CT) * (xq + 1)) >> 3);
    unsigned* ctr = (unsigned*)(a.ws + WS_CTL) + CW_CONVW + 64 * xq;
    for (;;) {
      int it0 = 0; if (lane == 0) it0 = (int)atomicAdd(ctr, 4u); it0 = __builtin_amdgcn_readfirstlane(it0) + ilo;
      if (it0 >= ihi) break;
#pragma unroll 1
      for (int it = it0; it < it0 + 4 && it < ihi; ++it) {
        const int t0 = it * CT, l0 = t0 & (SEQ - 1);
        int chw = ch; asm volatile("" : "+v"(chw));
        const unsigned zo = (unsigned)(((t0 - (CW - 1)) * DCONV + chw) * 2), wo = (unsigned)(chw * 4);
#define ZROW(j) (*(const v4u*)((const char*)Z + (unsigned)(zo + (unsigned)(j) * (DCONV * 2))))
#define WROW(w, q) (*(const LAS f32x4*)(sm + (((w) * 2 + (q)) * 64 + lane) * 4))
        f32x2 acc[CT][4];
        { const f32x4 b0 = *(const f32x4*)(cb + chw), b1 = *(const f32x4*)(cb + chw + 4);
#pragma unroll
          for (int i = 0; i < CT; ++i) { acc[i][0] = (f32x2){b0.x, b0.y}; acc[i][1] = (f32x2){b0.z, b0.w}; acc[i][2] = (f32x2){b1.x, b1.y}; acc[i][3] = (f32x2){b1.z, b1.w}; } }
        f32x2 act[CT][4]; v4u ring[8];
#pragma unroll
        for (int j = 0; j < CT + 8; ++j) { v4u r = (v4u){0u, 0u, 0u, 0u}; if (l0 - (CW - 1) + j >= 0) r = ZROW(j);
            if (j < CT) { act[j][0] = (f32x2){bflo(r.x), bfhi(r.x)}; act[j][1] = (f32x2){bflo(r.y), bfhi(r.y)}; act[j][2] = (f32x2){bflo(r.z), bfhi(r.z)}; act[j][3] = (f32x2){bflo(r.w), bfhi(r.w)}; } else ring[(j - CT) & 7] = r; }
#pragma nounroll
        for (int wq = 0; wq < 4; ++wq) {
#pragma unroll
            for (int r = 0; r < 8; ++r) {
                const int w = wq * 8 + r;
                if (w < CW) {
                    const f32x4 w0 = WROW(w, 0), w1 = WROW(w, 1);
                    const f32x2 wv[4] = {(f32x2){w0.x, w0.y}, (f32x2){w0.z, w0.w}, (f32x2){w1.x, w1.y}, (f32x2){w1.z, w1.w}};
#pragma unroll
                    for (int i = 0; i < CT; ++i) {
#pragma unroll
                        for (int c = 0; c < 4; ++c) acc[i][c] += act[(r + i) % CT][c] * wv[c];
                    }
                    if (w < CW - 1) {
                        const v4u rr = ring[r];
                        act[r % CT][0] = (f32x2){bflo(rr.x), bfhi(rr.x)}; act[r % CT][1] = (f32x2){bflo(rr.y), bfhi(rr.y)}; act[r % CT][2] = (f32x2){bflo(rr.z), bfhi(rr.z)}; act[r % CT][3] = (f32x2){bflo(rr.w), bfhi(rr.w)};
                        if (w + 8 < CW - 1) { const int j = w + CT + 8; ring[r] = (v4u){0u, 0u, 0u, 0u}; if (l0 - (CW - 1) + j >= 0) ring[r] = ZROW(j); }
                    }
                }
            }
        }
#undef ZROW
#undef WROW
        const f32x4 g0 = *(const f32x4*)(lng + chw), g1 = *(const f32x4*)(lng + chw + 4), be0 = *(const f32x4*)(lnb + chw), be1 = *(const f32x4*)(lnb + chw + 4);
        const f32x4 o0 = *(const f32x4*)(ong + DSSM + chw), o1 = *(const f32x4*)(ong + DSSM + chw + 4);
        const float gv[8] = {g0.x, g0.y, g0.z, g0.w, g1.x, g1.y, g1.z, g1.w}, bv[8] = {be0.x, be0.y, be0.z, be0.w, be1.x, be1.y, be1.z, be1.w};
        const float ov[8] = {o0.x, o0.y, o0.z, o0.w, o1.x, o1.y, o1.z, o1.w};
        float mean[CT], rstd[CT];
        { float s[CT];
#pragma unroll
          for (int i = 0; i < CT; ++i) { const f32x2 t = (acc[i][0] + acc[i][1]) + (acc[i][2] + acc[i][3]); s[i] = t.x + t.y; }
#pragma unroll
          for (int i = 0; i < CT; ++i) s[i] = wave_sum(s[i]);
#pragma unroll
          for (int i = 0; i < CT; ++i) mean[i] = s[i] * (1.f / DCONV);
          float q[CT];
#pragma unroll
          for (int i = 0; i < CT; ++i) { f32x2 t = {0.f, 0.f};
#pragma unroll
              for (int c = 0; c < 4; ++c) { const f32x2 d = acc[i][c] - mean[i]; t += d * d; }
              q[i] = t.x + t.y; }
#pragma unroll
          for (int i = 0; i < CT; ++i) q[i] = wave_sum(q[i]);
#pragma unroll
          for (int i = 0; i < CT; ++i) rstd[i] = rsqrtf(q[i] * (1.f / DCONV) + 1e-5f); }
        float ss[CT];
#pragma unroll
        for (int i = 0; i < CT; ++i) { f32x2 t = {0.f, 0.f};
#pragma unroll
            for (int c = 0; c < 4; ++c) { f32x2 v = (acc[i][c] - mean[i]) * rstd[i] * (f32x2){gv[2 * c], gv[2 * c + 1]} + (f32x2){bv[2 * c], bv[2 * c + 1]}; v.x = siluf_(v.x); v.y = siluf_(v.y); acc[i][c] = v; t += v * v; }
            ss[i] = t.x + t.y; }
#pragma unroll
        for (int i = 0; i < CT; ++i) ss[i] = wave_sum(ss[i]);
#pragma unroll
        for (int i = 0; i < CT; ++i) {
            const float r2 = rsqrtf(ss[i] * (1.f / DCONV) + 1e-6f);
            v4u o; o.x = pk2(acc[i][0].x * r2 * ov[0], acc[i][0].y * r2 * ov[1]); o.y = pk2(acc[i][1].x * r2 * ov[2], acc[i][1].y * r2 * ov[3]);
            o.z = pk2(acc[i][2].x * r2 * ov[4], acc[i][2].y * r2 * ov[5]); o.w = pk2(acc[i][3].x * r2 * ov[6], acc[i][3].y * r2 * ov[7]);
            *(v4u*)(MRG + (size_t)(t0 + i) * D + DSSM + chw) = o;
        }
      }
    }
}
__device__ __forceinline__ void p3e_norm(const Args& a, int gw, int ngw, int lane) {
    bf16* MRG = (bf16*)(a.ws + WS_MRG); const float* ong = a.in[I_ONG]; const int ch = lane * 8;
    const f32x4 o0 = *(const f32x4*)(ong + ch), o1 = *(const f32x4*)(ong + ch + 4);
    const float ov[8] = {o0.x, o0.y, o0.z, o0.w, o1.x, o1.y, o1.z, o1.w};
    v4u r[8];
#pragma unroll
    for (int u = 0; u < 8; ++u) { const int m = (gw + u * ngw < NTOK) ? gw + u * ngw : gw; r[u] = *(const v4u*)(MRG + (size_t)m * D + ch); }
    for (int m0 = gw; m0 < NTOK; m0 += 8 * ngw) {
        v4u c[8];
#pragma unroll
        for (int u = 0; u < 8; ++u) c[u] = r[u];
#pragma unroll
        for (int u = 0; u < 8; ++u) { const int mn = m0 + (8 + u) * ngw, m = (mn < NTOK) ? mn : gw; r[u] = *(const v4u*)(MRG + (size_t)m * D + ch); }
        asm volatile("" ::: "memory");
#pragma unroll
        for (int u = 0; u < 8; ++u) {
            const int m = m0 + u * ngw;
            if (m < NTOK) {
                float f[8]; unpack8(c[u], f);
                float ss = 0.f;
#pragma unroll
                for (int q = 0; q < 8; ++q) ss += f[q] * f[q];
                const float r2 = rsqrtf(wave_sum(ss) * (1.f / DSSM) + 1e-6f);
                v4u o; o.x = pk2(f[0] * r2 * ov[0], f[1] * r2 * ov[1]); o.y = pk2(f[2] * r2 * ov[2], f[3] * r2 * ov[3]);
                o.z = pk2(f[4] * r2 * ov[4], f[5] * r2 * ov[5]); o.w = pk2(f[6] * r2 * ov[6], f[7] * r2 * ov[7]);
                *(v4u*)(MRG + (size_t)m * D + ch) = o;
            }
        }
        asm volatile("" ::: "memory");
    }
}

__device__ __forceinline__ void moe_tables(const Args& a, LAS int* T) {
    const unsigned* cnt = (const unsigned*)(a.ws + WS_CTL) + CW_CNT;
    if (threadIdx.x < 32) T[threadIdx.x] = (int)__hip_atomic_load(cnt + threadIdx.x, __ATOMIC_RELAXED, __HIP_MEMORY_SCOPE_AGENT);
    __syncthreads();
    if (threadIdx.x == 0) { int rb = 0, t64 = 0, t256 = 0;
        for (int e = 0; e < NE; ++e) { T[32 + e] = rb; T[65 + e] = t64; T[98 + e] = t256; const int c = T[e]; rb += c; t64 += (c + 63) >> 6; t256 += (c + 255) >> 8; }
        T[32 + NE] = rb; T[65 + NE] = t64; T[98 + NE] = t256; }
    __syncthreads();
    for (int t = threadIdx.x; t < 640; t += NTHR) { int e = 0;
#pragma unroll 4
        for (int q = 1; q < NE; ++q) if (T[98 + q] <= t) e = q;
        T[1280 + t] = e; }
    __syncthreads();
}

__device__ __forceinline__ bf16* ys_ptr(const Args& a, int tok, int k) {
    if (k == 0) return (bf16*)(a.out + (size_t)tok * D);
    if (k == 3) return (bf16*)(a.ws + WS_YS3) + (size_t)tok * D;
    return (bf16*)(a.ws + WS_YS12) + ((size_t)(k - 1) * NTOK + tok) * D;
}

#if YS_F8
typedef v2u ys8_t;
__device__ __forceinline__ void unpack_ys(const ys8_t w, float (&f)[8]) {
    const f32x2 a = __builtin_amdgcn_cvt_pk_f32_fp8(w.x, false), b = __builtin_amdgcn_cvt_pk_f32_fp8(w.x, true), c = __builtin_amdgcn_cvt_pk_f32_fp8(w.y, false), d = __builtin_amdgcn_cvt_pk_f32_fp8(w.y, true);
    f[0] = a.x; f[1] = a.y; f[2] = b.x; f[3] = b.y; f[4] = c.x; f[5] = c.y; f[6] = d.x; f[7] = d.y; }
__device__ __forceinline__ ys8_t load_ys(const Args& a, int tok, int k, int ch) {
    const unsigned char* p = (k == 0) ? (const unsigned char*)(a.out + (size_t)tok * D) : (k == 3) ? (a.ws + WS_YS3) + (size_t)tok * D : (a.ws + WS_YS12) + ((size_t)(k - 1) * NTOK + tok) * D;
    return __builtin_nontemporal_load((const ys8_t*)(p + ch)); }
#else
typedef v4u ys8_t;
__device__ __forceinline__ void unpack_ys(const ys8_t w, float (&f)[8]) { unpack8(w, f); }
__device__ __forceinline__ ys8_t load_ys(const Args& a, int tok, int k, int ch) { return *(const ys8_t*)(ys_ptr(a, tok, k) + ch); }
#endif
struct P9Ld { v4u x[2]; ys8_t y[4][2]; f32x4 w; };
__device__ __forceinline__ P9Ld p9_load(const Args& a, int tok, int lane) {
    P9Ld r; r.w = *(const f32x4*)((const float*)(a.ws + WS_TOPW) + tok * 4);
#pragma unroll
    for (int q = 0; q < 2; ++q) {
        const int ch = lane * 8 + 512 * q;
        r.x[q] = __builtin_nontemporal_load((const v4u*)((const bf16*)(a.out + (size_t)tok * D) + D + ch));
#pragma unroll
        for (int k = 0; k < 4; ++k) r.y[k][q] = load_ys(a, tok, k, ch);
    }
    return r;
}
__device__ __forceinline__ void p9_token(const Args& a, const P9Ld& r, int tok, int lane) {
    const float* mod = (const float*)(a.ws + WS_MOD); const float* fg = a.in[I_FG];
    const int b = tok >> 13;
    float xo[2][8], ss = 0.f;
#pragma unroll
    for (int q = 0; q < 2; ++q) {
        const int ch = lane * 8 + 512 * q;
        float x1[8], y0[8], y1[8], y2[8], y3[8];
        unpack8(r.x[q], x1); unpack_ys(r.y[0][q], y0); unpack_ys(r.y[1][q], y1); unpack_ys(r.y[2][q], y2); unpack_ys(r.y[3][q], y3);
        const f32x4 g0 = *(const f32x4*)(mod + b * 6 * D + 5 * D + ch), g1 = *(const f32x4*)(mod + b * 6 * D + 5 * D + ch + 4);
        const float g2[8] = {g0.x, g0.y, g0.z, g0.w, g1.x, g1.y, g1.z, g1.w};
#pragma unroll
        for (int c = 0; c < 8; ++c) { xo[q][c] = x1[c] + g2[c] * (((r.w.x * y0[c] + r.w.y * y1[c]) + r.w.z * y2[c]) + r.w.w * y3[c]); ss += xo[q][c] * xo[q][c]; }
    }
    const float rstd = rsqrtf(wave_sum(ss) * (1.f / D) + 1e-6f);
#pragma unroll
    for (int q = 0; q < 2; ++q) {
        const int ch = lane * 8 + 512 * q;
        const f32x4 f0 = *(const f32x4*)(fg + ch), f1 = *(const f32x4*)(fg + ch + 4);
        f32x4 o0, o1;
        o0.x = xo[q][0] * rstd * f0.x; o0.y = xo[q][1] * rstd * f0.y; o0.z = xo[q][2] * rstd * f0.z; o0.w = xo[q][3] * rstd * f0.w;
        o1.x = xo[q][4] * rstd * f1.x; o1.y = xo[q][5] * rstd * f1.y; o1.z = xo[q][6] * rstd * f1.z; o1.w = xo[q][7] * rstd * f1.w;
        f32x4* op = (f32x4*)(a.out + (size_t)tok * D + ch);
        __builtin_nontemporal_store(o0, op); __builtin_nontemporal_store(o1, op + 1);
    }
}
__device__ __forceinline__ void p9_final(const Args& a, int gw, int ngw, int lane) {
    P9Ld r0 = p9_load(a, gw < NTOK ? gw : 0, lane), r1 = p9_load(a, gw + ngw < NTOK ? gw + ngw : 0, lane);
    for (int tok = gw; tok < NTOK; tok += 2 * ngw) {
        { const P9Ld cu = r0; const int tn = tok + 2 * ngw; r0 = p9_load(a, tn < NTOK ? tn : tok, lane);
          asm volatile("" ::: "memory"); p9_token(a, cu, tok, lane); asm volatile("" ::: "memory"); }
        if (tok + ngw < NTOK) { const P9Ld cu = r1; const int tn = tok + 3 * ngw; r1 = p9_load(a, tn < NTOK ? tn : tok + ngw, lane);
          asm volatile("" ::: "memory"); p9_token(a, cu, tok + ngw, lane); asm volatile("" ::: "memory"); }
    }
}

namespace pg8 {
constexpr int BM = 256, BK = 64, HALF = 128, HTB = HALF * BK * 2  , STAGE_BYTES = 8 * HTB, NXCD = 8, WGM = 8;
__host__ __device__ __forceinline__ int lds_byte(int r, int c) { const int st = (r >> 4) * 2 + (c >> 5), rr = r & 15, cc = c & 31, ob = rr * 64 + cc * 2; return st * 1024 + (ob ^ (((ob >> 9) & 1) << 5)); }
__host__ __device__ __forceinline__ void stage_rc(int b, int& R, int& C) { const int st = b / 1024, sb = b % 1024, swz = sb ^ (((sb >> 9) & 1) << 5); R = (st >> 1) * 16 + swz / 64; C = (st & 1) * 32 + (swz % 64) / 2; }
__host__ __device__ __forceinline__ int perm32(int rho) { const int n = rho >> 4, i = rho & 15; return 8 * (i >> 2) + 4 * n + (i & 3); }
struct Unit { int pm, pn, e, row0, slot0, nvalid; };
typedef int v8i __attribute__((ext_vector_type(8)));
__device__ __forceinline__ v8i cat8(const bf16x8 lo, const bf16x8 hi) { typedef int v4i __attribute__((ext_vector_type(4))); const v4i a = __builtin_bit_cast(v4i, lo), b = __builtin_bit_cast(v4i, hi); return (v8i){a[0], a[1], a[2], a[3], b[0], b[1], b[2], b[3]}; }
__device__ __forceinline__ bf16x8 lo8(const v8i v) { typedef int v4i __attribute__((ext_vector_type(4))); return __builtin_bit_cast(bf16x8, __builtin_shufflevector(v, v, 0, 1, 2, 3)); }
__device__ __forceinline__ bf16x8 hi8(const v8i v) { typedef int v4i __attribute__((ext_vector_type(4))); return __builtin_bit_cast(bf16x8, __builtin_shufflevector(v, v, 4, 5, 6, 7)); }
__device__ __forceinline__ unsigned cvt_pk_bf16(float lo, float hi) { unsigned r; asm volatile("v_cvt_pk_bf16_f32 %0, %1, %2" : "=v"(r) : "v"(lo), "v"(hi)); return r; }

template <class Epi, class Sched, bool ALIGN_EPI, bool F8 = false>
__device__ __forceinline__ void gemm_phase(LAS unsigned char* lds, const Sched& S, const Epi& E) {
    const int tid = threadIdx.x, wid = __builtin_amdgcn_readfirstlane(tid >> 6), lane = tid & 63, wr = wid >> 2, wc = wid & 3, fr = lane & 15, fq = lane >> 4;
    constexpr int EB = F8 ? 1 : 2;
    const int nt = S.K / (128 / EB);
    int R[2], C[2]; unsigned voffB[2];
#pragma unroll
    for (int i = 0; i < 2; ++i) { stage_rc(tid * 16 + i * 8192, R[i], C[i]); const int Rb = Epi::PERM ? ((R[i] & ~31) + perm32(R[i] & 31)) : R[i]; voffB[i] = (unsigned)(Rb * S.ldb * EB + C[i] * 2); }
    const size_t kstep = (size_t)(BK * 2);
    const size_t bhstep = (size_t)HALF * S.ldb * EB;
    const unsigned ldsw = (unsigned)wid * 1024u;
    const int aoff = lds_byte(wr * 64 + fr, fq * 8), boff = lds_byte(wc * 32 + fr, fq * 8);
#define PG8_SA(b, h) (((b) * 2 + (h)) * HTB)
#define PG8_SB(b, h) ((4 + (b) * 2 + (h)) * HTB)
#define PG8_STAGE(bufoff, gbase, voff) do { _Pragma("unroll") for (int _i = 0; _i < 2; ++_i) \
        __builtin_amdgcn_global_load_lds((const unsigned*)((const char*)(gbase) + (voff)[_i]), (LAS unsigned*)(lds + (bufoff) + ldsw + _i * 8192), 16, 0, 0); } while (0)
#define PG8_LDA(dst, b, h) do { _Pragma("unroll") for (int m = 0; m < 4; ++m) dst[m] = cat8(*(const LAS bf16x8*)(lds + PG8_SA(b, h) + aoff + m * 2048), *(const LAS bf16x8*)(lds + PG8_SA(b, h) + aoff + m * 2048 + 1024)); } while (0)
#define PG8_LDB(dst, b, h) do { _Pragma("unroll") for (int n = 0; n < 2; ++n) dst[n] = cat8(*(const LAS bf16x8*)(lds + PG8_SB(b, h) + boff + n * 2048), *(const LAS bf16x8*)(lds + PG8_SB(b, h) + boff + n * 2048 + 1024)); } while (0)
#define PG8_MMA(ai, bj, At, Bt) do { __builtin_amdgcn_s_setprio(1); _Pragma("unroll") for (int m = 0; m < 4; ++m) _Pragma("unroll") for (int n = 0; n < 2; ++n) { \
        if constexpr (F8) { asm volatile("v_mfma_scale_f32_16x16x128_f8f6f4 %0, %1, %2, %0, %3, %4 op_sel_hi:[0,0,0]" : "+v"(acc[ai][bj][m][n]) : "v"(Bt[n]), "v"(At[m]), "v"(f8sb), "v"(f8sa)); } \
        else { acc[ai][bj][m][n] = __builtin_amdgcn_mfma_f32_16x16x32_bf16(lo8(Bt[n]), lo8(At[m]), acc[ai][bj][m][n], 0, 0, 0); acc[ai][bj][m][n] = __builtin_amdgcn_mfma_f32_16x16x32_bf16(hi8(Bt[n]), hi8(At[m]), acc[ai][bj][m][n], 0, 0, 0); } } \
        __builtin_amdgcn_s_setprio(0); } while (0)
#define PG8_WAIT_V(n) asm volatile("s_waitcnt vmcnt(" #n ")" ::: "memory")
#define PG8_WAIT_VR() do { if (relax_t0) asm volatile("s_waitcnt vmcnt(%0)" :: "n"(8 + Epi::NVM) : "memory"); else PG8_WAIT_V(8); } while (0)
#define PG8_WAIT_L(n) asm volatile("s_waitcnt lgkmcnt(" #n ")" ::: "memory")
#define PG8_BAR __builtin_amdgcn_s_barrier()
#define PG8_SCHED __builtin_amdgcn_sched_barrier(0)
    Unit cur, nxt; int ui = 0; cur.e = 0;
    if (!S.next(0, cur)) return;
    nxt = cur;
    f32x4 acc[2][2][4][2];
#pragma unroll
    for (int a = 0; a < 2; ++a)
#pragma unroll
        for (int b = 0; b < 2; ++b)
#pragma unroll
            for (int m = 0; m < 4; ++m)
#pragma unroll
                for (int n = 0; n < 2; ++n) acc[a][b][m][n] = (f32x4){0.f, 0.f, 0.f, 0.f};
    const int f8sa = S.scale_a, f8sb = S.scale_b;
    v8i At[4], B0[2], B1[2];
    unsigned ao[2][2], an[2][2];
    S.a_offsets(cur, R, C, ao);
    const char* cA = S.a_base(cur); const char* cB = S.b_base(cur);
    PG8_STAGE(PG8_SB(0, 0), cB, voffB); PG8_STAGE(PG8_SB(0, 1), cB + bhstep, voffB); PG8_STAGE(PG8_SA(0, 0), cA, ao[0]); PG8_STAGE(PG8_SA(0, 1), cA, ao[1]);
    if (wr == 1) PG8_BAR;
    PG8_WAIT_V(2); PG8_BAR;
    PG8_STAGE(PG8_SB(1, 0), cB + kstep, voffB); PG8_STAGE(PG8_SA(1, 0), cA + kstep, ao[0]); PG8_STAGE(PG8_SB(1, 1), cB + bhstep + kstep, voffB); PG8_STAGE(PG8_SA(1, 1), cA + kstep, ao[1]);
    PG8_WAIT_V(8); PG8_BAR;
    int tz = 0; asm volatile("" : "+s"(tz));
    bool relax = false;
#if TIME_PHASE >= 0
    unsigned long long tk0 = 0, tk1 = 0, tacc_k = 0, tacc_e = 0;
#endif
    for (;;) {
#if TIME_PHASE >= 0
        if (S.tstamp) tk0 = __builtin_amdgcn_s_memrealtime();
#endif
        const bool has_next = S.next(ui + 1, nxt);
        const char* nA = cA; const char* nB = cB;
#pragma unroll
        for (int h = 0; h < 2; ++h)
#pragma unroll
            for (int i = 0; i < 2; ++i) an[h][i] = ao[h][i];
        if (has_next) { nA = S.a_base(nxt); nB = S.b_base(nxt); S.a_offsets(nxt, R, C, an); }
        for (int t = 0; t < nt; t += 2) {
            const bool last = (t == nt - 2), relax_t0 = relax && t == tz;
            const char* a1 = cA + (size_t)(t + 1) * kstep;
            const char* a2 = last ? nA : cA + (size_t)(t + 2) * kstep; const char* b2 = last ? nB : cB + (size_t)(t + 2) * kstep;
            const char* a3 = a2 + kstep; const char* b3 = b2 + kstep;
            unsigned o2[2][2];
#pragma unroll
            for (int h = 0; h < 2; ++h)
#pragma unroll
                for (int i = 0; i < 2; ++i) o2[h][i] = last ? an[h][i] : ao[h][i];
            PG8_LDB(B0, 0, 0); PG8_LDB(B1, 0, 1); PG8_SCHED; PG8_LDA(At, 0, 0); if (t != tz) PG8_STAGE(PG8_SA(1, 1), a1, ao[1]);
            PG8_WAIT_VR(); PG8_WAIT_L(0); PG8_BAR; PG8_MMA(0, 0, At, B0); PG8_MMA(0, 1, At, B1); PG8_BAR; PG8_SCHED;
            PG8_LDA(At, 0, 1); PG8_STAGE(PG8_SB(0, 0), b2, voffB); PG8_STAGE(PG8_SB(0, 1), b2 + bhstep, voffB); PG8_STAGE(PG8_SA(0, 0), a2, o2[0]);
            PG8_WAIT_VR(); PG8_WAIT_L(0); PG8_BAR; PG8_MMA(1, 0, At, B0); PG8_MMA(1, 1, At, B1); PG8_BAR; PG8_SCHED;
            PG8_LDB(B0, 1, 0); PG8_LDB(B1, 1, 1); PG8_SCHED; PG8_LDA(At, 1, 0); PG8_STAGE(PG8_SA(0, 1), a2, o2[1]);
            PG8_WAIT_VR(); PG8_WAIT_L(0); PG8_BAR; PG8_MMA(0, 0, At, B0); PG8_MMA(0, 1, At, B1); PG8_BAR; PG8_SCHED;
            PG8_LDA(At, 1, 1); PG8_STAGE(PG8_SB(1, 0), b3, voffB); PG8_STAGE(PG8_SB(1, 1), b3 + bhstep, voffB); PG8_STAGE(PG8_SA(1, 0), a3, o2[0]);
            PG8_WAIT_V(8); PG8_WAIT_L(0); PG8_BAR; PG8_MMA(1, 0, At, B0); PG8_MMA(1, 1, At, B1); PG8_BAR; PG8_SCHED;
        }
#if TIME_PHASE >= 0
        if (S.tstamp) { tk1 = __builtin_amdgcn_s_memrealtime(); tacc_k += tk1 - tk0; }
#endif
        if (has_next) PG8_STAGE(PG8_SA(1, 1), nA + kstep, an[1]);
        if constexpr (ALIGN_EPI) { if (wr == 0) PG8_BAR; }
        if constexpr (F8) { asm volatile("s_nop 15\n\ts_nop 15" ::: "memory"); }
        E(acc, cur, wr, wc, fr, fq);
        if (S.rep_epi) { asm volatile("" ::: "memory"); E(acc, cur, wr, wc, fr, fq); }
#if TIME_PHASE >= 0
        if (S.tstamp) { tacc_e += __builtin_amdgcn_s_memrealtime() - tk1; }
#endif
        if (!has_next) break;
#pragma unroll
        for (int a = 0; a < 2; ++a)
#pragma unroll
            for (int b = 0; b < 2; ++b)
#pragma unroll
                for (int m = 0; m < 4; ++m)
#pragma unroll
                    for (int n = 0; n < 2; ++n) acc[a][b][m][n] = (f32x4){0.f, 0.f, 0.f, 0.f};
        relax = (Epi::NVM > 0) && (cur.nvalid == BM) && !S.rep_epi;
        cur = nxt; cA = nA; cB = nB; ++ui;
#pragma unroll
        for (int h = 0; h < 2; ++h)
#pragma unroll
            for (int i = 0; i < 2; ++i) ao[h][i] = an[h][i];
        if constexpr (ALIGN_EPI) { if (wr == 1) PG8_BAR; }
    }
    PG8_WAIT_V(0);
    if constexpr (!ALIGN_EPI) { if (wr == 0) PG8_BAR; }
    PG8_BAR;
#if TIME_PHASE >= 0
    if (S.tstamp && threadIdx.x == 0) { LAS unsigned long long* TSg = (LAS unsigned long long*)(lds + 131072 + 4096); TSg[24] = 0; TSg[25] = tacc_k; TSg[26] = tacc_k + tacc_e; }
#endif
#undef PG8_SA
#undef PG8_SB
#undef PG8_STAGE
#undef PG8_LDA
#undef PG8_LDB
#undef PG8_MMA
#undef PG8_WAIT_V
#undef PG8_WAIT_VR
#undef PG8_WAIT_L
#undef PG8_BAR
#undef PG8_SCHED
}

struct SchedDense {
    static constexpr int scale_a = 127, scale_b = 127, rep_epi = 0;
    const bf16* A; const bf16* Bt; int K, lda, ldb; int nM, nN, nwg, G, c, rep, tstamp = 0;
    __device__ __forceinline__ void init(const bf16* A_, const bf16* Bt_, int M, int N, int K_, int lda_, int ldb_, int G_, int c_, int rep_ = 1) { A = A_; Bt = Bt_; K = K_; lda = lda_; ldb = ldb_; nM = M / BM; nN = N / BM; nwg = nM * nN; G = G_; c = c_; rep = rep_; }
    __device__ __forceinline__ bool next(int i, Unit& u) const {
        const long L = (long)(i / rep) * G + c; if (L >= nwg) return false;
        int wgid = (int)L; { const int q = nwg / NXCD, r = nwg % NXCD, xcd = wgid % NXCD, off = wgid / NXCD; wgid = (xcd < r ? xcd * (q + 1) : r * (q + 1) + (xcd - r) * q) + off; }
        const int nig = WGM * nN, gid = wgid / nig, fm = gid * WGM, gsz = (nM - fm) < WGM ? (nM - fm) : WGM;
        u.pm = fm + ((wgid % nig) % gsz); u.pn = (wgid % nig) / gsz; u.e = 0; u.row0 = u.pm * BM; u.slot0 = 0; u.nvalid = BM; return true;
    }
    __device__ __forceinline__ const char* a_base(const Unit& u) const { return (const char*)A + (size_t)u.pm * BM * lda * 2; }
    __device__ __forceinline__ const char* b_base(const Unit& u) const { return (const char*)Bt + (size_t)u.pn * BM * ldb * 2; }
    __device__ __forceinline__ void a_offsets(const Unit&, const int (&R)[2], const int (&C)[2], unsigned (&off)[2][2]) const {
#pragma unroll
        for (int h = 0; h < 2; ++h)
#pragma unroll
            for (int i = 0; i < 2; ++i) off[h][i] = (unsigned)((R[i] + HALF * h) * lda + C[i]) * 2u;
    }
};
struct SchedGroup {
    static constexpr int scale_a = 127, scale_b = 127, rep_epi = 0, tstamp = 0;
    const bf16* A; const bf16* Bt; int K, lda, ldb; int nM, nN, ng, G, c; size_t astride, bstride; int rep, nmax;
    __device__ __forceinline__ bool next(int i, Unit& u) const {
        const int L = (i / rep) * G + c; if (L >= ng * nM * nN || i >= nmax) return false;
        const int g = L / (nM * nN), rem = L % (nM * nN);
        u.e = g; u.pm = rem % nM; u.pn = rem / nM; u.row0 = u.pm * BM; u.slot0 = 0; u.nvalid = BM; return true;
    }
    __device__ __forceinline__ const char* a_base(const Unit& u) const { return (const char*)(A + (size_t)u.e * astride) + (size_t)u.pm * BM * lda * 2; }
    __device__ __forceinline__ const char* b_base(const Unit& u) const { return (const char*)(Bt + (size_t)u.e * bstride) + (size_t)u.pn * BM * ldb * 2; }
    __device__ __forceinline__ void a_offsets(const Unit&, const int (&R)[2], const int (&C)[2], unsigned (&off)[2][2]) const {
#pragma unroll
        for (int h = 0; h < 2; ++h)
#pragma unroll
            for (int i = 0; i < 2; ++i) off[h][i] = (unsigned)((R[i] + HALF * h) * lda + C[i]) * 2u;
    }
};
}

__device__ __forceinline__ unsigned pk_fp8x4(float a, float b, float c, float d) { unsigned r = __builtin_amdgcn_cvt_pk_fp8_f32(a, b, 0u, false); return __builtin_amdgcn_cvt_pk_fp8_f32(c, d, r, true); }
struct TItem { const float* W; unsigned char* WT; int K, N, k0, n0, drow0, f8, perm; };
__device__ __forceinline__ int wd_perm_row(int c) { return (c & ~255) + ((c >> 3) & 1) * 128 + ((c >> 6) & 3) * 32 + ((c >> 4) & 3) * 8 + (c & 7); }
__device__ __forceinline__ void titem_load(const TItem& t, int lane, f32x4 (&v)[8]) {
    const float* p = t.W + (size_t)(t.k0 + 8 * (lane >> 3)) * t.N + t.n0 + 4 * (lane & 7);
#pragma unroll
    for (int i = 0; i < 8; ++i) v[i] = __builtin_nontemporal_load((const f32x4*)(p + (size_t)i * t.N));
}
__device__ __forceinline__ void titem_store(const TItem& t, int lane, const f32x4 (&v)[8], float f8scale) {
    const int n4 = lane & 7, kb = lane >> 3;
#pragma unroll
    for (int j = 0; j < 4; ++j) {
        const int cc = 4 * n4 + j;
        const size_t row = (size_t)(t.perm == 1 ? wd_perm_row(t.drow0 + cc) : t.perm == 2 ? t.drow0 + 8 * ((((cc >> 3) & 1) << 1) | (cc >> 4)) + (cc & 7) : t.drow0 + cc);
        if (t.f8) { v2u o; o.x = pk_fp8x4(v[0][j] * f8scale, v[1][j] * f8scale, v[2][j] * f8scale, v[3][j] * f8scale); o.y = pk_fp8x4(v[4][j] * f8scale, v[5][j] * f8scale, v[6][j] * f8scale, v[7][j] * f8scale);
            *(v2u*)(t.WT + row * t.K + t.k0 + 8 * kb) = o; }
        else { v4u o; o.x = pk2(v[0][j], v[1][j]); o.y = pk2(v[2][j], v[3][j]); o.z = pk2(v[4][j], v[5][j]); o.w = pk2(v[6][j], v[7][j]);
            *(v4u*)(t.WT + (row * t.K + t.k0 + 8 * kb) * 2) = o; }
    }
}
constexpr float WGU_F8_SCALE = 32.0f;
__device__ __forceinline__ TItem p0_item(const Args& a, int it) {
    constexpr int I_IN = 16 * 48, I_GLU = 8 * 16, I_OUT = 16 * 32, I_EXP = 16 * 32;
    TItem t; t.f8 = 0; t.perm = 0; int r = it;
    if (r < I_IN) { const int kb = r / 48, nb = r % 48, n0 = nb * 32; int drow;
        if (n0 < 512) drow = n0; else if (n0 < 1024) { const int j = n0 - 512; drow = 512 + (j >> 7) * 256 + (j & 127); } else { const int j = n0 - 1024; drow = 512 + (j >> 7) * 256 + 128 + (j & 127); }
        t.W = a.in[I_WIN]; t.WT = a.ws + WS_WIN; t.K = D; t.N = DIN; t.k0 = kb * 64; t.n0 = n0; t.drow0 = drow; return t; } r -= I_IN;
    if (r < I_GLU) { const int kb = r / 16, nb = r % 16; t.W = a.in[I_WGLU]; t.WT = a.ws + WS_WGLU; t.K = DSSM; t.N = DSSM; t.k0 = kb * 64; t.n0 = nb * 32; t.drow0 = nb * 32; return t; } r -= I_GLU;
    if (r < I_OUT) { const int kb = r / 32, nb = r % 32; t.W = a.in[I_WOUT]; t.WT = a.ws + WS_WOUT; t.K = D; t.N = D; t.k0 = kb * 64; t.n0 = nb * 32; t.drow0 = nb * 32; return t; } r -= I_OUT;
    const int e = r / (3 * I_EXP), q = r % (3 * I_EXP), which = q / I_EXP, sidx = q % I_EXP, kb = sidx / 32, nb = sidx % 32, n0 = nb * 32;
    t.K = D; t.N = FF; t.k0 = kb * 64; t.n0 = n0;
    if (which == 0) { t.W = a.in[I_WG] + (size_t)e * D * FF; t.WT = a.ws + WS_WGU + (size_t)e * 2048 * D * (MOE1_F8 ? 1 : 2); t.drow0 = (n0 >> 7) * 256 + (n0 & 127); t.f8 = MOE1_F8; t.perm = MOE1_WIDE ? 2 : 0; }
    else if (which == 1) { t.W = a.in[I_WU] + (size_t)e * D * FF; t.WT = a.ws + WS_WGU + (size_t)e * 2048 * D * (MOE1_F8 ? 1 : 2); t.drow0 = (n0 >> 7) * 256 + 128 + (n0 & 127); t.f8 = MOE1_F8; t.perm = MOE1_WIDE ? 2 : 0; }
    else { t.W = a.in[I_WD] + (size_t)e * FF * D; t.WT = a.ws + WS_WD + (size_t)e * D * FF * (MOE2_F8 ? 1 : 2); t.drow0 = n0; t.f8 = MOE2_F8; t.perm = MOE2_WIDE; }
    return t;
}
__device__ __forceinline__ void p0_convert(const Args& a, int gw, int ngw, int lane) {
    constexpr int NITEMS = 16 * 48 + 8 * 16 + 16 * 32 + 3 * NE * 16 * 32;
    const int x = blockIdx.x & 7, lo = (int)(((long)NITEMS * x) >> 3), hi = (int)(((long)NITEMS * (x + 1)) >> 3);
    unsigned* ctr = (unsigned*)(a.ws + WS_CTL) + CW_CONV + 64 * x;
    int it = 0, nleft = 0;
    auto grab = [&]() { if (nleft == 0) { int g0 = 0; if (lane == 0) g0 = (int)atomicAdd(ctr, 8u); it = __builtin_amdgcn_readfirstlane(g0) + lo; nleft = 8; } };
    grab();
    bool have = it < hi; TItem c0{}, c1{}; bool ctwo = false; f32x4 v0[8], v1[8];
    if (have) { c0 = p0_item(a, it); ctwo = it + 1 < hi; c1 = p0_item(a, ctwo ? it + 1 : it); titem_load(c0, lane, v0); titem_load(c1, lane, v1); it += 2; nleft -= 2; }
    while (have) {
        grab();
        const bool hn = it < hi; TItem n0{}, n1{}; bool ntwo = false; f32x4 w0[8], w1[8];
        if (hn) { n0 = p0_item(a, it); ntwo = it + 1 < hi; n1 = p0_item(a, ntwo ? it + 1 : it); titem_load(n0, lane, w0); titem_load(n1, lane, w1); it += 2; nleft -= 2; }
        asm volatile("" ::: "memory");
        titem_store(c0, lane, v0, WGU_F8_SCALE);
        if (ctwo) titem_store(c1, lane, v1, WGU_F8_SCALE);
        asm volatile("" ::: "memory");
        have = hn; c0 = n0; c1 = n1; ctwo = ntwo;
#pragma unroll
        for (int i = 0; i < 8; ++i) { v0[i] = w0[i]; v1[i] = w1[i]; }
    }
}
__device__ __forceinline__ void p0_s5_mats(const Args& a, LAS float* sm) {
    LAS float* Ptau = sm; LAS float* Pt1 = sm + 128; LAS float* Ps = sm + 256; LAS float* LD = sm + 384;
    LAS float* Bb = sm + 512; LAS float* Kt = sm + 512 + 2048; LAS float* Cs = sm + 512 + 2048 + 256;
    bf16* BTS = (bf16*)(a.ws + WS_BTS); bf16* BTY = (bf16*)(a.ws + WS_BTY);
    const int t = threadIdx.x;
    for (int it0 = blockIdx.x * 4; it0 < NG * TCH; it0 += gridDim.x * 4) {
        const int g = it0 >> 5;
        if (t < 64) {
            const int p = t;
            const float lr = a.in[I_LRE][g * NP + p], li = a.in[I_LIM][g * NP + p], dt = expf(a.in[I_LDT][g]);
            const float mag = expf(lr * dt); float sn, cs; sincosf(li * dt, &sn, &cs);
            const float ar = mag * cs, ai = mag * sn, den = lr * lr + li * li, nr = ar - 1.f;
            const float qr = (nr * lr + ai * li) / den, qi = (ai * lr - nr * li) / den;
            LD[2 * p] = lr * dt; LD[2 * p + 1] = li * dt;
#pragma unroll
            for (int h = 0; h < 16; ++h) {
                const float br = a.in[I_BRE][(g * NP + p) * GH + h], bi = a.in[I_BIM][(g * NP + p) * GH + h];
                Bb[(p * 16 + h) * 2] = qr * br - qi * bi; Bb[(p * 16 + h) * 2 + 1] = qr * bi + qi * br;
            }
        }
        for (int i = t; i < GH * NP; i += NTHR) { Cs[2 * i] = a.in[I_CRE][g * GH * NP + i]; Cs[2 * i + 1] = a.in[I_CIM][g * GH * NP + i]; }
        __syncthreads();
        for (int tau = it0 & 31; tau < (it0 & 31) + 4; ++tau) {
        if (t < 192) {
            const int p = t & 63, which = t >> 6; const float e = which == 0 ? (float)tau : which == 1 ? (float)(tau + 1) : (float)(31 - tau);
            const float m = expf(e * LD[2 * p]); float s2, c2; sincosf(e * LD[2 * p + 1], &s2, &c2);
            LAS float* dst = which == 0 ? Ptau : which == 1 ? Pt1 : Ps; dst[2 * p] = m * c2; dst[2 * p + 1] = m * s2;
        }
        __syncthreads();
        if (t < 256) {
            const int h = t >> 4, h2 = t & 15; float s = 0.f;
#pragma unroll 8
            for (int p = 0; p < NP; ++p) {
                const float cr = Cs[(h * NP + p) * 2], ci = Cs[(h * NP + p) * 2 + 1];
                const float pr = Ptau[2 * p], pi = Ptau[2 * p + 1], br = Bb[(p * 16 + h2) * 2], bi = Bb[(p * 16 + h2) * 2 + 1];
                const float xr = pr * br - pi * bi, xi = pr * bi + pi * br;
                s += cr * xr - ci * xi;
            }
            if (tau == 0 && h == h2) s += a.in[I_DSK][g * GH + h];
            Kt[t] = s;
        }
        __syncthreads();
        bf16* by = BTY + (size_t)g * 512 * U2G;
        for (int idx = t; idx < (TCH - tau) * 32; idx += NTHR) {
            const int j = idx >> 5, h = (idx >> 1) & 15, half = idx & 1, tt = tau + j, sidx = j;
            const LAS float* k = Kt + h * 16 + half * 8;
            v4u o; o.x = pk2(k[0], k[1]); o.y = pk2(k[2], k[3]); o.z = pk2(k[4], k[5]); o.w = pk2(k[6], k[7]);
            *(v4u*)(by + (size_t)(tt * 16 + h) * U2G + sidx * 16 + half * 8) = o;
        }
        if (tau >= 1) for (int idx = t; idx < (TCH - tau) * 32; idx += NTHR) {
            const int j = idx >> 5, h = (idx >> 1) & 15, half = idx & 1, tt = j, sidx = tau + j;
            *(v4u*)(by + (size_t)(tt * 16 + h) * U2G + sidx * 16 + half * 8) = (v4u){0u, 0u, 0u, 0u};
        }
        if (t < 256) {
            const int h = t >> 4, piece = t & 15; float v[8];
#pragma unroll
            for (int q = 0; q < 8; ++q) { const int pp = piece * 8 + q, p = pp & 63;
                const float cr = Cs[(h * NP + p) * 2], ci = Cs[(h * NP + p) * 2 + 1], pr = Pt1[2 * p], pi = Pt1[2 * p + 1];
                v[q] = (pp < 64) ? (cr * pr - ci * pi) : -(cr * pi + ci * pr); }
            v4u o; o.x = pk2(v[0], v[1]); o.y = pk2(v[2], v[3]); o.z = pk2(v[4], v[5]); o.w = pk2(v[6], v[7]);
            *(v4u*)(by + (size_t)(tau * 16 + h) * U2G + 512 + piece * 8) = o;
        } else {
            const int u = t - 256, n = u >> 1, half = u & 1, p = n & 63; float v[8];
#pragma unroll
            for (int q = 0; q < 8; ++q) { const int h = half * 8 + q; const float pr = Ps[2 * p], pi = Ps[2 * p + 1], br = Bb[(p * 16 + h) * 2], bi = Bb[(p * 16 + h) * 2 + 1];
                v[q] = (n < 64) ? (pr * br - pi * bi) : (pr * bi + pi * br); }
            v4u o; o.x = pk2(v[0], v[1]); o.y = pk2(v[2], v[3]); o.z = pk2(v[4], v[5]); o.w = pk2(v[6], v[7]);
            bf16* bs = BTS + (size_t)g * 256 * 512;
            *(v4u*)(bs + (size_t)n * 512 + tau * 16 + half * 8) = o;
            *(v4u*)(bs + (size_t)(128 + n) * 512 + tau * 16 + half * 8) = (v4u){0u, 0u, 0u, 0u};
        }
        __syncthreads();
        }
    }
}

using pg8::Unit; using pg8::cvt_pk_bf16;
struct EpiInProj {
    static constexpr bool PERM = true; static constexpr int NVM = 0;
    bf16* U2; bf16* Z;
    __device__ __forceinline__ void operator()(const f32x4 (&acc)[2][2][4][2], const Unit& u, int wr, int wc, int fr, int fq) const {
#pragma unroll
        for (int ai = 0; ai < 2; ++ai)
#pragma unroll
            for (int m = 0; m < 4; ++m) {
                const int tok = u.pm * 256 + ai * 128 + wr * 64 + m * 16 + fr;
                if (u.pn < 2) {
                    const int b = tok >> 13, l = tok & 8191;
                    bf16* rowp = U2 + (size_t)(b * NCH + (l >> 5)) * U2LD + (l & 31) * 16;
#pragma unroll
                    for (int bj = 0; bj < 2; ++bj) { const int c0 = u.pn * 256 + bj * 128 + wc * 32 + 8 * fq; const f32x4 v0 = acc[ai][bj][m][0], v1 = acc[ai][bj][m][1];
                        v4u w; w.x = cvt_pk_bf16(v0[0], v0[1]); w.y = cvt_pk_bf16(v0[2], v0[3]); w.z = cvt_pk_bf16(v1[0], v1[1]); w.w = cvt_pk_bf16(v1[2], v1[3]);
                        *(v4u*)(rowp + (c0 >> 4) * U2G + (c0 & 15)) = w; }
                } else {
                    const int j0 = (u.pn - 2) * 128 + wc * 32 + 8 * fq;
                    const f32x4 a0 = acc[ai][0][m][0], a1 = acc[ai][0][m][1], g0 = acc[ai][1][m][0], g1 = acc[ai][1][m][1];
                    constexpr float KS = -1.4426950408889634f;
                    const f32x2 z0 = (f32x2){a0[0], a0[1]} * sig2((f32x2){g0[0], g0[1]}, KS), z1 = (f32x2){a0[2], a0[3]} * sig2((f32x2){g0[2], g0[3]}, KS);
                    const f32x2 z2 = (f32x2){a1[0], a1[1]} * sig2((f32x2){g1[0], g1[1]}, KS), z3 = (f32x2){a1[2], a1[3]} * sig2((f32x2){g1[2], g1[3]}, KS);
                    v4u w; w.x = cvt_pk_bf16(z0.x, z0.y); w.y = cvt_pk_bf16(z1.x, z1.y); w.z = cvt_pk_bf16(z2.x, z2.y); w.w = cvt_pk_bf16(z3.x, z3.y);
                    *(v4u*)(Z + (size_t)tok * DCONV + j0) = w;
                }
            }
    }
};
struct EpiGlu {
    static constexpr bool PERM = true; static constexpr int NVM = 0;
    const bf16* YG; bf16* MRG; const float* bias;
    __device__ __forceinline__ void operator()(const f32x4 (&acc)[2][2][4][2], const Unit& u, int wr, int wc, int fr, int fq) const {
#pragma unroll
        for (int bj = 0; bj < 2; ++bj) {
            const int c0 = u.pn * 256 + bj * 128 + wc * 32 + 8 * fq;
            const f32x4 b0 = *(const f32x4*)(bias + c0), b1 = *(const f32x4*)(bias + c0 + 4);
#pragma unroll
            for (int ai = 0; ai < 2; ++ai)
#pragma unroll
                for (int m = 0; m < 4; ++m) {
                    const int tok = u.pm * 256 + ai * 128 + wr * 64 + m * 16 + fr;
                    float y[8]; unpack8(*(const v4u*)(YG + (size_t)tok * DSSM + c0), y);
                    const f32x4 v0 = acc[ai][bj][m][0] + b0, v1 = acc[ai][bj][m][1] + b1;
                    constexpr float KS = -1.4426950408889634f;
                    const f32x2 z0 = (f32x2){y[0], y[1]} * sig2((f32x2){v0[0], v0[1]}, KS), z1 = (f32x2){y[2], y[3]} * sig2((f32x2){v0[2], v0[3]}, KS);
                    const f32x2 z2 = (f32x2){y[4], y[5]} * sig2((f32x2){v1[0], v1[1]}, KS), z3 = (f32x2){y[6], y[7]} * sig2((f32x2){v1[2], v1[3]}, KS);
                    v4u w; w.x = cvt_pk_bf16(z0.x, z0.y); w.y = cvt_pk_bf16(z1.x, z1.y); w.z = cvt_pk_bf16(z2.x, z2.y); w.w = cvt_pk_bf16(z3.x, z3.y);
                    *(v4u*)(MRG + (size_t)tok * D + c0) = w;
                }
        }
    }
};
struct EpiOut {
    static constexpr bool PERM = true; static constexpr int NVM = 0;
    const float* x; float* out; const float* mod; float* ssq;
    __device__ __forceinline__ void operator()(const f32x4 (&acc)[2][2][4][2], const Unit& u, int wr, int wc, int fr, int fq) const {
        const int b = (u.pm * 256) >> 13;
        f32x4 g1[2][2];
#pragma unroll
        for (int bj = 0; bj < 2; ++bj)
#pragma unroll
            for (int n = 0; n < 2; ++n) g1[bj][n] = *(const f32x4*)(mod + b * 6 * D + 2 * D + u.pn * 256 + bj * 128 + wc * 32 + 8 * fq + 4 * n);
#pragma unroll
        for (int ai = 0; ai < 2; ++ai)
#pragma unroll
            for (int m = 0; m < 4; ++m) {
                const int row = u.pm * 256 + ai * 128 + wr * 64 + m * 16 + fr; float sq = 0.f;
                bf16* drow = (bf16*)(out + (size_t)row * D);
#pragma unroll
                for (int bj = 0; bj < 2; ++bj) {
                    const int c0 = u.pn * 256 + bj * 128 + wc * 32 + 8 * fq;
                    const f32x4 o0 = *(const f32x4*)(x + (size_t)row * D + c0) + g1[bj][0] * acc[ai][bj][m][0], o1 = *(const f32x4*)(x + (size_t)row * D + c0 + 4) + g1[bj][1] * acc[ai][bj][m][1];
                    sq += ((o0[0] * o0[0] + o0[1] * o0[1]) + (o0[2] * o0[2] + o0[3] * o0[3])) + ((o1[0] * o1[0] + o1[1] * o1[1]) + (o1[2] * o1[2] + o1[3] * o1[3]));
                    v4u hi, lo;
                    hi.x = pk2(o0[0], o0[1]); hi.y = pk2(o0[2], o0[3]); hi.z = pk2(o1[0], o1[1]); hi.w = pk2(o1[2], o1[3]);
                    lo.x = pk2(o0[0] - bflo(hi.x), o0[1] - bfhi(hi.x)); lo.y = pk2(o0[2] - bflo(hi.y), o0[3] - bfhi(hi.y));
                    lo.z = pk2(o1[0] - bflo(hi.z), o1[1] - bfhi(hi.z)); lo.w = pk2(o1[2] - bflo(hi.w), o1[3] - bfhi(hi.w));
                    *(v4u*)(drow + D + c0) = hi; *(v4u*)(drow + c0) = lo;
                }
                sq += __shfl_xor(sq, 16); sq += __shfl_xor(sq, 32);
                if (fq == 0) ssq[row * 16 + u.pn * 4 + wc] = sq;
            }
    }
};

__device__ __forceinline__ void p2_fast(const Args& a, LAS unsigned char* lds) {
    pg8::SchedDense S; S.init((const bf16*)(a.ws + WS_H1), (const bf16*)(a.ws + WS_WIN), NTOK, DIN, D, D, D, gridDim.x, blockIdx.x, (REP_GEMM == 2) ? 2 : 1); S.tstamp = (TSTAMP_GEMM == 2) ? 1 : 0;
    EpiInProj E{(bf16*)(a.ws + WS_U2), (bf16*)(a.ws + WS_Z)};
    pg8::gemm_phase<EpiInProj, pg8::SchedDense, true>(lds, S, E);
}
__device__ __forceinline__ void p3d_fast(const Args& a, LAS unsigned char* lds) {
    pg8::SchedDense S; S.init((const bf16*)(a.ws + WS_YG), (const bf16*)(a.ws + WS_WGLU), NTOK, DSSM, DSSM, DSSM, DSSM, gridDim.x, blockIdx.x, (REP_GEMM == 6) ? 2 : 1);
    EpiGlu E{(const bf16*)(a.ws + WS_YG), (bf16*)(a.ws + WS_MRG), a.in[I_BGLU]};
    pg8::gemm_phase<EpiGlu, pg8::SchedDense, true>(lds, S, E);
}
__device__ __forceinline__ void p4_fast(const Args& a, LAS unsigned char* lds) {
    pg8::SchedDense S; S.init((const bf16*)(a.ws + WS_MRG), (const bf16*)(a.ws + WS_WOUT), NTOK, D, D, D, D, gridDim.x, blockIdx.x, (REP_GEMM == 8) ? 2 : 1);
    EpiOut E{a.in[I_X], a.out, (const float*)(a.ws + WS_MOD), (float*)(a.ws + WS_SSQ)};
    pg8::gemm_phase<EpiOut, pg8::SchedDense, ALIGN_P4>(lds, S, E);
}

template <bool GATHER>
struct SchedMoE {
    const LAS int* T; const char* Abase; const char* Bt; const int* tokk; int K, lda, ldb, nN, G, c; size_t bstride; int rep, eb, scale_a, scale_b, rep_epi, tstamp;
    __device__ __forceinline__ bool next(int i_, Unit& u) const {
        const int i = i_ / rep;
        const int NT = __builtin_amdgcn_readfirstlane(T[98 + NE]); int Tt, pn;
        if ((G & 7) == 0 && ((G >> 3) % nN) == 0) {
            const int x = c & 7, j = c >> 3, rtpr = (G >> 3) / nN, Ts = (x * NT) >> 3, Te = ((x + 1) * NT) >> 3;
            pn = j / rtpr; Tt = Ts + i * rtpr + (j % rtpr); if (Tt >= Te) return false;
            if (!GATHER) Tt = Te - 1 - (Tt - Ts);
        } else { const int L = i * G + c; Tt = L / nN; pn = L % nN; if (Tt >= NT) return false; }
        int e = 0;
        if (GATHER) { e = u.e;
            while (e + 1 < NE && __builtin_amdgcn_readfirstlane(T[98 + e + 1]) <= Tt) ++e; e = __builtin_amdgcn_readfirstlane(e); }
        else e = __builtin_amdgcn_readfirstlane(T[1280 + Tt]);
        u.e = e; u.pn = pn; u.pm = Tt; u.slot0 = __builtin_amdgcn_readfirstlane((Tt - T[98 + e]) * 256); u.row0 = __builtin_amdgcn_readfirstlane(T[32 + e] + u.slot0);
        const int left = __builtin_amdgcn_readfirstlane(T[e] - u.slot0); u.nvalid = left < 256 ? left : 256; return true;
    }
    __device__ __forceinline__ const char* a_base(const Unit& u) const { return GATHER ? Abase : Abase + (size_t)u.row0 * lda * eb; }
    __device__ __forceinline__ const char* b_base(const Unit& u) const { return Bt + ((size_t)u.e * bstride + (size_t)u.pn * 256 * ldb) * eb; }
    __device__ __forceinline__ void a_offsets(const Unit& u, const int (&R)[2], const int (&C)[2], unsigned (&off)[2][2]) const {
#pragma unroll
        for (int h = 0; h < 2; ++h)
#pragma unroll
            for (int i = 0; i < 2; ++i) {
                const int row = R[i] + 128 * h;
                if (GATHER) { int tok = 0; if (row < u.nvalid) tok = tokk[(size_t)u.e * CAP + u.slot0 + row] >> 2; off[h][i] = (unsigned)tok * (unsigned)(lda * eb) + (unsigned)C[i] * 2u; }
                else off[h][i] = (unsigned)(row * lda * eb + C[i] * 2);
            }
    }
};
struct EpiMoe1 {
    static constexpr bool PERM = true; static constexpr int NVM = (MOE1_WIDE ? 4 : 0);
    bf16* ACT; const float* bg; const float* bu;
#if MOE1_WIDE
    __device__ __forceinline__ void operator()(f32x4 (&acc)[2][2][4][2], const Unit& u, int wr, int wc, int fr, int fq) const {
        asm volatile("" : "+v"(fr), "+v"(fq));
        const int gq = ((fq & 1) << 1) | (fq >> 1);
        const int f0 = u.pn * 128 + wc * 32 + 8 * gq;
        {
            const f32x4 g0 = *(const f32x4*)(bg + u.e * FF + f0), g1 = *(const f32x4*)(bg + u.e * FF + f0 + 4);
            const f32x4 u0 = *(const f32x4*)(bu + u.e * FF + f0) + 1.0f, u1 = *(const f32x4*)(bu + u.e * FF + f0 + 4) + 1.0f;
#pragma unroll
            for (int ai = 0; ai < 2; ++ai)
#pragma unroll
                for (int m = 0; m < 4; ++m) { acc[ai][0][m][0] += g0; acc[ai][0][m][1] += g1; acc[ai][1][m][0] += u0; acc[ai][1][m][1] += u1; }
            __builtin_amdgcn_sched_barrier(0);
        }
        unsigned char* dstu = (unsigned char*)ACT + (size_t)u.row0 * FF + u.pn * 128;
        const unsigned voff = (unsigned)((wr * 64 + (fq >> 1) * 16 + fr) * FF + wc * 32 + 16 * (fq & 1));
#pragma unroll
        for (int ai = 0; ai < 2; ++ai)
#pragma unroll
            for (int mp = 0; mp < 2; ++mp) {
                unsigned w[2][2];
#pragma unroll
                for (int mm = 0; mm < 2; ++mm) {
                    const int m = 2 * mp + mm;
                    float o[8];
#pragma unroll
                    for (int n = 0; n < 2; ++n) {
                        const f32x4 gv = acc[ai][0][m][n], uv = acc[ai][1][m][n];
#pragma unroll
                        for (int q = 0; q < 4; q += 2) {
                            const f32x2 gate = {fminf(gv[q], 7.0f), fminf(gv[q + 1], 7.0f)};
                            const f32x2 up1 = {__builtin_amdgcn_fmed3f(uv[q], -6.0f, 8.0f), __builtin_amdgcn_fmed3f(uv[q + 1], -6.0f, 8.0f)};
                            const f32x2 r = up1 * (gate * sig2(gate, -1.4426950408889634f * 1.702f));
                            o[n * 4 + q] = r.x; o[n * 4 + q + 1] = r.y;
                        }
                    }
                    w[mm][0] = pk_fp8x4(o[0], o[1], o[2], o[3]); w[mm][1] = pk_fp8x4(o[4], o[5], o[6], o[7]);
                    __builtin_amdgcn_sched_barrier(0);
                }
                const auto r0 = __builtin_amdgcn_permlane32_swap(w[0][0], w[1][0], false, false), r1 = __builtin_amdgcn_permlane32_swap(w[0][1], w[1][1], false, false);
                const v4u W = {r0[0], r1[0], r0[1], r1[1]};
                const int rl = ai * 128 + wr * 64 + (2 * mp + (fq >> 1)) * 16 + fr;
                if (rl < u.nvalid) *(v4u*)(dstu + (voff + (unsigned)((ai * 128 + mp * 32) * FF))) = W;
            }
#else
    __device__ __forceinline__ void operator()(const f32x4 (&acc)[2][2][4][2], const Unit& u, int wr, int wc, int fr, int fq) const {
        const int f0 = u.pn * 128 + wc * 32 + 8 * fq;
        const f32x4 g0 = *(const f32x4*)(bg + u.e * FF + f0), g1 = *(const f32x4*)(bg + u.e * FF + f0 + 4), u0 = *(const f32x4*)(bu + u.e * FF + f0), u1 = *(const f32x4*)(bu + u.e * FF + f0 + 4);
#pragma unroll
        for (int ai = 0; ai < 2; ++ai)
#pragma unroll
            for (int m = 0; m < 4; ++m) {
                const int rl = ai * 128 + wr * 64 + m * 16 + fr;
                if (rl < u.nvalid) {
                    float o[8];
#pragma unroll
                    for (int n = 0; n < 2; ++n) {
                        const f32x4 gv = acc[ai][0][m][n] + (n ? g1 : g0), uv = acc[ai][1][m][n] + (n ? u1 : u0);
#pragma unroll
                        for (int q = 0; q < 4; q += 2) {
                            const f32x2 gate = {fminf(gv[q], 7.0f), fminf(gv[q + 1], 7.0f)};
                            const f32x2 up = {__builtin_amdgcn_fmed3f(uv[q], -7.0f, 7.0f), __builtin_amdgcn_fmed3f(uv[q + 1], -7.0f, 7.0f)};
                            const f32x2 r = (up + 1.0f) * (gate * sig2(gate, -1.4426950408889634f * 1.702f));
                            o[n * 4 + q] = r.x; o[n * 4 + q + 1] = r.y;
                        }
                    }
#if MOE2_F8
                    v2u w; w.x = pk_fp8x4(o[0], o[1], o[2], o[3]); w.y = pk_fp8x4(o[4], o[5], o[6], o[7]);
                    *(v2u*)((unsigned char*)ACT + (size_t)(u.row0 + rl) * FF + f0) = w;
#else
                    v4u w; w.x = cvt_pk_bf16(o[0], o[1]); w.y = cvt_pk_bf16(o[2], o[3]); w.z = cvt_pk_bf16(o[4], o[5]); w.w = cvt_pk_bf16(o[6], o[7]);
                    *(v4u*)(ACT + (size_t)(u.row0 + rl) * FF + f0) = w;
#endif
                }
            }
#endif
    }
};
struct EpiMoe2 {
    static constexpr bool PERM = true; static constexpr int NVM = (MOE2_WIDE ? 8 : 0);
    float* out; unsigned char* ws; const int* tokk; const float* bd;
    __device__ __forceinline__ void operator()(const f32x4 (&acc)[2][2][4][2], const Unit& u, int wr, int wc, int fr, int fq) const {
#if MOE2_WIDE
        const int c0 = u.pn * 256 + wc * 64 + 16 * fq;
#else
        const int c0 = u.pn * 256 + wc * 32 + 8 * fq;
#endif
        f32x4 bv[2][2];
#pragma unroll
        for (int bj = 0; bj < 2; ++bj)
#pragma unroll
            for (int n = 0; n < 2; ++n) bv[bj][n] = *(const f32x4*)(bd + u.e * D + c0 + (MOE2_WIDE ? bj * 8 : bj * 128) + 4 * n);
        int tks[2][4];
#pragma unroll
        for (int ai = 0; ai < 2; ++ai)
#pragma unroll
            for (int m = 0; m < 4; ++m) { const int rl = ai * 128 + wr * 64 + m * 16 + fr; tks[ai][m] = (rl < u.nvalid) ? tokk[(size_t)u.e * CAP + u.slot0 + rl] : 0; }
#pragma unroll
        for (int ai = 0; ai < 2; ++ai)
#pragma unroll
            for (int m = 0; m < 4; ++m) {
                const int rl = ai * 128 + wr * 64 + m * 16 + fr;
                if (rl < u.nvalid) {
                    const int tk = tks[ai][m], tok = tk >> 2, k = tk & 3;
#if YS_F8
                    unsigned char* dst = (k == 0) ? (unsigned char*)(out + (size_t)tok * D) : (k == 3) ? (ws + WS_YS3) + (size_t)tok * D : (ws + WS_YS12) + ((size_t)(k - 1) * NTOK + tok) * D;
#if MOE2_WIDE
                    const f32x4 v0 = acc[ai][0][m][0] + bv[0][0], v1 = acc[ai][0][m][1] + bv[0][1], v2 = acc[ai][1][m][0] + bv[1][0], v3 = acc[ai][1][m][1] + bv[1][1];
                    v4u w; w.x = pk_fp8x4(v0[0], v0[1], v0[2], v0[3]); w.y = pk_fp8x4(v1[0], v1[1], v1[2], v1[3]); w.z = pk_fp8x4(v2[0], v2[1], v2[2], v2[3]); w.w = pk_fp8x4(v3[0], v3[1], v3[2], v3[3]);
                    *(v4u*)(dst + c0) = w;
#else
#pragma unroll
                    for (int bj = 0; bj < 2; ++bj) { const f32x4 v0 = acc[ai][bj][m][0] + bv[bj][0], v1 = acc[ai][bj][m][1] + bv[bj][1];
                        v2u w; w.x = pk_fp8x4(v0[0], v0[1], v0[2], v0[3]); w.y = pk_fp8x4(v1[0], v1[1], v1[2], v1[3]);
                        *(v2u*)(dst + c0 + bj * 128) = w; }
#endif
#else
                    bf16* dst = (k == 0) ? (bf16*)(out + (size_t)tok * D) : (k == 3) ? (bf16*)(ws + WS_YS3) + (size_t)tok * D : (bf16*)(ws + WS_YS12) + ((size_t)(k - 1) * NTOK + tok) * D;
#pragma unroll
                    for (int bj = 0; bj < 2; ++bj) { const f32x4 v0 = acc[ai][bj][m][0] + bv[bj][0], v1 = acc[ai][bj][m][1] + bv[bj][1];
                        v4u w; w.x = cvt_pk_bf16(v0[0], v0[1]); w.y = cvt_pk_bf16(v0[2], v0[3]); w.z = cvt_pk_bf16(v1[0], v1[1]); w.w = cvt_pk_bf16(v1[2], v1[3]);
                        *(v4u*)(dst + c0 + bj * 128) = w; }
#endif
                }
            }
    }
};
__device__ __forceinline__ void p7_fast(const Args& a, LAS unsigned char* lds, LAS int* T) {
    SchedMoE<true> S{T, (const char*)(a.ws + WS_H2), (const char*)(a.ws + WS_WGU), (const int*)(a.ws + WS_TOKK), D, D, D, 8, (int)gridDim.x, (int)blockIdx.x, (size_t)2048 * D, (REP_GEMM == 10) ? 2 : 1, MOE1_F8 ? 1 : 2, 127, 127 - 5, (REP_EPI == 10) ? 1 : 0, (TSTAMP_GEMM == 10) ? 1 : 0};
    EpiMoe1 E{(bf16*)(a.ws + WS_ACT), a.in[I_BG], a.in[I_BU]};
    pg8::gemm_phase<EpiMoe1, SchedMoE<true>, ALIGN_MOE, MOE1_F8 != 0>(lds, S, E);
}
__device__ __forceinline__ void p8_fast(const Args& a, LAS unsigned char* lds, LAS int* T) {
    SchedMoE<false> S{T, (const char*)(a.ws + WS_ACT), (const char*)(a.ws + WS_WD), (const int*)(a.ws + WS_TOKK), FF, FF, FF, 4, (int)gridDim.x, (int)blockIdx.x, (size_t)D * FF, (REP_GEMM == 11) ? 2 : 1, MOE2_F8 ? 1 : 2, 127, MOE2_F8 ? 127 - 5 : 127, (REP_EPI == 11) ? 1 : 0, (TSTAMP_GEMM == 11) ? 1 : 0};
    EpiMoe2 E{a.out, a.ws, (const int*)(a.ws + WS_TOKK), a.in[I_BD]};
    pg8::gemm_phase<EpiMoe2, SchedMoE<false>, ALIGN_MOE, MOE2_F8 != 0>(lds, S, E);
}

struct EpiSloc {
    static constexpr bool PERM = false; static constexpr int NVM = 0;
    float* SL;
    __device__ __forceinline__ void operator()(const f32x4 (&acc)[2][2][4][2], const Unit& u, int wr, int wc, int fr, int fq) const {
#pragma unroll
        for (int ai = 0; ai < 2; ++ai)
#pragma unroll
            for (int m = 0; m < 4; ++m) {
                float* rowp = SL + (size_t)(u.pm * 256 + ai * 128 + wr * 64 + m * 16 + fr) * (NG * 128) + u.e * 128 + wc * 32 + 4 * fq;
#pragma unroll
                for (int n = 0; n < 2; ++n) *(f32x4*)(rowp + n * 16) = acc[ai][0][m][n];
            }
    }
};
struct EpiY {
    static constexpr bool PERM = true; static constexpr int NVM = 0;
    bf16* YG;
    __device__ __forceinline__ void operator()(const f32x4 (&acc)[2][2][4][2], const Unit& u, int wr, int wc, int fr, int fq) const {
#pragma unroll
        for (int ai = 0; ai < 2; ++ai)
#pragma unroll
            for (int m = 0; m < 4; ++m) {
                const int r = u.pm * 256 + ai * 128 + wr * 64 + m * 16 + fr;
#pragma unroll
                for (int bj = 0; bj < 2; ++bj) {
                    const int c0 = u.pn * 256 + bj * 128 + wc * 32 + 8 * fq, t = c0 >> 4, h0 = c0 & 15;
                    const f32x4 v0 = acc[ai][bj][m][0], v1 = acc[ai][bj][m][1];
                    const f32x2 z0 = gelu2((f32x2){v0[0], v0[1]}), z1 = gelu2((f32x2){v0[2], v0[3]}), z2 = gelu2((f32x2){v1[0], v1[1]}), z3 = gelu2((f32x2){v1[2], v1[3]});
                    v4u w; w.x = cvt_pk_bf16(z0.x, z0.y); w.y = cvt_pk_bf16(z1.x, z1.y); w.z = cvt_pk_bf16(z2.x, z2.y); w.w = cvt_pk_bf16(z3.x, z3.y);
                    *(v4u*)(YG + (size_t)(r * 32 + t) * DSSM + u.e * GH + h0) = w;
                }
            }
    }
};
__device__ __forceinline__ void p3a_fast(const Args& a, LAS unsigned char* lds) {
    pg8::SchedGroup S{(const bf16*)(a.ws + WS_U2), (const bf16*)(a.ws + WS_BTS), 512, U2LD, 512, NROW2 / 256, 1, NG, (int)gridDim.x, (int)blockIdx.x, (size_t)U2G, (size_t)256 * 512, (REP_GEMM == 3) ? 2 : 1, 1 << 30};
    EpiSloc E{(float*)(a.ws + WS_SLOC)};
    pg8::gemm_phase<EpiSloc, pg8::SchedGroup, true>(lds, S, E);
}
__device__ __forceinline__ void p3c_fast(const Args& a, LAS unsigned char* lds) {
    pg8::SchedGroup S{(const bf16*)(a.ws + WS_U2), (const bf16*)(a.ws + WS_BTY), U2G, U2LD, U2G, NROW2 / 256, 2, NG, (int)gridDim.x, (int)blockIdx.x, (size_t)U2G, (size_t)512 * U2G, (REP_GEMM == 5) ? 2 : 1, 1 << 30};
    EpiY E{(bf16*)(a.ws + WS_YG)};
    pg8::gemm_phase<EpiY, pg8::SchedGroup, true>(lds, S, E);
}
__device__ __forceinline__ void p3c_pair(const Args& a, LAS unsigned char* lds, int g, int pm) {
    pg8::SchedGroup S{(const bf16*)(a.ws + WS_U2), (const bf16*)(a.ws + WS_BTY), U2G, U2LD, U2G, NROW2 / 256, 2, NG, NROW2 / 256, g * 2 * (NROW2 / 256) + pm, (size_t)U2G, (size_t)512 * U2G, 1, 2};
    EpiY E{(bf16*)(a.ws + WS_YG)};
    pg8::gemm_phase<EpiY, pg8::SchedGroup, true>(lds, S, E);
}
__device__ __forceinline__ void p3b_scan(const Args& a, LAS float* sm, bool fused) {
    const float* SL = (const float*)(a.ws + WS_SLOC); bf16* U2 = (bf16*)(a.ws + WS_U2);
    const int t = threadIdx.x, p = t & 63, seg = t >> 6;
    for (int task = blockIdx.x; task < NB * NG; task += gridDim.x) {
        const int b = fused ? (task % (NROW2 / 256)) : (task / NG), g = fused ? (task / (NROW2 / 256)) : (task % NG);
        const float lr = a.in[I_LRE][g * NP + p], li = a.in[I_LIM][g * NP + p], dt = expf(a.in[I_LDT][g]);
        float ar, ai, br, bi;
        { const float m = expf(32.f * lr * dt); float s2, c2; sincosf(32.f * li * dt, &s2, &c2); ar = m * c2; ai = m * s2; }
        { const float m = expf(1024.f * lr * dt); float s2, c2; sincosf(1024.f * li * dt, &s2, &c2); br = m * c2; bi = m * s2; }
        const float* sl = SL + (size_t)(b * NCH + seg * 32) * (NG * 128) + g * 128 + p;
        float sr = 0.f, si = 0.f;
        float lre[32], lim[32];
#pragma unroll
        for (int c = 0; c < 32; ++c) { lre[c] = sl[(size_t)c * (NG * 128)]; lim[c] = sl[(size_t)c * (NG * 128) + 64]; }
#pragma unroll
        for (int c = 0; c < 32; ++c) { const float nr = ar * sr - ai * si + lre[c], ni = ar * si + ai * sr + lim[c]; sr = nr; si = ni; }
        sm[(seg * 64 + p) * 2] = sr; sm[(seg * 64 + p) * 2 + 1] = si;
        __syncthreads();
        float cr = 0.f, ci = 0.f;
        for (int s = 0; s < seg; ++s) { const float er = sm[(s * 64 + p) * 2], ei = sm[(s * 64 + p) * 2 + 1]; const float nr = br * cr - bi * ci + er, ni = br * ci + bi * cr + ei; cr = nr; ci = ni; }
        bf16* up = U2 + (size_t)(b * NCH + seg * 32) * U2LD + g * U2G + 512 + p;
        sr = cr; si = ci;
#pragma unroll
        for (int c = 0; c < 32; ++c) {
            up[(size_t)c * U2LD] = (bf16)f2bf(sr); up[(size_t)c * U2LD + 64] = (bf16)f2bf(si);
            const float nr = ar * sr - ai * si + lre[c], ni = ar * si + ai * sr + lim[c]; sr = nr; si = ni;
        }
        __syncthreads();
    }
}


#define XB_TMO      128
#define XB_XCNT(j)  (256  + 64 * (j))
#define XB_XSUB(j)  (1280 + 64 * (j))
#define XB_XGEN(j)  (2304 + 64 * (j))
#define XB_TOP      3328
#define XB_TOPGEN   3392
#define XCD_BAR_WORDS 3456
#define XB_SPIN_CAP (1u << 22)
__device__ __forceinline__ unsigned xb_ld(unsigned* p)              { return __hip_atomic_load(p, __ATOMIC_RELAXED, __HIP_MEMORY_SCOPE_AGENT); }
__device__ __forceinline__ unsigned xb_add(unsigned* p, unsigned v) { return __hip_atomic_fetch_add(p, v, __ATOMIC_RELAXED, __HIP_MEMORY_SCOPE_AGENT); }
__device__ __forceinline__ unsigned xb_xcc_id() { return (unsigned)__builtin_amdgcn_s_getreg((3 << 11) | 20) & 0xFu; }
#define XB_SPIN(cond, bar) do { unsigned _sp = 0; while (cond) { __builtin_amdgcn_s_sleep(1); \
    if ((++_sp & 255u) == 0u) { if (xb_ld(&(bar)[XB_TMO])) break; if (_sp > XB_SPIN_CAP) { atomicAdd(&(bar)[XB_TMO], 1u); break; } } } } while (0)
struct XcdBarrier { unsigned* bar; unsigned x; volatile LAS unsigned* st; };
__device__ __forceinline__ XcdBarrier xcd_barrier_post(unsigned* bar, volatile LAS unsigned* st) {
    XcdBarrier b; b.bar = bar; b.x = xb_xcc_id(); b.st = st;
    if (threadIdx.x == 0) (void)xb_add(&bar[XB_XCNT(b.x)], 1u);
    return b;
}
__device__ __forceinline__ void xcd_barrier_complete(unsigned* bar, unsigned x, unsigned& nloc, unsigned& nx) {
    const unsigned G = gridDim.x * gridDim.y * gridDim.z;
    unsigned sum, cnt, mine, sp = 0u;
    for (;;) {
        sum = 0u; cnt = 0u; mine = 0u;
#pragma unroll
        for (unsigned j = 0; j < 16; ++j) { const unsigned c = xb_ld(&bar[XB_XCNT(j)]); sum += c; cnt += (c > 0u) ? 1u : 0u; mine = (j == x) ? c : mine; }
        if (sum == G) break;
        __builtin_amdgcn_s_sleep(1);
        if ((++sp & 255u) == 0u) { if (xb_ld(&bar[XB_TMO])) break; if (sp > XB_SPIN_CAP) { atomicAdd(&bar[XB_TMO], 1u); break; } }
    }
    nloc = mine > 0u ? mine : 1u; nx = cnt > 0u ? cnt : 1u;
}
__device__ __forceinline__ void xcd_barrier(const XcdBarrier& b) {
    asm volatile("s_waitcnt vmcnt(0)" ::: "memory");
    __syncthreads();
    if (threadIdx.x == 0) {
        unsigned* bar = b.bar;
        __builtin_amdgcn_s_waitcnt(0);
        unsigned nloc = b.st[0], nx = b.st[1];
        if (nloc == 0u) { xcd_barrier_complete(bar, b.x, nloc, nx); b.st[0] = nloc; b.st[1] = nx; }
        const unsigned old = xb_add(&bar[XB_XSUB(b.x)], 1u);
        const unsigned gen = old / nloc;
        if (old + 1u == (gen + 1u) * nloc) {
            __builtin_amdgcn_fence(__ATOMIC_RELEASE, "agent");
            asm volatile("s_waitcnt vmcnt(0)" ::: "memory");
            const unsigned og = xb_add(&bar[XB_TOP], 1u);
            const unsigned tg = og / nx;
            if (og + 1u == (tg + 1u) * nx) xb_add(&bar[XB_TOPGEN], 1u);
            else XB_SPIN(xb_ld(&bar[XB_TOPGEN]) == tg, bar);
            __builtin_amdgcn_fence(__ATOMIC_ACQUIRE, "agent");
            xb_add(&bar[XB_XGEN(b.x)], 1u);
            asm volatile("s_waitcnt vmcnt(0)" ::: "memory");
        } else {
            XB_SPIN(xb_ld(&bar[XB_XGEN(b.x)]) == gen, bar);
            __builtin_amdgcn_fence(__ATOMIC_ACQUIRE, "agent");
            asm volatile("s_waitcnt vmcnt(0)" ::: "memory");
        }
    }
    __syncthreads();
}

__device__ __forceinline__ void p1_router_item(const Args& a, int it, int lane) {
    const float* rw = a.in[I_RW]; const float* g = a.in[I_N2G]; const float* mod = (const float*)(a.ws + WS_MOD);
    bf16* RWH = (bf16*)(a.ws + WS_RWT); bf16* RWL = RWH + NB * NE * D; float* rbias = (float*)(a.ws + WS_RWT + 524288);
    {
        const int b = it >> 5, e = it & 31; float bs = 0.f;
#pragma unroll 4
        for (int j = 0; j < 16; ++j) {
            const int k = lane + 64 * j; const float w = rw[k * NE + e], wp = w * g[k] * (1.0f + mod[b * 6 * D + 4 * D + k]);
            const unsigned hi = f2bf(wp), lo = f2bf(wp - bf2f(hi));
            RWH[(size_t)(b * NE + e) * D + k] = (bf16)hi; RWL[(size_t)(b * NE + e) * D + k] = (bf16)lo;
            bs += mod[b * 6 * D + 3 * D + k] * w;
        }
        bs = wave_sum(bs);
        if (lane == 0) rbias[b * NE + e] = bs + a.in[I_RB][e];
    }
}
__device__ __forceinline__ void top4_of8(float (&v)[8], const int (&e)[8], float (&tv)[4], int (&ti)[4]) {
#pragma unroll
    for (int r = 0; r < 4; ++r) {
        float bv = v[0]; int be = e[0];
#pragma unroll
        for (int i = 1; i < 8; ++i) { const bool t = v[i] > bv || (v[i] == bv && e[i] < be); bv = t ? v[i] : bv; be = t ? e[i] : be; }
        tv[r] = bv; ti[r] = be;
#pragma unroll
        for (int i = 0; i < 8; ++i) v[i] = (e[i] == be) ? -3.0e38f : v[i];
    }
}
__device__ __forceinline__ bf16x8 pack_hi8(const f32x4 x0, const f32x4 x1, bf16x8& lo) {
    const float f[8] = {x0[0], x0[1], x0[2], x0[3], x1[0], x1[1], x1[2], x1[3]};
    v4u h, l;
#pragma unroll
    for (int i = 0; i < 4; ++i) { const unsigned w = pk2(f[2 * i], f[2 * i + 1]); h[i] = w; l[i] = pk2(f[2 * i] - bflo(w), f[2 * i + 1] - bfhi(w)); }
    lo = __builtin_bit_cast(bf16x8, l);
    return __builtin_bit_cast(bf16x8, h);
}
__device__ __forceinline__ void p5_fast(const Args& a, LAS unsigned char* lds, int lane, int wave) {
    LAS unsigned* hist = (LAS unsigned*)(lds + 131072 + 1024);
    LAS unsigned* basearr = hist + 64;
    const bf16* RWH = (const bf16*)(a.ws + WS_RWT); const bf16* RWL = RWH + NB * NE * D; const float* rbias = (const float*)(a.ws + WS_RWT + 524288);
    const float* g = a.in[I_N2G]; const float* mod = (const float*)(a.ws + WS_MOD);
    bf16* H2 = (bf16*)(a.ws + WS_H2); float* topw = (float*)(a.ws + WS_TOPW); int* tokk = (int*)(a.ws + WS_TOKK); unsigned* cnt = (unsigned*)(a.ws + WS_CTL) + CW_CNT;
    const int col = lane & 15, q = lane >> 4;
    LAS float* gam = (LAS float*)(lds + 131072 + 8192); LAS float* bet = gam + D;
    int lds_batch = -1;
    if (threadIdx.x < 96) hist[threadIdx.x] = 0u;
    __syncthreads();
    int iter = 0;
    for (int task0 = blockIdx.x * NWAVES; task0 < NTOK / 16; task0 += gridDim.x * NWAVES, ++iter) {
        const int task = task0 + wave; const bool active = task < NTOK / 16;
        float tv[4] = {0.f, 0.f, 0.f, 0.f}; int ti[4] = {0, 1, 2, 3}; unsigned rank[4] = {0u, 0u, 0u, 0u};
        const int tok = task * 16 + col, b = (task * 16) >> 13;
        LAS unsigned* hcur = hist + (iter & 1) * 32;
        {
            const int bb = (task0 * 16) >> 13;
            if (bb != lds_batch) {
                __syncthreads();
                const v4u* srch = (const v4u*)(RWH + (size_t)bb * NE * D); const v4u* srcl = (const v4u*)(RWL + (size_t)bb * NE * D);
#pragma unroll
                for (int i = 0; i < 8; ++i) { const int ci = threadIdx.x + NTHR * i, e = ci >> 7, c = ci & 127, d = (e * 128 + (c ^ (e & 15))) * 16;
                    *(LAS v4u*)(lds + d) = srch[ci]; *(LAS v4u*)(lds + 65536 + d) = srcl[ci]; }
                for (int k = threadIdx.x; k < D; k += NTHR) { gam[k] = g[k] * (1.0f + mod[bb * 6 * D + 4 * D + k]); bet[k] = mod[bb * 6 * D + 3 * D + k]; }
                lds_batch = bb;
                __syncthreads();
            }
        }
        if (active) {
            float rstd;
            { const f32x4* sp = (const f32x4*)((const float*)(a.ws + WS_SSQ) + (size_t)tok * 16); const f32x4 s0 = sp[0], s1 = sp[1], s2 = sp[2], s3 = sp[3];
              const float ss = (((s0[0] + s0[1]) + (s0[2] + s0[3])) + ((s1[0] + s1[1]) + (s1[2] + s1[3]))) + (((s2[0] + s2[1]) + (s2[2] + s2[3])) + ((s3[0] + s3[1]) + (s3[2] + s3[3])));
              rstd = rsqrtf(ss * (1.f / D) + 1e-6f); }
            f32x4 acc0 = {0.f, 0.f, 0.f, 0.f}, acc1 = {0.f, 0.f, 0.f, 0.f};
            const bf16* hrow = (const bf16*)(a.out + (size_t)tok * D) + D + 8 * q; const bf16* lrow = (const bf16*)(a.out + (size_t)tok * D) + 8 * q;
            v4u rh[8], rl[8];
#pragma unroll
            for (int i = 0; i < 8; ++i) { rh[i] = __builtin_nontemporal_load((const v4u*)(hrow + 32 * i)); rl[i] = __builtin_nontemporal_load((const v4u*)(lrow + 32 * i)); }
            const int e0 = col, e1 = 16 + col;
#pragma unroll 1
            for (int so = 0; so < 32; so += 8) {
#pragma unroll
                for (int si = 0; si < 8; ++si) {
                    const int st = so + si, k0 = 32 * st, k = k0 + 8 * q, c = 4 * st + q;
                    const v4u xh = rh[si], xl = rl[si];
                    { const int kn = (st + 8 < 32) ? k0 + 256 : 0; rh[si] = __builtin_nontemporal_load((const v4u*)(hrow + kn)); rl[si] = __builtin_nontemporal_load((const v4u*)(lrow + kn)); }
                    asm volatile("" ::: "memory");
                    const bf16x8 a0h = *(const LAS bf16x8*)(lds + (e0 * 128 + (c ^ (e0 & 15))) * 16), a0l = *(const LAS bf16x8*)(lds + 65536 + (e0 * 128 + (c ^ (e0 & 15))) * 16);
                    const bf16x8 a1h = *(const LAS bf16x8*)(lds + (e1 * 128 + (c ^ (e1 & 15))) * 16), a1l = *(const LAS bf16x8*)(lds + 65536 + (e1 * 128 + (c ^ (e1 & 15))) * 16);
                    const f32x4 g0 = *(const LAS f32x4*)(gam + k), g1 = *(const LAS f32x4*)(gam + k + 4), s0 = *(const LAS f32x4*)(bet + k), s1 = *(const LAS f32x4*)(bet + k + 4);
                    const bf16x8 bh = __builtin_bit_cast(bf16x8, xh), bl = __builtin_bit_cast(bf16x8, xl);
                    acc0 = __builtin_amdgcn_mfma_f32_16x16x32_bf16(a0h, bh, acc0, 0, 0, 0); acc0 = __builtin_amdgcn_mfma_f32_16x16x32_bf16(a0h, bl, acc0, 0, 0, 0); acc0 = __builtin_amdgcn_mfma_f32_16x16x32_bf16(a0l, bh, acc0, 0, 0, 0);
                    acc1 = __builtin_amdgcn_mfma_f32_16x16x32_bf16(a1h, bh, acc1, 0, 0, 0); acc1 = __builtin_amdgcn_mfma_f32_16x16x32_bf16(a1h, bl, acc1, 0, 0, 0); acc1 = __builtin_amdgcn_mfma_f32_16x16x32_bf16(a1l, bh, acc1, 0, 0, 0);
                    const f32x4 x0 = {bflo(xh.x) + bflo(xl.x), bfhi(xh.x) + bfhi(xl.x), bflo(xh.y) + bflo(xl.y), bfhi(xh.y) + bfhi(xl.y)};
                    const f32x4 x1 = {bflo(xh.z) + bflo(xl.z), bfhi(xh.z) + bfhi(xl.z), bflo(xh.w) + bflo(xl.w), bfhi(xh.w) + bfhi(xl.w)};
                    const f32x4 h0 = x0 * rstd * g0 + s0, h1 = x1 * rstd * g1 + s1;
#if MOE1_F8
                    v2u hw; hw.x = pk_fp8x4(h0[0], h0[1], h0[2], h0[3]); hw.y = pk_fp8x4(h1[0], h1[1], h1[2], h1[3]);
                    *(v2u*)((unsigned char*)H2 + (size_t)tok * D + 8 * q + k0) = hw;
#else
                    v4u hw; hw.x = pk2(h0[0], h0[1]); hw.y = pk2(h0[2], h0[3]); hw.z = pk2(h1[0], h1[1]); hw.w = pk2(h1[2], h1[3]);
                    *(v4u*)(H2 + (size_t)tok * D + 8 * q + k0) = hw;
#endif
                    asm volatile("" ::: "memory");
                }
            }
            STAMP(19);
            float v[8]; int e[8];
#pragma unroll
            for (int j = 0; j < 4; ++j) { e[j] = 4 * q + j; e[4 + j] = 16 + 4 * q + j; v[j] = rstd * acc0[j] + rbias[b * NE + 4 * q + j]; v[4 + j] = rstd * acc1[j] + rbias[b * NE + 16 + 4 * q + j]; }
            top4_of8(v, e, tv, ti);
#pragma unroll
            for (int off = 16; off <= 32; off <<= 1) {
                float v2[8]; int e2[8];
#pragma unroll
                for (int r = 0; r < 4; ++r) { v2[r] = tv[r]; e2[r] = ti[r]; v2[4 + r] = __shfl_xor(tv[r], off); e2[4 + r] = __shfl_xor(ti[r], off); }
                top4_of8(v2, e2, tv, ti);
            }
            if (q == 0) {
#pragma unroll
                for (int r = 0; r < 4; ++r) rank[r] = __hip_atomic_fetch_add(hcur + ti[r], 1u, __ATOMIC_RELAXED, __HIP_MEMORY_SCOPE_WORKGROUP);
            }
        }
        STAMP(20);
        __syncthreads();
        STAMP(21);
        if (threadIdx.x < 32) { const unsigned n = hcur[threadIdx.x]; basearr[threadIdx.x] = n ? atomicAdd(cnt + threadIdx.x, n) : 0u; hist[((iter + 1) & 1) * 32 + threadIdx.x] = 0u; }
        __syncthreads();
        if (active && q == 0) {
            const float e1 = __expf(tv[1] - tv[0]), e2 = __expf(tv[2] - tv[0]), e3 = __expf(tv[3] - tv[0]), inv = 1.f / (1.f + e1 + e2 + e3);
            const float w[4] = {inv, e1 * inv, e2 * inv, e3 * inv};
#pragma unroll
            for (int r = 0; r < 4; ++r) { const unsigned slot = basearr[ti[r]] + rank[r]; tokk[(size_t)ti[r] * CAP + slot] = tok * 4 + r; }
            *(f32x4*)(topw + tok * 4) = (f32x4){w[0], w[1], w[2], w[3]};
        }
    }
}

constexpr int NPHASE = 13;
__global__ void __launch_bounds__(NTHR, 2) fwd_kernel(Args a) {
    extern __shared__ __attribute__((aligned(16))) unsigned char lds_raw[];
    LAS unsigned char* lds = (LAS unsigned char*)lds_raw;
    LAS float* sm = (LAS float*)lds;
    LAS int* T = (LAS int*)(lds + 131072);
#if USE_CG_SYNC
    cg::grid_group grid = cg::this_grid();
#else
    volatile LAS unsigned* MISC = (volatile LAS unsigned*)(lds + 131072 + 2048);
    if (threadIdx.x < 32) MISC[threadIdx.x] = 0u;
    __syncthreads();
    XcdBarrier xbar = xcd_barrier_post((unsigned*)(a.ws + WS_CTL) + CW_BAR, MISC + 8);
#endif
    const int tid = threadIdx.x, lane = tid & 63, wave = __builtin_amdgcn_readfirstlane(tid >> 6);
    const int gw = blockIdx.x * NWAVES + wave, ngw = gridDim.x * NWAVES;
    const int lo = a.ph_lo, hi = a.ph_hi;
#define IN(k) (lo <= (k) && (k) < hi)
#if TIME_PHASE >= 0
    LAS unsigned long long* TS = (LAS unsigned long long*)(lds + 131072 + 4096);
#endif
#if USE_CG_SYNC
#define SEAM(k) do { if (IN(k) && IN((k) + 1)) grid.sync(); } while (0)
#else
#define SEAM(k) do { if (IN(k) && IN((k) + 1)) xcd_barrier(xbar); } while (0)
#endif
#define REP(k) _Pragma("nounroll") for (int _r = 0; _r < (((REP_MASK >> (k)) & 1) ? a.rep_mask : 1); ++_r)
    STAMP(0); if (IN(0)) { REP(0) { p0_mod(a, sm); STAMP(16); p0_s5_mats(a, sm); __syncthreads(); STAMP(17); p0_convert(a, gw, ngw, lane); __syncthreads(); STAMP(18); } }
    STAMP(1); if (IN(0)) { mod_wait(a); p1_dynamic(a, lane); } SEAM(1);
    STAMP(2); if (IN(2)) { REP(2) { p2_fast(a, lds); } } SEAM(2);
    STAMP(3); if (IN(3)) { p3a_fast(a, lds); if (gridDim.x >= NB * NG) { asm volatile("s_waitcnt vmcnt(0)" ::: "memory"); __syncthreads(); if (blockIdx.x < NB * NG) { p3b_scan(a, sm, true); asm volatile("s_waitcnt vmcnt(0)" ::: "memory"); __syncthreads(); p3c_pair(a, lds, blockIdx.x / (NROW2 / 256), blockIdx.x % (NROW2 / 256)); } __syncthreads(); p3e_conv(a, sm, lane); } else p3e_conv(a, sm, lane); }
    if (gridDim.x < NB * NG) { SEAM(3); if (IN(4)) { p3b_scan(a, sm, false); __syncthreads(); p3e_conv(a, sm, lane); } }
    STAMP(4); if (gridDim.x < NB * NG) SEAM(4);
    STAMP(5); if (IN(5) && gridDim.x < NB * NG) { p3c_fast(a, lds); } SEAM(5);
    STAMP(6); if (IN(6)) { REP(6) { p3d_fast(a, lds); } } SEAM(6);
    STAMP(7); if (IN(7)) { p3e_norm(a, gw, ngw, lane); } SEAM(7);
    STAMP(8); if (IN(8)) { REP(8) { p4_fast(a, lds); } } SEAM(8);
    STAMP(9); if (IN(9)) { p5_fast(a, lds, lane, wave); } SEAM(9);
    STAMP(10); if (IN(10)) { moe_tables(a, T); REP(10) { p7_fast(a, lds, T); } } SEAM(10);
    STAMP(11); if (IN(11)) { moe_tables(a, T); REP(11) { p8_fast(a, lds, T); } } SEAM(11);
    STAMP(12); if (IN(12)) { p9_final(a, gw, ngw, lane); }
#undef REP
    STAMP(13);
#if TIME_PHASE >= 0
    if (blockIdx.x == 0 && threadIdx.x == 0) { const unsigned long long dt = TS[TIME_B] - TS[TIME_A], t1 = TS[13]; while (__builtin_amdgcn_s_memrealtime() - t1 < 8ull * dt) __builtin_amdgcn_s_sleep(8); }
#endif
#undef IN
#undef SEAM
}

#ifndef N_LAUNCHES
#define N_LAUNCHES 1
#endif
extern "C" void kernel_launch(void* const* d_in, const int* in_sizes, int n_in, void* d_out, int out_size, void* d_ws, size_t ws_size, hipStream_t stream) {
    static int grid = 0;
    if (grid == 0) {
        if (n_in != 32 || out_size != NTOK * D || ws_size < WS_END) { fprintf(stderr, "kernel_launch: unexpected problem (n_in %d out %d ws %zu)\n", n_in, out_size, ws_size); grid = -1; return; }
        int dev = 0, cus = 0, per_cu = 0;
        if (hipGetDevice(&dev) != hipSuccess || hipDeviceGetAttribute(&cus, hipDeviceAttributeMultiprocessorCount, dev) != hipSuccess) { grid = -1; return; }
        if (hipFuncSetAttribute((const void*)fwd_kernel, hipFuncAttributeMaxDynamicSharedMemorySize, LDS_BYTES) != hipSuccess) { fprintf(stderr, "kernel_launch: hipFuncSetAttribute failed\n"); grid = -1; return; }
        if (hipOccupancyMaxActiveBlocksPerMultiprocessor(&per_cu, (const void*)fwd_kernel, NTHR, LDS_BYTES) != hipSuccess || per_cu < 1) { fprintf(stderr, "kernel_launch: occupancy query says %d\n", per_cu); (void)hipGetLastError(); per_cu = 1; }
        grid = cus;
    }
    if (grid < 0) return;
    (void)hipMemsetAsync((char*)d_ws + WS_CTL, 0, 65536, stream);
    Args a{};
    for (int i = 0; i < 32; ++i) a.in[i] = (const float*)d_in[i];
    a.out = (float*)d_out; a.ws = (unsigned char*)d_ws; a.rep_mask = 2;
    for (int li = 0; li < N_LAUNCHES; ++li) {
        a.ph_lo = (N_LAUNCHES == 1) ? 0 : li; a.ph_hi = (N_LAUNCHES == 1) ? NPHASE : li + 1;
        void* args[] = {&a};
        hipError_t e = hipLaunchCooperativeKernel((const void*)fwd_kernel, dim3(grid), dim3(NTHR), args, LDS_BYTES, stream);
        if (e != hipSuccess) { fprintf(stderr, "kernel_launch: launch %d failed: %s\n", li, hipGetErrorString(e)); break; }
    }
}
```

```cpp
#include <hip/hip_runtime.h>
#include <hip/hip_cooperative_groups.h>
#include <cstdio>
#include <cstdint>
namespace cg = cooperative_groups;
#define MOE2_WIDE (MOE2_F8 && YS_F8)
#define MOE1_WIDE (MOE1_F8 && MOE2_F8)
#ifndef USE_CG_SYNC
#define USE_CG_SYNC 0
#endif
#ifndef YS_F8
#define YS_F8 1
#endif
#ifndef MOE2_F8
#define MOE2_F8 1
#endif
#ifndef MOE1_F8
#define MOE1_F8 1
#endif
#ifndef TIME_PHASE
#define TIME_PHASE -1
#endif
#ifndef TIME_A
#define TIME_A (TIME_PHASE)
#define TIME_B (TIME_PHASE + 1)
#endif
#ifndef ALIGN_P4
#define ALIGN_P4 true
#endif
#ifndef ALIGN_MOE
#define ALIGN_MOE true
#endif
#ifndef TSTAMP_GEMM
#define TSTAMP_GEMM 0
#endif
#ifndef REP_EPI
#define REP_EPI 0
#endif
#ifndef REP_GEMM
#define REP_GEMM 0
#endif
#ifndef REP_MASK
#define REP_MASK 0
#endif

#define GAS __attribute__((address_space(1)))
#define LAS __attribute__((address_space(3)))
typedef unsigned short bf16;
typedef unsigned v4u __attribute__((ext_vector_type(4)));
typedef unsigned v2u __attribute__((ext_vector_type(2)));
typedef float f32x4 __attribute__((ext_vector_type(4)));
typedef float f32x2 __attribute__((ext_vector_type(2)));
typedef short bf16x8 __attribute__((ext_vector_type(8)));

constexpr int NB = 4, SEQ = 8192, D = 1024, NTOK = NB * SEQ;
constexpr int DSSM = 512, DCONV = 512, NG = 32, GH = 16, NP = 64, DIN = 1536, CW = 31;
constexpr int NE = 32, TOPK = 4, FF = 1024;
constexpr int TCH = 32, NCH = SEQ / TCH, NROW2 = NB * NCH, U2G = 640, U2LD = NG * U2G;
constexpr int NWAVES = 8, NTHR = 512;
constexpr int LDS_BYTES = 147456;
constexpr int CAP = NTOK;

enum { I_X = 0, I_C, I_ADAW, I_ADAB, I_N1G, I_WIN, I_LRE, I_LIM, I_LDT, I_BRE, I_BIM, I_CRE, I_CIM, I_DSK, I_WGLU, I_BGLU, I_CONVW, I_CONVB, I_LNG, I_LNB,
       I_ONG, I_WOUT, I_N2G, I_RW, I_RB, I_WG, I_BG, I_WU, I_BU, I_WD, I_BD, I_FG };

constexpr size_t MiB = 1u << 20;
constexpr size_t WS_WIN = 0 * MiB;
constexpr size_t WS_WGLU = 3 * MiB;
constexpr size_t WS_WOUT = 4 * MiB;
constexpr size_t WS_BTS = 6 * MiB;
constexpr size_t WS_BTY = 14 * MiB;
constexpr size_t WS_H2 = 0 * MiB;
constexpr size_t WS_YS3 = 0 * MiB;
constexpr size_t WS_CTL = 64 * MiB;
constexpr size_t WS_MOD = 64 * MiB + 65536;
constexpr size_t WS_TOPW = 65 * MiB;
constexpr size_t WS_TOKK = 66 * MiB;
constexpr size_t WS_RWT = 70 * MiB;
constexpr size_t WS_ACT = 72 * MiB;
constexpr size_t WS_SSQ = 72 * MiB;
constexpr size_t WS_H1 = 72 * MiB;
constexpr size_t WS_U2 = 136 * MiB;
constexpr size_t WS_Z = 176 * MiB;
constexpr size_t WS_SLOC = 208 * MiB;
constexpr size_t WS_YG = 224 * MiB;
constexpr size_t WS_MRG = 256 * MiB;
constexpr size_t WS_WD = 328 * MiB;
constexpr size_t WS_WGU = 392 * MiB;
constexpr size_t WS_YS12 = 392 * MiB;
constexpr size_t WS_END = 520 * MiB;
constexpr int CW_CNT = 8192  , CW_CONV = 64  , CW_MOD = 640, CW_P1 = 4608  , CW_CONVW = 5120  , CW_BAR = 1024;

struct Args { const float* in[32]; float* out; unsigned char* ws; int ph_lo, ph_hi, rep_mask, pad; };

__device__ __forceinline__ float bf2f(unsigned v) { return __builtin_bit_cast(float, v << 16); }
__device__ __forceinline__ unsigned f2bf(float f) { unsigned u = __builtin_bit_cast(unsigned, f); return (u + 0x7fffu + ((u >> 16) & 1u)) >> 16; }
__device__ __forceinline__ unsigned pk2(float lo, float hi) { unsigned r; asm("v_cvt_pk_bf16_f32 %0, %1, %2" : "=v"(r) : "v"(lo), "v"(hi)); return r; }
__device__ __forceinline__ float bflo(unsigned w) { return __builtin_bit_cast(float, w << 16); }
__device__ __forceinline__ float bfhi(unsigned w) { return __builtin_bit_cast(float, w & 0xffff0000u); }
__device__ __forceinline__ float sigmoidf_(float x) { return __builtin_amdgcn_rcpf(1.0f + __expf(-x)); }
__device__ __forceinline__ float siluf_(float x) { return x * sigmoidf_(x); }
__device__ __forceinline__ float gelu_tanh(float x) { const float u = 0.7978845608028654f * (x + 0.044715f * x * x * x); return x * sigmoidf_(2.0f * u); }
__device__ __forceinline__ f32x2 sig2(const f32x2 x, const float k  ) {
    const f32x2 t = x * k; f32x2 e; e.x = __builtin_amdgcn_exp2f(t.x); e.y = __builtin_amdgcn_exp2f(t.y);
    const f32x2 d = e + 1.0f; f32x2 r; r.x = __builtin_amdgcn_rcpf(d.x); r.y = __builtin_amdgcn_rcpf(d.y); return r; }
__device__ __forceinline__ f32x2 gelu2(const f32x2 x) {
    const f32x2 p = (x * x) * 0.044715f + 1.0f; return x * sig2(x * p, -1.4426950408889634f * 2.0f * 0.7978845608028654f); }
#define WS_DPP(v, ctrl, rmask) ((v) + __builtin_bit_cast(float, __builtin_amdgcn_update_dpp(0, __builtin_bit_cast(int, (v)), (ctrl), (rmask), 0xf, false)))
__device__ __forceinline__ float wave_sum(float v) {
    v = WS_DPP(v, 0x128, 0xf);
    v = WS_DPP(v, 0x124, 0xf);
    v = WS_DPP(v, 0x122, 0xf);
    v = WS_DPP(v, 0x121, 0xf);
    v = WS_DPP(v, 0x142, 0xa);
    v = WS_DPP(v, 0x143, 0xc);
    return __builtin_bit_cast(float, __builtin_amdgcn_readlane(__builtin_bit_cast(int, v), 63));
}
#define LDS_WAIT() asm volatile("s_waitcnt lgkmcnt(0)" ::: "memory")
#ifndef TIME_PHASE
#define TIME_PHASE -1
#endif
#if TIME_PHASE >= 0
extern __shared__ __attribute__((aligned(16))) unsigned char lds_raw_ts[];
#define STAMP(k) do { if (threadIdx.x == 0) ((LAS unsigned long long*)((LAS unsigned char*)lds_raw_ts + 131072 + 4096))[k] = __builtin_amdgcn_s_memrealtime(); } while (0)
#else
#define STAMP(k) do { } while (0)
#endif

__device__ __forceinline__ void p0_mod(const Args& a, LAS float* sm) {
    const float* c = a.in[I_C]; const float* W = a.in[I_ADAW]; const float* bias = a.in[I_ADAB];
    float* mod = (float*)(a.ws + WS_MOD);
    const int t = threadIdx.x, cl = t & 31, kq = t >> 5;
    if (blockIdx.x >= 192) return;
    LAS float* sc = sm + 2048;
    for (int i = t; i < NB * D; i += NTHR) sc[i] = siluf_(c[i]);
    __syncthreads();
    for (int item = blockIdx.x; item < 192; item += gridDim.x) {
        const int col = item * 32 + cl;
        float a0 = 0.f, a1 = 0.f, a2 = 0.f, a3 = 0.f;
#pragma unroll 16
        for (int k = kq; k < D; k += 16) {
            const float w = W[(size_t)k * (6 * D) + col];
            a0 += sc[k] * w; a1 += sc[D + k] * w; a2 += sc[2 * D + k] * w; a3 += sc[3 * D + k] * w;
        }
        sm[(kq * 32 + cl) * 4 + 0] = a0; sm[(kq * 32 + cl) * 4 + 1] = a1; sm[(kq * 32 + cl) * 4 + 2] = a2; sm[(kq * 32 + cl) * 4 + 3] = a3;
        __syncthreads();
        if (t < 128) { const int b = t >> 5; float s = 0.f;
#pragma unroll
            for (int q = 0; q < 16; ++q) s += sm[(q * 32 + cl) * 4 + b];
            mod[b * 6 * D + col] = s + bias[col]; }
        __syncthreads();
        if (t == 0) {
            __builtin_amdgcn_fence(__ATOMIC_RELEASE, "agent"); asm volatile("s_waitcnt vmcnt(0)" ::: "memory");
            __hip_atomic_fetch_add((unsigned*)(a.ws + WS_CTL) + CW_MOD, 1u, __ATOMIC_RELAXED, __HIP_MEMORY_SCOPE_AGENT);
        }
    }
}
__device__ __forceinline__ void mod_wait(const Args& a) {
    if (threadIdx.x == 0) {
        unsigned* f = (unsigned*)(a.ws + WS_CTL) + CW_MOD; unsigned sp = 0;
        while (__hip_atomic_load(f, __ATOMIC_RELAXED, __HIP_MEMORY_SCOPE_AGENT) < 192u) { __builtin_amdgcn_s_sleep(2); if (++sp > (1u << 24)) break; }
        __builtin_amdgcn_fence(__ATOMIC_ACQUIRE, "agent"); asm volatile("s_waitcnt vmcnt(0)" ::: "memory");
    }
    __syncthreads();
}

__device__ __forceinline__ void p1_router_item(const Args& a, int it, int lane);
__device__ __forceinline__ void p1_dynamic(const Args& a, int lane) {
    const float* x = a.in[I_X]; const float* g = a.in[I_N1G]; const float* mod = (const float*)(a.ws + WS_MOD); bf16* h1 = (bf16*)(a.ws + WS_H1);
    constexpr int NIT = NB * NE + NTOK / 4;
    const int xq = blockIdx.x & 7, lo = (int)(((long)NIT * xq) >> 3), hi = (int)(((long)NIT * (xq + 1)) >> 3);
    unsigned* ctr = (unsigned*)(a.ws + WS_CTL) + CW_P1 + 64 * xq;
    for (;;) {
        int it0 = 0; if (lane == 0) it0 = (int)atomicAdd(ctr, 2u); it0 = __builtin_amdgcn_readfirstlane(it0) + lo;
        if (it0 >= hi) break;
#pragma unroll 1
        for (int it = it0; it < it0 + 2 && it < hi; ++it) {
        if (it < NB * NE) { p1_router_item(a, it, lane); continue; }
        const int m0 = (it - NB * NE) * 4;
        f32x4 v[4][4];
#pragma unroll
        for (int u = 0; u < 4; ++u)
#pragma unroll
            for (int j = 0; j < 4; ++j) v[u][j] = __builtin_nontemporal_load((const f32x4*)(x + (size_t)(m0 + u) * D) + lane + 64 * j);
#pragma unroll
        for (int u = 0; u < 4; ++u) {
            const int m = m0 + u, b = m >> 13; float s = 0.f;
#pragma unroll
            for (int j = 0; j < 4; ++j) s += (v[u][j].x * v[u][j].x + v[u][j].y * v[u][j].y) + (v[u][j].z * v[u][j].z + v[u][j].w * v[u][j].w);
            const float rstd = rsqrtf(wave_sum(s) * (1.f / D) + 1e-6f);
            unsigned long long* o8 = (unsigned long long*)(h1 + (size_t)m * D) + lane;
#pragma unroll
            for (int j = 0; j < 4; ++j) {
                const int k = 4 * lane + 256 * j;
                const f32x4 gg = *(const f32x4*)(g + k), sh = *(const f32x4*)(mod + b * 6 * D + k), sc = *(const f32x4*)(mod + b * 6 * D + D + k);
                const f32x4 h = v[u][j] * rstd * gg * (sc + 1.0f) + sh;
                o8[64 * j] = (unsigned long long)pk2(h.x, h.y) | ((unsigned long long)pk2(h.z, h.w) << 32);
            }
        }
        }
    }
}

__device__ __forceinline__ void unpack8(const v4u w, float (&f)[8]) {
    f[0] = bflo(w.x); f[1] = bfhi(w.x); f[2] = bflo(w.y); f[3] = bfhi(w.y); f[4] = bflo(w.z); f[5] = bfhi(w.z); f[6] = bflo(w.w); f[7] = bfhi(w.w);
}
__device__ __forceinline__ void p3e_conv(const Args& a, LAS float* sm, int lane) {
    constexpr int CT = 4;
    for (int i = threadIdx.x; i < CW * DCONV / 4; i += NTHR) { const int w = i >> 7, c4 = i & 127, ln = c4 >> 1, hf = c4 & 1;
        *(LAS f32x4*)(sm + ((w * 2 + hf) * 64 + ln) * 4) = *(const f32x4*)(a.in[I_CONVW] + w * DCONV + c4 * 4); }
    __syncthreads();
    const bf16* Z = (const bf16*)(a.ws + WS_Z); bf16* MRG = (bf16*)(a.ws + WS_MRG);
    const float* cw = a.in[I_CONVW]; const float* cb = a.in[I_CONVB]; const float* lng = a.in[I_LNG]; const float* lnb = a.in[I_LNB]; const float* ong = a.in[I_ONG];
    const int ch = lane * 8;
    const int xq = blockIdx.x & 7, ilo = (int)(((long)(NTOK / CT) * xq) >> 3), ihi = (int)(((long)(NTOK / CT) * (xq + 1)) >> 3);
    unsigned* ctr = (unsigned*)(a.ws + WS_CTL) + CW_CONVW + 64 * xq;
    for (;;) {
      int it0 = 0; if (lane == 0) it0 = (int)atomicAdd(ctr, 4u); it0 = __builtin_amdgcn_readfirstlane(it0) + ilo;
      if (it0 >= ihi) break;
#pragma unroll 1
      for (int it = it0; it < it0 + 4 && it < ihi; ++it) {
        const int t0 = it * CT, l0 = t0 & (SEQ - 1);
        int chw = ch; asm volatile("" : "+v"(chw));
        const unsigned zo = (unsigned)(((t0 - (CW - 1)) * DCONV + chw) * 2), wo = (unsigned)(chw * 4);
#define ZROW(j) (*(const v4u*)((const char*)Z + (unsigned)(zo + (unsigned)(j) * (DCONV * 2))))
#define WROW(w, q) (*(const LAS f32x4*)(sm + (((w) * 2 + (q)) * 64 + lane) * 4))
        f32x2 acc[CT][4];
        { const f32x4 b0 = *(const f32x4*)(cb + chw), b1 = *(const f32x4*)(cb + chw + 4);
#pragma unroll
          for (int i = 0; i < CT; ++i) { acc[i][0] = (f32x2){b0.x, b0.y}; acc[i][1] = (f32x2){b0.z, b0.w}; acc[i][2] = (f32x2){b1.x, b1.y}; acc[i][3] = (f32x2){b1.z, b1.w}; } }
        f32x2 act[CT][4]; v4u ring[8];
#pragma unroll
        for (int j = 0; j < CT + 8; ++j) { v4u r = (v4u){0u, 0u, 0u, 0u}; if (l0 - (CW - 1) + j >= 0) r = ZROW(j);
            if (j < CT) { act[j][0] = (f32x2){bflo(r.x), bfhi(r.x)}; act[j][1] = (f32x2){bflo(r.y), bfhi(r.y)}; act[j][2] = (f32x2){bflo(r.z), bfhi(r.z)}; act[j][3] = (f32x2){bflo(r.w), bfhi(r.w)}; } else ring[(j - CT) & 7] = r; }
#pragma nounroll
        for (int wq = 0; wq < 4; ++wq) {
#pragma unroll
            for (int r = 0; r < 8; ++r) {
                const int w = wq * 8 + r;
                if (w < CW) {
                    const f32x4 w0 = WROW(w, 0), w1 = WROW(w, 1);
                    const f32x2 wv[4] = {(f32x2){w0.x, w0.y}, (f32x2){w0.z, w0.w}, (f32x2){w1.x, w1.y}, (f32x2){w1.z, w1.w}};
#pragma unroll
                    for (int i = 0; i < CT; ++i) {
#pragma unroll
                        for (int c = 0; c < 4; ++c) acc[i][c] += act[(r + i) % CT][c] * wv[c];
                    }
                    if (w < CW - 1) {
                        const v4u rr = ring[r];
                        act[r % CT][0] = (f32x2){bflo(rr.x), bfhi(rr.x)}; act[r % CT][1] = (f32x2){bflo(rr.y), bfhi(rr.y)}; act[r % CT][2] = (f32x2){bflo(rr.z), bfhi(rr.z)}; act[r % CT][3] = (f32x2){bflo(rr.w), bfhi(rr.w)};
                        if (w + 8 < CW - 1) { const int j = w + CT + 8; ring[r] = (v4u){0u, 0u, 0u, 0u}; if (l0 - (CW - 1) + j >= 0) ring[r] = ZROW(j); }
                    }
                }
            }
        }
#undef ZROW
#undef WROW
        const f32x4 g0 = *(const f32x4*)(lng + chw), g1 = *(const f32x4*)(lng + chw + 4), be0 = *(const f32x4*)(lnb + chw), be1 = *(const f32x4*)(lnb + chw + 4);
        const f32x4 o0 = *(const f32x4*)(ong + DSSM + chw), o1 = *(const f32x4*)(ong + DSSM + chw + 4);
        const float gv[8] = {g0.x, g0.y, g0.z, g0.w, g1.x, g1.y, g1.z, g1.w}, bv[8] = {be0.x, be0.y, be0.z, be0.w, be1.x, be1.y, be1.z, be1.w};
        const float ov[8] = {o0.x, o0.y, o0.z, o0.w, o1.x, o1.y, o1.z, o1.w};
        float mean[CT], rstd[CT];
        { float s[CT];
#pragma unroll
          for (int i = 0; i < CT; ++i) { const f32x2 t = (acc[i][0] + acc[i][1]) + (acc[i][2] + acc[i][3]); s[i] = t.x + t.y; }
#pragma unroll
          for (int i = 0; i < CT; ++i) s[i] = wave_sum(s[i]);
#pragma unroll
          for (int i = 0; i < CT; ++i) mean[i] = s[i] * (1.f / DCONV);
          float q[CT];
#pragma unroll
          for (int i = 0; i < CT; ++i) { f32x2 t = {0.f, 0.f};
#pragma unroll
              for (int c = 0; c < 4; ++c) { const f32x2 d = acc[i][c] - mean[i]; t += d * d; }
              q[i] = t.x + t.y; }
#pragma unroll
          for (int i = 0; i < CT; ++i) q[i] = wave_sum(q[i]);
#pragma unroll
          for (int i = 0; i < CT; ++i) rstd[i] = rsqrtf(q[i] * (1.f / DCONV) + 1e-5f); }
        float ss[CT];
#pragma unroll
        for (int i = 0; i < CT; ++i) { f32x2 t = {0.f, 0.f};
#pragma unroll
            for (int c = 0; c < 4; ++c) { f32x2 v = (acc[i][c] - mean[i]) * rstd[i] * (f32x2){gv[2 * c], gv[2 * c + 1]} + (f32x2){bv[2 * c], bv[2 * c + 1]}; v.x = siluf_(v.x); v.y = siluf_(v.y); acc[i][c] = v; t += v * v; }
            ss[i] = t.x + t.y; }
#pragma unroll
        for (int i = 0; i < CT; ++i) ss[i] = wave_sum(ss[i]);
#pragma unroll
        for (int i = 0; i < CT; ++i) {
            const float r2 = rsqrtf(ss[i] * (1.f / DCONV) + 1e-6f);
            v4u o; o.x = pk2(acc[i][0].x * r2 * ov[0], acc[i][0].y * r2 * ov[1]); o.y = pk2(acc[i][1].x * r2 * ov[2], acc[i][1].y * r2 * ov[3]);
            o.z = pk2(acc[i][2].x * r2 * ov[4], acc[i][2].y * r2 * ov[5]); o.w = pk2(acc[i][3].x * r2 * ov[6], acc[i][3].y * r2 * ov[7]);
            *(v4u*)(MRG + (size_t)(t0 + i) * D + DSSM + chw) = o;
        }
      }
    }
}
__device__ __forceinline__ void p3e_norm(const Args& a, int gw, int ngw, int lane) {
    bf16* MRG = (bf16*)(a.ws + WS_MRG); const float* ong = a.in[I_ONG]; const int ch = lane * 8;
    const f32x4 o0 = *(const f32x4*)(ong + ch), o1 = *(const f32x4*)(ong + ch + 4);
    const float ov[8] = {o0.x, o0.y, o0.z, o0.w, o1.x, o1.y, o1.z, o1.w};
    v4u r[8];
#pragma unroll
    for (int u = 0; u < 8; ++u) { const int m = (gw + u * ngw < NTOK) ? gw + u * ngw : gw; r[u] = *(const v4u*)(MRG + (size_t)m * D + ch); }
    for (int m0 = gw; m0 < NTOK; m0 += 8 * ngw) {
        v4u c[8];
#pragma unroll
        for (int u = 0; u < 8; ++u) c[u] = r[u];
#pragma unroll
        for (int u = 0; u < 8; ++u) { const int mn = m0 + (8 + u) * ngw, m = (mn < NTOK) ? mn : gw; r[u] = *(const v4u*)(MRG + (size_t)m * D + ch); }
        asm volatile("" ::: "memory");
#pragma unroll
        for (int u = 0; u < 8; ++u) {
            const int m = m0 + u * ngw;
            if (m < NTOK) {
                float f[8]; unpack8(c[u], f);
                float ss = 0.f;
#pragma unroll
                for (int q = 0; q < 8; ++q) ss += f[q] * f[q];
                const float r2 = rsqrtf(wave_sum(ss) * (1.f / DSSM) + 1e-6f);
                v4u o; o.x = pk2(f[0] * r2 * ov[0], f[1] * r2 * ov[1]); o.y = pk2(f[2] * r2 * ov[2], f[3] * r2 * ov[3]);
                o.z = pk2(f[4] * r2 * ov[4], f[5] * r2 * ov[5]); o.w = pk2(f[6] * r2 * ov[6], f[7] * r2 * ov[7]);
                *(v4u*)(MRG + (size_t)m * D + ch) = o;
            }
        }
        asm volatile("" ::: "memory");
    }
}

__device__ __forceinline__ void moe_tables(const Args& a, LAS int* T) {
    const unsigned* cnt = (const unsigned*)(a.ws + WS_CTL) + CW_CNT;
    if (threadIdx.x < 32) T[threadIdx.x] = (int)__hip_atomic_load(cnt + 32 * threadIdx.x, __ATOMIC_RELAXED, __HIP_MEMORY_SCOPE_AGENT);
    __syncthreads();
    if (threadIdx.x == 0) { int rb = 0, t64 = 0, t256 = 0;
        for (int e = 0; e < NE; ++e) { T[32 + e] = rb; T[65 + e] = t64; T[98 + e] = t256; const int c = T[e]; rb += c; t64 += (c + 63) >> 6; t256 += (c + 255) >> 8; }
        T[32 + NE] = rb; T[65 + NE] = t64; T[98 + NE] = t256; }
    __syncthreads();
    for (int t = threadIdx.x; t < 640; t += NTHR) { int e = 0;
#pragma unroll 4
        for (int q = 1; q < NE; ++q) if (T[98 + q] <= t) e = q;
        T[1280 + t] = e; }
    __syncthreads();
}

__device__ __forceinline__ bf16* ys_ptr(const Args& a, int tok, int k) {
    if (k == 0) return (bf16*)(a.out + (size_t)tok * D);
    if (k == 3) return (bf16*)(a.ws + WS_YS3) + (size_t)tok * D;
    return (bf16*)(a.ws + WS_YS12) + ((size_t)(k - 1) * NTOK + tok) * D;
}

#if YS_F8
typedef v2u ys8_t;
__device__ __forceinline__ void unpack_ys(const ys8_t w, float (&f)[8]) {
    const f32x2 a = __builtin_amdgcn_cvt_pk_f32_fp8(w.x, false), b = __builtin_amdgcn_cvt_pk_f32_fp8(w.x, true), c = __builtin_amdgcn_cvt_pk_f32_fp8(w.y, false), d = __builtin_amdgcn_cvt_pk_f32_fp8(w.y, true);
    f[0] = a.x; f[1] = a.y; f[2] = b.x; f[3] = b.y; f[4] = c.x; f[5] = c.y; f[6] = d.x; f[7] = d.y; }
__device__ __forceinline__ ys8_t load_ys(const Args& a, int tok, int k, int ch) {
    const unsigned char* p = (k == 0) ? (const unsigned char*)(a.out + (size_t)tok * D) : (k == 3) ? (a.ws + WS_YS3) + (size_t)tok * D : (a.ws + WS_YS12) + ((size_t)(k - 1) * NTOK + tok) * D;
    return __builtin_nontemporal_load((const ys8_t*)(p + ch)); }
#else
typedef v4u ys8_t;
__device__ __forceinline__ void unpack_ys(const ys8_t w, float (&f)[8]) { unpack8(w, f); }
__device__ __forceinline__ ys8_t load_ys(const Args& a, int tok, int k, int ch) { return *(const ys8_t*)(ys_ptr(a, tok, k) + ch); }
#endif
struct P9Ld { v4u x[2]; ys8_t y[4][2]; f32x4 w; };
__device__ __forceinline__ P9Ld p9_load(const Args& a, int tok, int lane) {
    P9Ld r; r.w = *(const f32x4*)((const float*)(a.ws + WS_TOPW) + tok * 4);
#pragma unroll
    for (int q = 0; q < 2; ++q) {
        const int ch = lane * 8 + 512 * q;
        r.x[q] = __builtin_nontemporal_load((const v4u*)((const bf16*)(a.out + (size_t)tok * D) + D + ch));
#pragma unroll
        for (int k = 0; k < 4; ++k) r.y[k][q] = load_ys(a, tok, k, ch);
    }
    return r;
}
__device__ __forceinline__ void p9_token(const Args& a, const P9Ld& r, int tok, int lane) {
    const float* mod = (const float*)(a.ws + WS_MOD); const float* fg = a.in[I_FG];
    const int b = tok >> 13;
    float xo[2][8], ss = 0.f;
#pragma unroll
    for (int q = 0; q < 2; ++q) {
        const int ch = lane * 8 + 512 * q;
        float x1[8], y0[8], y1[8], y2[8], y3[8];
        unpack8(r.x[q], x1); unpack_ys(r.y[0][q], y0); unpack_ys(r.y[1][q], y1); unpack_ys(r.y[2][q], y2); unpack_ys(r.y[3][q], y3);
        const f32x4 g0 = *(const f32x4*)(mod + b * 6 * D + 5 * D + ch), g1 = *(const f32x4*)(mod + b * 6 * D + 5 * D + ch + 4);
        const float g2[8] = {g0.x, g0.y, g0.z, g0.w, g1.x, g1.y, g1.z, g1.w};
#pragma unroll
        for (int c = 0; c < 8; ++c) { xo[q][c] = x1[c] + g2[c] * (((r.w.x * y0[c] + r.w.y * y1[c]) + r.w.z * y2[c]) + r.w.w * y3[c]); ss += xo[q][c] * xo[q][c]; }
    }
    const float rstd = rsqrtf(wave_sum(ss) * (1.f / D) + 1e-6f);
#pragma unroll
    for (int q = 0; q < 2; ++q) {
        const int ch = lane * 8 + 512 * q;
        const f32x4 f0 = *(const f32x4*)(fg + ch), f1 = *(const f32x4*)(fg + ch + 4);
        f32x4 o0, o1;
        o0.x = xo[q][0] * rstd * f0.x; o0.y = xo[q][1] * rstd * f0.y; o0.z = xo[q][2] * rstd * f0.z; o0.w = xo[q][3] * rstd * f0.w;
        o1.x = xo[q][4] * rstd * f1.x; o1.y = xo[q][5] * rstd * f1.y; o1.z = xo[q][6] * rstd * f1.z; o1.w = xo[q][7] * rstd * f1.w;
        f32x4* op = (f32x4*)(a.out + (size_t)tok * D + ch);
        __builtin_nontemporal_store(o0, op); __builtin_nontemporal_store(o1, op + 1);
    }
}
__device__ __forceinline__ void p9_final(const Args& a, int gw, int ngw, int lane) {
    P9Ld r0 = p9_load(a, gw < NTOK ? gw : 0, lane), r1 = p9_load(a, gw + ngw < NTOK ? gw + ngw : 0, lane);
    for (int tok = gw; tok < NTOK; tok += 2 * ngw) {
        { const P9Ld cu = r0; const int tn = tok + 2 * ngw; r0 = p9_load(a, tn < NTOK ? tn : tok, lane);
          asm volatile("" ::: "memory"); p9_token(a, cu, tok, lane); asm volatile("" ::: "memory"); }
        if (tok + ngw < NTOK) { const P9Ld cu = r1; const int tn = tok + 3 * ngw; r1 = p9_load(a, tn < NTOK ? tn : tok + ngw, lane);
          asm volatile("" ::: "memory"); p9_token(a, cu, tok + ngw, lane); asm volatile("" ::: "memory"); }
    }
}

namespace pg8 {
constexpr int BM = 256, BK = 64, HALF = 128, HTB = HALF * BK * 2  , STAGE_BYTES = 8 * HTB, NXCD = 8, WGM = 8;
__host__ __device__ __forceinline__ int lds_byte(int r, int c) { const int st = (r >> 4) * 2 + (c >> 5), rr = r & 15, cc = c & 31, ob = rr * 64 + cc * 2; return st * 1024 + (ob ^ (((ob >> 9) & 1) << 5)); }
__host__ __device__ __forceinline__ void stage_rc(int b, int& R, int& C) { const int st = b / 1024, sb = b % 1024, swz = sb ^ (((sb >> 9) & 1) << 5); R = (st >> 1) * 16 + swz / 64; C = (st & 1) * 32 + (swz % 64) / 2; }
__host__ __device__ __forceinline__ int perm32(int rho) { const int n = rho >> 4, i = rho & 15; return 8 * (i >> 2) + 4 * n + (i & 3); }
struct Unit { int pm, pn, e, row0, slot0, nvalid; };
typedef int v8i __attribute__((ext_vector_type(8)));
__device__ __forceinline__ v8i cat8(const bf16x8 lo, const bf16x8 hi) { typedef int v4i __attribute__((ext_vector_type(4))); const v4i a = __builtin_bit_cast(v4i, lo), b = __builtin_bit_cast(v4i, hi); return (v8i){a[0], a[1], a[2], a[3], b[0], b[1], b[2], b[3]}; }
__device__ __forceinline__ bf16x8 lo8(const v8i v) { typedef int v4i __attribute__((ext_vector_type(4))); return __builtin_bit_cast(bf16x8, __builtin_shufflevector(v, v, 0, 1, 2, 3)); }
__device__ __forceinline__ bf16x8 hi8(const v8i v) { typedef int v4i __attribute__((ext_vector_type(4))); return __builtin_bit_cast(bf16x8, __builtin_shufflevector(v, v, 4, 5, 6, 7)); }
__device__ __forceinline__ unsigned cvt_pk_bf16(float lo, float hi) { unsigned r; asm volatile("v_cvt_pk_bf16_f32 %0, %1, %2" : "=v"(r) : "v"(lo), "v"(hi)); return r; }

template <class Epi, class Sched, bool ALIGN_EPI, bool F8 = false>
__device__ __forceinline__ void gemm_phase(LAS unsigned char* lds, const Sched& S, const Epi& E) {
    const int tid = threadIdx.x, wid = __builtin_amdgcn_readfirstlane(tid >> 6), lane = tid & 63, wr = wid >> 2, wc = wid & 3, fr = lane & 15, fq = lane >> 4;
    constexpr int EB = F8 ? 1 : 2;
    const int nt = S.K / (128 / EB);
    int R[2], C[2]; unsigned voffB[2];
#pragma unroll
    for (int i = 0; i < 2; ++i) { stage_rc(tid * 16 + i * 8192, R[i], C[i]); const int Rb = Epi::PERM ? ((R[i] & ~31) + perm32(R[i] & 31)) : R[i]; voffB[i] = (unsigned)(Rb * S.ldb * EB + C[i] * 2); }
    const size_t kstep = (size_t)(BK * 2);
    const size_t bhstep = (size_t)HALF * S.ldb * EB;
    const unsigned ldsw = (unsigned)wid * 1024u;
    const int aoff = lds_byte(wr * 64 + fr, fq * 8), boff = lds_byte(wc * 32 + fr, fq * 8);
#define PG8_SA(b, h) (((b) * 2 + (h)) * HTB)
#define PG8_SB(b, h) ((4 + (b) * 2 + (h)) * HTB)
#define PG8_STAGE(bufoff, gbase, voff) do { _Pragma("unroll") for (int _i = 0; _i < 2; ++_i) \
        __builtin_amdgcn_global_load_lds((const unsigned*)((const char*)(gbase) + (voff)[_i]), (LAS unsigned*)(lds + (bufoff) + ldsw + _i * 8192), 16, 0, 0); } while (0)
#define PG8_LDA(dst, b, h) do { _Pragma("unroll") for (int m = 0; m < 4; ++m) dst[m] = cat8(*(const LAS bf16x8*)(lds + PG8_SA(b, h) + aoff + m * 2048), *(const LAS bf16x8*)(lds + PG8_SA(b, h) + aoff + m * 2048 + 1024)); } while (0)
#define PG8_LDB(dst, b, h) do { _Pragma("unroll") for (int n = 0; n < 2; ++n) dst[n] = cat8(*(const LAS bf16x8*)(lds + PG8_SB(b, h) + boff + n * 2048), *(const LAS bf16x8*)(lds + PG8_SB(b, h) + boff + n * 2048 + 1024)); } while (0)
#define PG8_MMA(ai, bj, At, Bt) do { __builtin_amdgcn_s_setprio(1); _Pragma("unroll") for (int m = 0; m < 4; ++m) _Pragma("unroll") for (int n = 0; n < 2; ++n) { \
        if constexpr (F8) { asm volatile("v_mfma_scale_f32_16x16x128_f8f6f4 %0, %1, %2, %0, %3, %4 op_sel_hi:[0,0,0]" : "+v"(acc[ai][bj][m][n]) : "v"(Bt[n]), "v"(At[m]), "v"(f8sb), "v"(f8sa)); } \
        else { acc[ai][bj][m][n] = __builtin_amdgcn_mfma_f32_16x16x32_bf16(lo8(Bt[n]), lo8(At[m]), acc[ai][bj][m][n], 0, 0, 0); acc[ai][bj][m][n] = __builtin_amdgcn_mfma_f32_16x16x32_bf16(hi8(Bt[n]), hi8(At[m]), acc[ai][bj][m][n], 0, 0, 0); } } \
        __builtin_amdgcn_s_setprio(0); } while (0)
#define PG8_WAIT_V(n) asm volatile("s_waitcnt vmcnt(" #n ")" ::: "memory")
#define PG8_WAIT_L(n) asm volatile("s_waitcnt lgkmcnt(" #n ")" ::: "memory")
#define PG8_BAR __builtin_amdgcn_s_barrier()
#define PG8_SCHED __builtin_amdgcn_sched_barrier(0)
    Unit cur, nxt; int ui = 0; cur.e = 0;
    if (!S.next(0, cur)) return;
    nxt = cur;
    f32x4 acc[2][2][4][2];
#pragma unroll
    for (int a = 0; a < 2; ++a)
#pragma unroll
        for (int b = 0; b < 2; ++b)
#pragma unroll
            for (int m = 0; m < 4; ++m)
#pragma unroll
                for (int n = 0; n < 2; ++n) acc[a][b][m][n] = (f32x4){0.f, 0.f, 0.f, 0.f};
    const int f8sa = S.scale_a, f8sb = S.scale_b;
    v8i At[4], B0[2], B1[2];
    unsigned ao[2][2], an[2][2];
    S.a_offsets(cur, R, C, ao);
    const char* cA = S.a_base(cur); const char* cB = S.b_base(cur);
    PG8_STAGE(PG8_SB(0, 0), cB, voffB); PG8_STAGE(PG8_SB(0, 1), cB + bhstep, voffB); PG8_STAGE(PG8_SA(0, 0), cA, ao[0]); PG8_STAGE(PG8_SA(0, 1), cA, ao[1]);
    if (wr == 1) PG8_BAR;
    PG8_WAIT_V(2); PG8_BAR;
    PG8_STAGE(PG8_SB(1, 0), cB + kstep, voffB); PG8_STAGE(PG8_SA(1, 0), cA + kstep, ao[0]); PG8_STAGE(PG8_SB(1, 1), cB + bhstep + kstep, voffB);
    PG8_WAIT_V(6); PG8_BAR;
#if TIME_PHASE >= 0
    unsigned long long tk0 = 0, tk1 = 0, tacc_k = 0, tacc_e = 0;
#endif
    for (;;) {
#if TIME_PHASE >= 0
        if (S.tstamp) tk0 = __builtin_amdgcn_s_memrealtime();
#endif
        const bool has_next = S.next(ui + 1, nxt);
        const char* nA = cA; const char* nB = cB;
#pragma unroll
        for (int h = 0; h < 2; ++h)
#pragma unroll
            for (int i = 0; i < 2; ++i) an[h][i] = ao[h][i];
        if (has_next) { nA = S.a_base(nxt); nB = S.b_base(nxt); S.a_offsets(nxt, R, C, an); }
        for (int t = 0; t < nt; t += 2) {
            const bool last = (t == nt - 2);
            const char* a1 = cA + (size_t)(t + 1) * kstep;
            const char* a2 = last ? nA : cA + (size_t)(t + 2) * kstep; const char* b2 = last ? nB : cB + (size_t)(t + 2) * kstep;
            const char* a3 = a2 + kstep; const char* b3 = b2 + kstep;
            unsigned o2[2][2];
#pragma unroll
            for (int h = 0; h < 2; ++h)
#pragma unroll
                for (int i = 0; i < 2; ++i) o2[h][i] = last ? an[h][i] : ao[h][i];
            PG8_LDB(B0, 0, 0); PG8_LDB(B1, 0, 1); PG8_SCHED; PG8_LDA(At, 0, 0); PG8_STAGE(PG8_SA(1, 1), a1, ao[1]);
            PG8_WAIT_V(8); PG8_WAIT_L(0); PG8_BAR; PG8_MMA(0, 0, At, B0); PG8_MMA(0, 1, At, B1); PG8_BAR; PG8_SCHED;
            PG8_LDA(At, 0, 1); PG8_STAGE(PG8_SB(0, 0), b2, voffB); PG8_STAGE(PG8_SB(0, 1), b2 + bhstep, voffB); PG8_STAGE(PG8_SA(0, 0), a2, o2[0]);
            PG8_WAIT_V(8); PG8_WAIT_L(0); PG8_BAR; PG8_MMA(1, 0, At, B0); PG8_MMA(1, 1, At, B1); PG8_BAR; PG8_SCHED;
            PG8_LDB(B0, 1, 0); PG8_LDB(B1, 1, 1); PG8_SCHED; PG8_LDA(At, 1, 0); PG8_STAGE(PG8_SA(0, 1), a2, o2[1]);
            PG8_WAIT_V(8); PG8_WAIT_L(0); PG8_BAR; PG8_MMA(0, 0, At, B0); PG8_MMA(0, 1, At, B1); PG8_BAR; PG8_SCHED;
            PG8_LDA(At, 1, 1); PG8_STAGE(PG8_SB(1, 0), b3, voffB); PG8_STAGE(PG8_SB(1, 1), b3 + bhstep, voffB); PG8_STAGE(PG8_SA(1, 0), a3, o2[0]);
            PG8_WAIT_V(8); PG8_WAIT_L(0); PG8_BAR; PG8_MMA(1, 0, At, B0); PG8_MMA(1, 1, At, B1); PG8_BAR; PG8_SCHED;
        }
#if TIME_PHASE >= 0
        if (S.tstamp) { tk1 = __builtin_amdgcn_s_memrealtime(); tacc_k += tk1 - tk0; }
#endif
        if constexpr (ALIGN_EPI) { if (wr == 0) PG8_BAR; }
        if constexpr (F8) { asm volatile("s_nop 15\n\ts_nop 15" ::: "memory"); }
        E(acc, cur, wr, wc, fr, fq);
        if (S.rep_epi) { asm volatile("" ::: "memory"); E(acc, cur, wr, wc, fr, fq); }
#if TIME_PHASE >= 0
        if (S.tstamp) { tacc_e += __builtin_amdgcn_s_memrealtime() - tk1; }
#endif
        if (!has_next) break;
#pragma unroll
        for (int a = 0; a < 2; ++a)
#pragma unroll
            for (int b = 0; b < 2; ++b)
#pragma unroll
                for (int m = 0; m < 4; ++m)
#pragma unroll
                    for (int n = 0; n < 2; ++n) acc[a][b][m][n] = (f32x4){0.f, 0.f, 0.f, 0.f};
        cur = nxt; cA = nA; cB = nB; ++ui;
#pragma unroll
        for (int h = 0; h < 2; ++h)
#pragma unroll
            for (int i = 0; i < 2; ++i) ao[h][i] = an[h][i];
        if constexpr (ALIGN_EPI) { if (wr == 1) PG8_BAR; }
    }
    PG8_WAIT_V(0);
    if constexpr (!ALIGN_EPI) { if (wr == 0) PG8_BAR; }
    PG8_BAR;
#if TIME_PHASE >= 0
    if (S.tstamp && threadIdx.x == 0) { LAS unsigned long long* TSg = (LAS unsigned long long*)(lds + 131072 + 4096); TSg[24] = 0; TSg[25] = tacc_k; TSg[26] = tacc_k + tacc_e; }
#endif
#undef PG8_SA
#undef PG8_SB
#undef PG8_STAGE
#undef PG8_LDA
#undef PG8_LDB
#undef PG8_MMA
#undef PG8_WAIT_V
#undef PG8_WAIT_L
#undef PG8_BAR
#undef PG8_SCHED
}

struct SchedDense {
    static constexpr int scale_a = 127, scale_b = 127, rep_epi = 0;
    const bf16* A; const bf16* Bt; int K, lda, ldb; int nM, nN, nwg, G, c, rep, tstamp = 0;
    __device__ __forceinline__ void init(const bf16* A_, const bf16* Bt_, int M, int N, int K_, int lda_, int ldb_, int G_, int c_, int rep_ = 1) { A = A_; Bt = Bt_; K = K_; lda = lda_; ldb = ldb_; nM = M / BM; nN = N / BM; nwg = nM * nN; G = G_; c = c_; rep = rep_; }
    __device__ __forceinline__ bool next(int i, Unit& u) const {
        const long L = (long)(i / rep) * G + c; if (L >= nwg) return false;
        int wgid = (int)L; { const int q = nwg / NXCD, r = nwg % NXCD, xcd = wgid % NXCD, off = wgid / NXCD; wgid = (xcd < r ? xcd * (q + 1) : r * (q + 1) + (xcd - r) * q) + off; }
        const int nig = WGM * nN, gid = wgid / nig, fm = gid * WGM, gsz = (nM - fm) < WGM ? (nM - fm) : WGM;
        u.pm = fm + ((wgid % nig) % gsz); u.pn = (wgid % nig) / gsz; u.e = 0; u.row0 = u.pm * BM; u.slot0 = 0; u.nvalid = BM; return true;
    }
    __device__ __forceinline__ const char* a_base(const Unit& u) const { return (const char*)A + (size_t)u.pm * BM * lda * 2; }
    __device__ __forceinline__ const char* b_base(const Unit& u) const { return (const char*)Bt + (size_t)u.pn * BM * ldb * 2; }
    __device__ __forceinline__ void a_offsets(const Unit&, const int (&R)[2], const int (&C)[2], unsigned (&off)[2][2]) const {
#pragma unroll
        for (int h = 0; h < 2; ++h)
#pragma unroll
            for (int i = 0; i < 2; ++i) off[h][i] = (unsigned)((R[i] + HALF * h) * lda + C[i]) * 2u;
    }
};
struct SchedGroup {
    static constexpr int scale_a = 127, scale_b = 127, rep_epi = 0, tstamp = 0;
    const bf16* A; const bf16* Bt; int K, lda, ldb; int nM, nN, ng, G, c; size_t astride, bstride; int rep, nmax;
    __device__ __forceinline__ bool next(int i, Unit& u) const {
        const int L = (i / rep) * G + c; if (L >= ng * nM * nN || i >= nmax) return false;
        const int g = L / (nM * nN), rem = L % (nM * nN);
        u.e = g; u.pm = rem % nM; u.pn = rem / nM; u.row0 = u.pm * BM; u.slot0 = 0; u.nvalid = BM; return true;
    }
    __device__ __forceinline__ const char* a_base(const Unit& u) const { return (const char*)(A + (size_t)u.e * astride) + (size_t)u.pm * BM * lda * 2; }
    __device__ __forceinline__ const char* b_base(const Unit& u) const { return (const char*)(Bt + (size_t)u.e * bstride) + (size_t)u.pn * BM * ldb * 2; }
    __device__ __forceinline__ void a_offsets(const Unit&, const int (&R)[2], const int (&C)[2], unsigned (&off)[2][2]) const {
#pragma unroll
        for (int h = 0; h < 2; ++h)
#pragma unroll
            for (int i = 0; i < 2; ++i) off[h][i] = (unsigned)((R[i] + HALF * h) * lda + C[i]) * 2u;
    }
};
}

__device__ __forceinline__ unsigned pk_fp8x4(float a, float b, float c, float d) { unsigned r = __builtin_amdgcn_cvt_pk_fp8_f32(a, b, 0u, false); return __builtin_amdgcn_cvt_pk_fp8_f32(c, d, r, true); }
struct TItem { const float* W; unsigned char* WT; int K, N, k0, n0, drow0, f8, perm; };
__device__ __forceinline__ int wd_perm_row(int c) { return (c & ~255) + ((c >> 3) & 1) * 128 + ((c >> 6) & 3) * 32 + ((c >> 4) & 3) * 8 + (c & 7); }
__device__ __forceinline__ void titem_load(const TItem& t, int lane, f32x4 (&v)[8]) {
    const float* p = t.W + (size_t)(t.k0 + 8 * (lane >> 3)) * t.N + t.n0 + 4 * (lane & 7);
#pragma unroll
    for (int i = 0; i < 8; ++i) v[i] = __builtin_nontemporal_load((const f32x4*)(p + (size_t)i * t.N));
}
__device__ __forceinline__ void titem_store(const TItem& t, int lane, const f32x4 (&v)[8], float f8scale) {
    const int n4 = lane & 7, kb = lane >> 3;
#pragma unroll
    for (int j = 0; j < 4; ++j) {
        const int cc = 4 * n4 + j;
        const size_t row = (size_t)(t.perm == 1 ? wd_perm_row(t.drow0 + cc) : t.perm == 2 ? t.drow0 + 8 * ((((cc >> 3) & 1) << 1) | (cc >> 4)) + (cc & 7) : t.drow0 + cc);
        if (t.f8) { v2u o; o.x = pk_fp8x4(v[0][j] * f8scale, v[1][j] * f8scale, v[2][j] * f8scale, v[3][j] * f8scale); o.y = pk_fp8x4(v[4][j] * f8scale, v[5][j] * f8scale, v[6][j] * f8scale, v[7][j] * f8scale);
            *(v2u*)(t.WT + row * t.K + t.k0 + 8 * kb) = o; }
        else { v4u o; o.x = pk2(v[0][j], v[1][j]); o.y = pk2(v[2][j], v[3][j]); o.z = pk2(v[4][j], v[5][j]); o.w = pk2(v[6][j], v[7][j]);
            *(v4u*)(t.WT + (row * t.K + t.k0 + 8 * kb) * 2) = o; }
    }
}
constexpr float WGU_F8_SCALE = 32.0f;
__device__ __forceinline__ TItem p0_item(const Args& a, int it) {
    constexpr int I_IN = 16 * 48, I_GLU = 8 * 16, I_OUT = 16 * 32, I_EXP = 16 * 32;
    TItem t; t.f8 = 0; t.perm = 0; int r = it;
    if (r < I_IN) { const int kb = r / 48, nb = r % 48, n0 = nb * 32; int drow;
        if (n0 < 512) drow = n0; else if (n0 < 1024) { const int j = n0 - 512; drow = 512 + (j >> 7) * 256 + (j & 127); } else { const int j = n0 - 1024; drow = 512 + (j >> 7) * 256 + 128 + (j & 127); }
        t.W = a.in[I_WIN]; t.WT = a.ws + WS_WIN; t.K = D; t.N = DIN; t.k0 = kb * 64; t.n0 = n0; t.drow0 = drow; return t; } r -= I_IN;
    if (r < I_GLU) { const int kb = r / 16, nb = r % 16; t.W = a.in[I_WGLU]; t.WT = a.ws + WS_WGLU; t.K = DSSM; t.N = DSSM; t.k0 = kb * 64; t.n0 = nb * 32; t.drow0 = nb * 32; return t; } r -= I_GLU;
    if (r < I_OUT) { const int kb = r / 32, nb = r % 32; t.W = a.in[I_WOUT]; t.WT = a.ws + WS_WOUT; t.K = D; t.N = D; t.k0 = kb * 64; t.n0 = nb * 32; t.drow0 = nb * 32; return t; } r -= I_OUT;
    const int e = r / (3 * I_EXP), q = r % (3 * I_EXP), which = q / I_EXP, sidx = q % I_EXP, kb = sidx / 32, nb = sidx % 32, n0 = nb * 32;
    t.K = D; t.N = FF; t.k0 = kb * 64; t.n0 = n0;
    if (which == 0) { t.W = a.in[I_WG] + (size_t)e * D * FF; t.WT = a.ws + WS_WGU + (size_t)e * 2048 * D * (MOE1_F8 ? 1 : 2); t.drow0 = (n0 >> 7) * 256 + (n0 & 127); t.f8 = MOE1_F8; t.perm = MOE1_WIDE ? 2 : 0; }
    else if (which == 1) { t.W = a.in[I_WU] + (size_t)e * D * FF; t.WT = a.ws + WS_WGU + (size_t)e * 2048 * D * (MOE1_F8 ? 1 : 2); t.drow0 = (n0 >> 7) * 256 + 128 + (n0 & 127); t.f8 = MOE1_F8; t.perm = MOE1_WIDE ? 2 : 0; }
    else { t.W = a.in[I_WD] + (size_t)e * FF * D; t.WT = a.ws + WS_WD + (size_t)e * D * FF * (MOE2_F8 ? 1 : 2); t.drow0 = n0; t.f8 = MOE2_F8; t.perm = MOE2_WIDE; }
    return t;
}
__device__ __forceinline__ void p0_convert(const Args& a, int gw, int ngw, int lane) {
    constexpr int NITEMS = 16 * 48 + 8 * 16 + 16 * 32 + 3 * NE * 16 * 32;
    const int x = blockIdx.x & 7, lo = (int)(((long)NITEMS * x) >> 3), hi = (int)(((long)NITEMS * (x + 1)) >> 3);
    unsigned* ctr = (unsigned*)(a.ws + WS_CTL) + CW_CONV + 64 * x;
    int it = 0, nleft = 0;
    auto grab = [&]() { if (nleft == 0) { int g0 = 0; if (lane == 0) g0 = (int)atomicAdd(ctr, 8u); it = __builtin_amdgcn_readfirstlane(g0) + lo; nleft = 8; } };
    grab();
    bool have = it < hi; TItem c0{}, c1{}; bool ctwo = false; f32x4 v0[8], v1[8];
    if (have) { c0 = p0_item(a, it); ctwo = it + 1 < hi; c1 = p0_item(a, ctwo ? it + 1 : it); titem_load(c0, lane, v0); titem_load(c1, lane, v1); it += 2; nleft -= 2; }
    while (have) {
        grab();
        const bool hn = it < hi; TItem n0{}, n1{}; bool ntwo = false; f32x4 w0[8], w1[8];
        if (hn) { n0 = p0_item(a, it); ntwo = it + 1 < hi; n1 = p0_item(a, ntwo ? it + 1 : it); titem_load(n0, lane, w0); titem_load(n1, lane, w1); it += 2; nleft -= 2; }
        asm volatile("" ::: "memory");
        titem_store(c0, lane, v0, WGU_F8_SCALE);
        if (ctwo) titem_store(c1, lane, v1, WGU_F8_SCALE);
        asm volatile("" ::: "memory");
        have = hn; c0 = n0; c1 = n1; ctwo = ntwo;
#pragma unroll
        for (int i = 0; i < 8; ++i) { v0[i] = w0[i]; v1[i] = w1[i]; }
    }
}
__device__ __forceinline__ void p0_s5_mats(const Args& a, LAS float* sm) {
    LAS float* Ptau = sm; LAS float* Pt1 = sm + 128; LAS float* Ps = sm + 256; LAS float* LD = sm + 384;
    LAS float* Bb = sm + 512; LAS float* Kt = sm + 512 + 2048; LAS float* Cs = sm + 512 + 2048 + 256;
    bf16* BTS = (bf16*)(a.ws + WS_BTS); bf16* BTY = (bf16*)(a.ws + WS_BTY);
    const int t = threadIdx.x;
    for (int it0 = blockIdx.x * 4; it0 < NG * TCH; it0 += gridDim.x * 4) {
        const int g = it0 >> 5;
        if (t < 64) {
            const int p = t;
            const float lr = a.in[I_LRE][g * NP + p], li = a.in[I_LIM][g * NP + p], dt = expf(a.in[I_LDT][g]);
            const float mag = expf(lr * dt); float sn, cs; sincosf(li * dt, &sn, &cs);
            const float ar = mag * cs, ai = mag * sn, den = lr * lr + li * li, nr = ar - 1.f;
            const float qr = (nr * lr + ai * li) / den, qi = (ai * lr - nr * li) / den;
            LD[2 * p] = lr * dt; LD[2 * p + 1] = li * dt;
#pragma unroll
            for (int h = 0; h < 16; ++h) {
                const float br = a.in[I_BRE][(g * NP + p) * GH + h], bi = a.in[I_BIM][(g * NP + p) * GH + h];
                Bb[(p * 16 + h) * 2] = qr * br - qi * bi; Bb[(p * 16 + h) * 2 + 1] = qr * bi + qi * br;
            }
        }
        for (int i = t; i < GH * NP; i += NTHR) { Cs[2 * i] = a.in[I_CRE][g * GH * NP + i]; Cs[2 * i + 1] = a.in[I_CIM][g * GH * NP + i]; }
        __syncthreads();
        for (int tau = it0 & 31; tau < (it0 & 31) + 4; ++tau) {
        if (t < 192) {
            const int p = t & 63, which = t >> 6; const float e = which == 0 ? (float)tau : which == 1 ? (float)(tau + 1) : (float)(31 - tau);
            const float m = expf(e * LD[2 * p]); float s2, c2; sincosf(e * LD[2 * p + 1], &s2, &c2);
            LAS float* dst = which == 0 ? Ptau : which == 1 ? Pt1 : Ps; dst[2 * p] = m * c2; dst[2 * p + 1] = m * s2;
        }
        __syncthreads();
        if (t < 256) {
            const int h = t >> 4, h2 = t & 15; float s = 0.f;
#pragma unroll 8
            for (int p = 0; p < NP; ++p) {
                const float cr = Cs[(h * NP + p) * 2], ci = Cs[(h * NP + p) * 2 + 1];
                const float pr = Ptau[2 * p], pi = Ptau[2 * p + 1], br = Bb[(p * 16 + h2) * 2], bi = Bb[(p * 16 + h2) * 2 + 1];
                const float xr = pr * br - pi * bi, xi = pr * bi + pi * br;
                s += cr * xr - ci * xi;
            }
            if (tau == 0 && h == h2) s += a.in[I_DSK][g * GH + h];
            Kt[t] = s;
        }
        __syncthreads();
        bf16* by = BTY + (size_t)g * 512 * U2G;
        for (int idx = t; idx < (TCH - tau) * 32; idx += NTHR) {
            const int j = idx >> 5, h = (idx >> 1) & 15, half = idx & 1, tt = tau + j, sidx = j;
            const LAS float* k = Kt + h * 16 + half * 8;
            v4u o; o.x = pk2(k[0], k[1]); o.y = pk2(k[2], k[3]); o.z = pk2(k[4], k[5]); o.w = pk2(k[6], k[7]);
            *(v4u*)(by + (size_t)(tt * 16 + h) * U2G + sidx * 16 + half * 8) = o;
        }
        if (tau >= 1) for (int idx = t; idx < (TCH - tau) * 32; idx += NTHR) {
            const int j = idx >> 5, h = (idx >> 1) & 15, half = idx & 1, tt = j, sidx = tau + j;
            *(v4u*)(by + (size_t)(tt * 16 + h) * U2G + sidx * 16 + half * 8) = (v4u){0u, 0u, 0u, 0u};
        }
        if (t < 256) {
            const int h = t >> 4, piece = t & 15; float v[8];
#pragma unroll
            for (int q = 0; q < 8; ++q) { const int pp = piece * 8 + q, p = pp & 63;
                const float cr = Cs[(h * NP + p) * 2], ci = Cs[(h * NP + p) * 2 + 1], pr = Pt1[2 * p], pi = Pt1[2 * p + 1];
                v[q] = (pp < 64) ? (cr * pr - ci * pi) : -(cr * pi + ci * pr); }
            v4u o; o.x = pk2(v[0], v[1]); o.y = pk2(v[2], v[3]); o.z = pk2(v[4], v[5]); o.w = pk2(v[6], v[7]);
            *(v4u*)(by + (size_t)(tau * 16 + h) * U2G + 512 + piece * 8) = o;
        } else {
            const int u = t - 256, n = u >> 1, half = u & 1, p = n & 63; float v[8];
#pragma unroll
            for (int q = 0; q < 8; ++q) { const int h = half * 8 + q; const float pr = Ps[2 * p], pi = Ps[2 * p + 1], br = Bb[(p * 16 + h) * 2], bi = Bb[(p * 16 + h) * 2 + 1];
                v[q] = (n < 64) ? (pr * br - pi * bi) : (pr * bi + pi * br); }
            v4u o; o.x = pk2(v[0], v[1]); o.y = pk2(v[2], v[3]); o.z = pk2(v[4], v[5]); o.w = pk2(v[6], v[7]);
            bf16* bs = BTS + (size_t)g * 256 * 512;
            *(v4u*)(bs + (size_t)n * 512 + tau * 16 + half * 8) = o;
            *(v4u*)(bs + (size_t)(128 + n) * 512 + tau * 16 + half * 8) = (v4u){0u, 0u, 0u, 0u};
        }
        __syncthreads();
        }
    }
}

using pg8::Unit; using pg8::cvt_pk_bf16;
struct EpiInProj {
    static constexpr bool PERM = true;
    bf16* U2; bf16* Z;
    __device__ __forceinline__ void operator()(const f32x4 (&acc)[2][2][4][2], const Unit& u, int wr, int wc, int fr, int fq) const {
#pragma unroll
        for (int ai = 0; ai < 2; ++ai)
#pragma unroll
            for (int m = 0; m < 4; ++m) {
                const int tok = u.pm * 256 + ai * 128 + wr * 64 + m * 16 + fr;
                if (u.pn < 2) {
                    const int b = tok >> 13, l = tok & 8191;
                    bf16* rowp = U2 + (size_t)(b * NCH + (l >> 5)) * U2LD + (l & 31) * 16;
#pragma unroll
                    for (int bj = 0; bj < 2; ++bj) { const int c0 = u.pn * 256 + bj * 128 + wc * 32 + 8 * fq; const f32x4 v0 = acc[ai][bj][m][0], v1 = acc[ai][bj][m][1];
                        v4u w; w.x = cvt_pk_bf16(v0[0], v0[1]); w.y = cvt_pk_bf16(v0[2], v0[3]); w.z = cvt_pk_bf16(v1[0], v1[1]); w.w = cvt_pk_bf16(v1[2], v1[3]);
                        *(v4u*)(rowp + (c0 >> 4) * U2G + (c0 & 15)) = w; }
                } else {
                    const int j0 = (u.pn - 2) * 128 + wc * 32 + 8 * fq;
                    const f32x4 a0 = acc[ai][0][m][0], a1 = acc[ai][0][m][1], g0 = acc[ai][1][m][0], g1 = acc[ai][1][m][1];
                    constexpr float KS = -1.4426950408889634f;
                    const f32x2 z0 = (f32x2){a0[0], a0[1]} * sig2((f32x2){g0[0], g0[1]}, KS), z1 = (f32x2){a0[2], a0[3]} * sig2((f32x2){g0[2], g0[3]}, KS);
                    const f32x2 z2 = (f32x2){a1[0], a1[1]} * sig2((f32x2){g1[0], g1[1]}, KS), z3 = (f32x2){a1[2], a1[3]} * sig2((f32x2){g1[2], g1[3]}, KS);
                    v4u w; w.x = cvt_pk_bf16(z0.x, z0.y); w.y = cvt_pk_bf16(z1.x, z1.y); w.z = cvt_pk_bf16(z2.x, z2.y); w.w = cvt_pk_bf16(z3.x, z3.y);
                    *(v4u*)(Z + (size_t)tok * DCONV + j0) = w;
                }
            }
    }
};
struct EpiGlu {
    static constexpr bool PERM = true;
    const bf16* YG; bf16* MRG; const float* bias;
    __device__ __forceinline__ void operator()(const f32x4 (&acc)[2][2][4][2], const Unit& u, int wr, int wc, int fr, int fq) const {
#pragma unroll
        for (int bj = 0; bj < 2; ++bj) {
            const int c0 = u.pn * 256 + bj * 128 + wc * 32 + 8 * fq;
            const f32x4 b0 = *(const f32x4*)(bias + c0), b1 = *(const f32x4*)(bias + c0 + 4);
#pragma unroll
            for (int ai = 0; ai < 2; ++ai)
#pragma unroll
                for (int m = 0; m < 4; ++m) {
                    const int tok = u.pm * 256 + ai * 128 + wr * 64 + m * 16 + fr;
                    float y[8]; unpack8(*(const v4u*)(YG + (size_t)tok * DSSM + c0), y);
                    const f32x4 v0 = acc[ai][bj][m][0] + b0, v1 = acc[ai][bj][m][1] + b1;
                    constexpr float KS = -1.4426950408889634f;
                    const f32x2 z0 = (f32x2){y[0], y[1]} * sig2((f32x2){v0[0], v0[1]}, KS), z1 = (f32x2){y[2], y[3]} * sig2((f32x2){v0[2], v0[3]}, KS);
                    const f32x2 z2 = (f32x2){y[4], y[5]} * sig2((f32x2){v1[0], v1[1]}, KS), z3 = (f32x2){y[6], y[7]} * sig2((f32x2){v1[2], v1[3]}, KS);
                    v4u w; w.x = cvt_pk_bf16(z0.x, z0.y); w.y = cvt_pk_bf16(z1.x, z1.y); w.z = cvt_pk_bf16(z2.x, z2.y); w.w = cvt_pk_bf16(z3.x, z3.y);
                    *(v4u*)(MRG + (size_t)tok * D + c0) = w;
                }
        }
    }
};
struct EpiOut {
    static constexpr bool PERM = true;
    const float* x; float* out; const float* mod; float* ssq;
    __device__ __forceinline__ void operator()(const f32x4 (&acc)[2][2][4][2], const Unit& u, int wr, int wc, int fr, int fq) const {
        const int b = (u.pm * 256) >> 13;
        f32x4 g1[2][2];
#pragma unroll
        for (int bj = 0; bj < 2; ++bj)
#pragma unroll
            for (int n = 0; n < 2; ++n) g1[bj][n] = *(const f32x4*)(mod + b * 6 * D + 2 * D + u.pn * 256 + bj * 128 + wc * 32 + 8 * fq + 4 * n);
#pragma unroll
        for (int ai = 0; ai < 2; ++ai)
#pragma unroll
            for (int m = 0; m < 4; ++m) {
                const int row = u.pm * 256 + ai * 128 + wr * 64 + m * 16 + fr; float sq = 0.f;
                bf16* drow = (bf16*)(out + (size_t)row * D);
#pragma unroll
                for (int bj = 0; bj < 2; ++bj) {
                    const int c0 = u.pn * 256 + bj * 128 + wc * 32 + 8 * fq;
                    const f32x4 o0 = *(const f32x4*)(x + (size_t)row * D + c0) + g1[bj][0] * acc[ai][bj][m][0], o1 = *(const f32x4*)(x + (size_t)row * D + c0 + 4) + g1[bj][1] * acc[ai][bj][m][1];
                    sq += ((o0[0] * o0[0] + o0[1] * o0[1]) + (o0[2] * o0[2] + o0[3] * o0[3])) + ((o1[0] * o1[0] + o1[1] * o1[1]) + (o1[2] * o1[2] + o1[3] * o1[3]));
                    v4u hi, lo;
                    hi.x = pk2(o0[0], o0[1]); hi.y = pk2(o0[2], o0[3]); hi.z = pk2(o1[0], o1[1]); hi.w = pk2(o1[2], o1[3]);
                    lo.x = pk2(o0[0] - bflo(hi.x), o0[1] - bfhi(hi.x)); lo.y = pk2(o0[2] - bflo(hi.y), o0[3] - bfhi(hi.y));
                    lo.z = pk2(o1[0] - bflo(hi.z), o1[1] - bfhi(hi.z)); lo.w = pk2(o1[2] - bflo(hi.w), o1[3] - bfhi(hi.w));
                    *(v4u*)(drow + D + c0) = hi; *(v4u*)(drow + c0) = lo;
                }
                sq += __shfl_xor(sq, 16); sq += __shfl_xor(sq, 32);
                if (fq == 0) ssq[row * 16 + u.pn * 4 + wc] = sq;
            }
    }
};

__device__ __forceinline__ void p2_fast(const Args& a, LAS unsigned char* lds) {
    pg8::SchedDense S; S.init((const bf16*)(a.ws + WS_H1), (const bf16*)(a.ws + WS_WIN), NTOK, DIN, D, D, D, gridDim.x, blockIdx.x, (REP_GEMM == 2) ? 2 : 1); S.tstamp = (TSTAMP_GEMM == 2) ? 1 : 0;
    EpiInProj E{(bf16*)(a.ws + WS_U2), (bf16*)(a.ws + WS_Z)};
    pg8::gemm_phase<EpiInProj, pg8::SchedDense, true>(lds, S, E);
}
__device__ __forceinline__ void p3d_fast(const Args& a, LAS unsigned char* lds) {
    pg8::SchedDense S; S.init((const bf16*)(a.ws + WS_YG), (const bf16*)(a.ws + WS_WGLU), NTOK, DSSM, DSSM, DSSM, DSSM, gridDim.x, blockIdx.x, (REP_GEMM == 6) ? 2 : 1);
    EpiGlu E{(const bf16*)(a.ws + WS_YG), (bf16*)(a.ws + WS_MRG), a.in[I_BGLU]};
    pg8::gemm_phase<EpiGlu, pg8::SchedDense, true>(lds, S, E);
}
__device__ __forceinline__ void p4_fast(const Args& a, LAS unsigned char* lds) {
    pg8::SchedDense S; S.init((const bf16*)(a.ws + WS_MRG), (const bf16*)(a.ws + WS_WOUT), NTOK, D, D, D, D, gridDim.x, blockIdx.x, (REP_GEMM == 8) ? 2 : 1);
    EpiOut E{a.in[I_X], a.out, (const float*)(a.ws + WS_MOD), (float*)(a.ws + WS_SSQ)};
    pg8::gemm_phase<EpiOut, pg8::SchedDense, ALIGN_P4>(lds, S, E);
}

template <bool GATHER>
struct SchedMoE {
    const LAS int* T; const char* Abase; const char* Bt; const int* tokk; int K, lda, ldb, nN, G, c; size_t bstride; int rep, eb, scale_a, scale_b, rep_epi, tstamp;
    __device__ __forceinline__ bool next(int i_, Unit& u) const {
        const int i = i_ / rep;
        const int NT = __builtin_amdgcn_readfirstlane(T[98 + NE]); int Tt, pn;
        if ((G & 7) == 0 && ((G >> 3) % nN) == 0) {
            const int x = c & 7, j = c >> 3, rtpr = (G >> 3) / nN, Ts = (x * NT) >> 3, Te = ((x + 1) * NT) >> 3;
            pn = j / rtpr; Tt = Ts + i * rtpr + (j % rtpr); if (Tt >= Te) return false;
            if (!GATHER) Tt = Te - 1 - (Tt - Ts);
        } else { const int L = i * G + c; Tt = L / nN; pn = L % nN; if (Tt >= NT) return false; }
        int e = 0;
        if (GATHER) { e = u.e;
            while (e + 1 < NE && __builtin_amdgcn_readfirstlane(T[98 + e + 1]) <= Tt) ++e; e = __builtin_amdgcn_readfirstlane(e); }
        else e = __builtin_amdgcn_readfirstlane(T[1280 + Tt]);
        u.e = e; u.pn = pn; u.pm = Tt; u.slot0 = __builtin_amdgcn_readfirstlane((Tt - T[98 + e]) * 256); u.row0 = __builtin_amdgcn_readfirstlane(T[32 + e] + u.slot0);
        const int left = __builtin_amdgcn_readfirstlane(T[e] - u.slot0); u.nvalid = left < 256 ? left : 256; return true;
    }
    __device__ __forceinline__ const char* a_base(const Unit& u) const { return GATHER ? Abase : Abase + (size_t)u.row0 * lda * eb; }
    __device__ __forceinline__ const char* b_base(const Unit& u) const { return Bt + ((size_t)u.e * bstride + (size_t)u.pn * 256 * ldb) * eb; }
    __device__ __forceinline__ void a_offsets(const Unit& u, const int (&R)[2], const int (&C)[2], unsigned (&off)[2][2]) const {
#pragma unroll
        for (int h = 0; h < 2; ++h)
#pragma unroll
            for (int i = 0; i < 2; ++i) {
                const int row = R[i] + 128 * h;
                if (GATHER) { int tok = 0; if (row < u.nvalid) tok = tokk[(size_t)u.e * CAP + u.slot0 + row] >> 2; off[h][i] = (unsigned)tok * (unsigned)(lda * eb) + (unsigned)C[i] * 2u; }
                else off[h][i] = (unsigned)(row * lda * eb + C[i] * 2);
            }
    }
};
struct EpiMoe1 {
    static constexpr bool PERM = true;
    bf16* ACT; const float* bg; const float* bu;
#if MOE1_WIDE
    __device__ __forceinline__ void operator()(f32x4 (&acc)[2][2][4][2], const Unit& u, int wr, int wc, int fr, int fq) const {
        asm volatile("" : "+v"(fr), "+v"(fq));
        const int gq = ((fq & 1) << 1) | (fq >> 1);
        const int f0 = u.pn * 128 + wc * 32 + 8 * gq;
        {
            const f32x4 g0 = *(const f32x4*)(bg + u.e * FF + f0), g1 = *(const f32x4*)(bg + u.e * FF + f0 + 4);
            const f32x4 u0 = *(const f32x4*)(bu + u.e * FF + f0) + 1.0f, u1 = *(const f32x4*)(bu + u.e * FF + f0 + 4) + 1.0f;
#pragma unroll
            for (int ai = 0; ai < 2; ++ai)
#pragma unroll
                for (int m = 0; m < 4; ++m) { acc[ai][0][m][0] += g0; acc[ai][0][m][1] += g1; acc[ai][1][m][0] += u0; acc[ai][1][m][1] += u1; }
            __builtin_amdgcn_sched_barrier(0);
        }
        unsigned char* dstu = (unsigned char*)ACT + (size_t)u.row0 * FF + u.pn * 128;
        const unsigned voff = (unsigned)((wr * 64 + (fq >> 1) * 16 + fr) * FF + wc * 32 + 16 * (fq & 1));
#pragma unroll
        for (int ai = 0; ai < 2; ++ai)
#pragma unroll
            for (int mp = 0; mp < 2; ++mp) {
                unsigned w[2][2];
#pragma unroll
                for (int mm = 0; mm < 2; ++mm) {
                    const int m = 2 * mp + mm;
                    float o[8];
#pragma unroll
                    for (int n = 0; n < 2; ++n) {
                        const f32x4 gv = acc[ai][0][m][n], uv = acc[ai][1][m][n];
#pragma unroll
                        for (int q = 0; q < 4; q += 2) {
                            const f32x2 gate = {fminf(gv[q], 7.0f), fminf(gv[q + 1], 7.0f)};
                            const f32x2 up1 = {__builtin_amdgcn_fmed3f(uv[q], -6.0f, 8.0f), __builtin_amdgcn_fmed3f(uv[q + 1], -6.0f, 8.0f)};
                            const f32x2 r = up1 * (gate * sig2(gate, -1.4426950408889634f * 1.702f));
                            o[n * 4 + q] = r.x; o[n * 4 + q + 1] = r.y;
                        }
                    }
                    w[mm][0] = pk_fp8x4(o[0], o[1], o[2], o[3]); w[mm][1] = pk_fp8x4(o[4], o[5], o[6], o[7]);
                    __builtin_amdgcn_sched_barrier(0);
                }
                const auto r0 = __builtin_amdgcn_permlane32_swap(w[0][0], w[1][0], false, false), r1 = __builtin_amdgcn_permlane32_swap(w[0][1], w[1][1], false, false);
                const v4u W = {r0[0], r1[0], r0[1], r1[1]};
                const int rl = ai * 128 + wr * 64 + (2 * mp + (fq >> 1)) * 16 + fr;
                if (rl < u.nvalid) *(v4u*)(dstu + (voff + (unsigned)((ai * 128 + mp * 32) * FF))) = W;
            }
#else
    __device__ __forceinline__ void operator()(const f32x4 (&acc)[2][2][4][2], const Unit& u, int wr, int wc, int fr, int fq) const {
        const int f0 = u.pn * 128 + wc * 32 + 8 * fq;
        const f32x4 g0 = *(const f32x4*)(bg + u.e * FF + f0), g1 = *(const f32x4*)(bg + u.e * FF + f0 + 4), u0 = *(const f32x4*)(bu + u.e * FF + f0), u1 = *(const f32x4*)(bu + u.e * FF + f0 + 4);
#pragma unroll
        for (int ai = 0; ai < 2; ++ai)
#pragma unroll
            for (int m = 0; m < 4; ++m) {
                const int rl = ai * 128 + wr * 64 + m * 16 + fr;
                if (rl < u.nvalid) {
                    float o[8];
#pragma unroll
                    for (int n = 0; n < 2; ++n) {
                        const f32x4 gv = acc[ai][0][m][n] + (n ? g1 : g0), uv = acc[ai][1][m][n] + (n ? u1 : u0);
#pragma unroll
                        for (int q = 0; q < 4; q += 2) {
                            const f32x2 gate = {fminf(gv[q], 7.0f), fminf(gv[q + 1], 7.0f)};
                            const f32x2 up = {__builtin_amdgcn_fmed3f(uv[q], -7.0f, 7.0f), __builtin_amdgcn_fmed3f(uv[q + 1], -7.0f, 7.0f)};
                            const f32x2 r = (up + 1.0f) * (gate * sig2(gate, -1.4426950408889634f * 1.702f));
                            o[n * 4 + q] = r.x; o[n * 4 + q + 1] = r.y;
                        }
                    }
#if MOE2_F8
                    v2u w; w.x = pk_fp8x4(o[0], o[1], o[2], o[3]); w.y = pk_fp8x4(o[4], o[5], o[6], o[7]);
                    *(v2u*)((unsigned char*)ACT + (size_t)(u.row0 + rl) * FF + f0) = w;
#else
                    v4u w; w.x = cvt_pk_bf16(o[0], o[1]); w.y = cvt_pk_bf16(o[2], o[3]); w.z = cvt_pk_bf16(o[4], o[5]); w.w = cvt_pk_bf16(o[6], o[7]);
                    *(v4u*)(ACT + (size_t)(u.row0 + rl) * FF + f0) = w;
#endif
                }
            }
#endif
    }
};
struct EpiMoe2 {
    static constexpr bool PERM = true;
    float* out; unsigned char* ws; const int* tokk; const float* bd;
    __device__ __forceinline__ void operator()(const f32x4 (&acc)[2][2][4][2], const Unit& u, int wr, int wc, int fr, int fq) const {
#if MOE2_WIDE
        const int c0 = u.pn * 256 + wc * 64 + 16 * fq;
#else
        const int c0 = u.pn * 256 + wc * 32 + 8 * fq;
#endif
        f32x4 bv[2][2];
#pragma unroll
        for (int bj = 0; bj < 2; ++bj)
#pragma unroll
            for (int n = 0; n < 2; ++n) bv[bj][n] = *(const f32x4*)(bd + u.e * D + c0 + (MOE2_WIDE ? bj * 8 : bj * 128) + 4 * n);
        int tks[2][4];
#pragma unroll
        for (int ai = 0; ai < 2; ++ai)
#pragma unroll
            for (int m = 0; m < 4; ++m) { const int rl = ai * 128 + wr * 64 + m * 16 + fr; tks[ai][m] = (rl < u.nvalid) ? tokk[(size_t)u.e * CAP + u.slot0 + rl] : 0; }
#pragma unroll
        for (int ai = 0; ai < 2; ++ai)
#pragma unroll
            for (int m = 0; m < 4; ++m) {
                const int rl = ai * 128 + wr * 64 + m * 16 + fr;
                if (rl < u.nvalid) {
                    const int tk = tks[ai][m], tok = tk >> 2, k = tk & 3;
#if YS_F8
                    unsigned char* dst = (k == 0) ? (unsigned char*)(out + (size_t)tok * D) : (k == 3) ? (ws + WS_YS3) + (size_t)tok * D : (ws + WS_YS12) + ((size_t)(k - 1) * NTOK + tok) * D;
#if MOE2_WIDE
                    const f32x4 v0 = acc[ai][0][m][0] + bv[0][0], v1 = acc[ai][0][m][1] + bv[0][1], v2 = acc[ai][1][m][0] + bv[1][0], v3 = acc[ai][1][m][1] + bv[1][1];
                    v4u w; w.x = pk_fp8x4(v0[0], v0[1], v0[2], v0[3]); w.y = pk_fp8x4(v1[0], v1[1], v1[2], v1[3]); w.z = pk_fp8x4(v2[0], v2[1], v2[2], v2[3]); w.w = pk_fp8x4(v3[0], v3[1], v3[2], v3[3]);
                    *(v4u*)(dst + c0) = w;
#else
#pragma unroll
                    for (int bj = 0; bj < 2; ++bj) { const f32x4 v0 = acc[ai][bj][m][0] + bv[bj][0], v1 = acc[ai][bj][m][1] + bv[bj][1];
                        v2u w; w.x = pk_fp8x4(v0[0], v0[1], v0[2], v0[3]); w.y = pk_fp8x4(v1[0], v1[1], v1[2], v1[3]);
                        *(v2u*)(dst + c0 + bj * 128) = w; }
#endif
#else
                    bf16* dst = (k == 0) ? (bf16*)(out + (size_t)tok * D) : (k == 3) ? (bf16*)(ws + WS_YS3) + (size_t)tok * D : (bf16*)(ws + WS_YS12) + ((size_t)(k - 1) * NTOK + tok) * D;
#pragma unroll
                    for (int bj = 0; bj < 2; ++bj) { const f32x4 v0 = acc[ai][bj][m][0] + bv[bj][0], v1 = acc[ai][bj][m][1] + bv[bj][1];
                        v4u w; w.x = cvt_pk_bf16(v0[0], v0[1]); w.y = cvt_pk_bf16(v0[2], v0[3]); w.z = cvt_pk_bf16(v1[0], v1[1]); w.w = cvt_pk_bf16(v1[2], v1[3]);
                        *(v4u*)(dst + c0 + bj * 128) = w; }
#endif
                }
            }
    }
};
__device__ __forceinline__ void p7_fast(const Args& a, LAS unsigned char* lds, LAS int* T) {
    SchedMoE<true> S{T, (const char*)(a.ws + WS_H2), (const char*)(a.ws + WS_WGU), (const int*)(a.ws + WS_TOKK), D, D, D, 8, (int)gridDim.x, (int)blockIdx.x, (size_t)2048 * D, (REP_GEMM == 10) ? 2 : 1, MOE1_F8 ? 1 : 2, 127, 127 - 5, (REP_EPI == 10) ? 1 : 0, (TSTAMP_GEMM == 10) ? 1 : 0};
    EpiMoe1 E{(bf16*)(a.ws + WS_ACT), a.in[I_BG], a.in[I_BU]};
    pg8::gemm_phase<EpiMoe1, SchedMoE<true>, ALIGN_MOE, MOE1_F8 != 0>(lds, S, E);
}
__device__ __forceinline__ void p8_fast(const Args& a, LAS unsigned char* lds, LAS int* T) {
    SchedMoE<false> S{T, (const char*)(a.ws + WS_ACT), (const char*)(a.ws + WS_WD), (const int*)(a.ws + WS_TOKK), FF, FF, FF, 4, (int)gridDim.x, (int)blockIdx.x, (size_t)D * FF, (REP_GEMM == 11) ? 2 : 1, MOE2_F8 ? 1 : 2, 127, MOE2_F8 ? 127 - 5 : 127, (REP_EPI == 11) ? 1 : 0, (TSTAMP_GEMM == 11) ? 1 : 0};
    EpiMoe2 E{a.out, a.ws, (const int*)(a.ws + WS_TOKK), a.in[I_BD]};
    pg8::gemm_phase<EpiMoe2, SchedMoE<false>, ALIGN_MOE, MOE2_F8 != 0>(lds, S, E);
}

struct EpiSloc {
    static constexpr bool PERM = false;
    float* SL;
    __device__ __forceinline__ void operator()(const f32x4 (&acc)[2][2][4][2], const Unit& u, int wr, int wc, int fr, int fq) const {
#pragma unroll
        for (int ai = 0; ai < 2; ++ai)
#pragma unroll
            for (int m = 0; m < 4; ++m) {
                float* rowp = SL + (size_t)(u.pm * 256 + ai * 128 + wr * 64 + m * 16 + fr) * (NG * 128) + u.e * 128 + wc * 32 + 4 * fq;
#pragma unroll
                for (int n = 0; n < 2; ++n) *(f32x4*)(rowp + n * 16) = acc[ai][0][m][n];
            }
    }
};
struct EpiY {
    static constexpr bool PERM = true;
    bf16* YG;
    __device__ __forceinline__ void operator()(const f32x4 (&acc)[2][2][4][2], const Unit& u, int wr, int wc, int fr, int fq) const {
#pragma unroll
        for (int ai = 0; ai < 2; ++ai)
#pragma unroll
            for (int m = 0; m < 4; ++m) {
                const int r = u.pm * 256 + ai * 128 + wr * 64 + m * 16 + fr;
#pragma unroll
                for (int bj = 0; bj < 2; ++bj) {
                    const int c0 = u.pn * 256 + bj * 128 + wc * 32 + 8 * fq, t = c0 >> 4, h0 = c0 & 15;
                    const f32x4 v0 = acc[ai][bj][m][0], v1 = acc[ai][bj][m][1];
                    const f32x2 z0 = gelu2((f32x2){v0[0], v0[1]}), z1 = gelu2((f32x2){v0[2], v0[3]}), z2 = gelu2((f32x2){v1[0], v1[1]}), z3 = gelu2((f32x2){v1[2], v1[3]});
                    v4u w; w.x = cvt_pk_bf16(z0.x, z0.y); w.y = cvt_pk_bf16(z1.x, z1.y); w.z = cvt_pk_bf16(z2.x, z2.y); w.w = cvt_pk_bf16(z3.x, z3.y);
                    *(v4u*)(YG + (size_t)(r * 32 + t) * DSSM + u.e * GH + h0) = w;
                }
            }
    }
};
__device__ __forceinline__ void p3a_fast(const Args& a, LAS unsigned char* lds) {
    pg8::SchedGroup S{(const bf16*)(a.ws + WS_U2), (const bf16*)(a.ws + WS_BTS), 512, U2LD, 512, NROW2 / 256, 1, NG, (int)gridDim.x, (int)blockIdx.x, (size_t)U2G, (size_t)256 * 512, (REP_GEMM == 3) ? 2 : 1, 1 << 30};
    EpiSloc E{(float*)(a.ws + WS_SLOC)};
    pg8::gemm_phase<EpiSloc, pg8::SchedGroup, true>(lds, S, E);
}
__device__ __forceinline__ void p3c_fast(const Args& a, LAS unsigned char* lds) {
    pg8::SchedGroup S{(const bf16*)(a.ws + WS_U2), (const bf16*)(a.ws + WS_BTY), U2G, U2LD, U2G, NROW2 / 256, 2, NG, (int)gridDim.x, (int)blockIdx.x, (size_t)U2G, (size_t)512 * U2G, (REP_GEMM == 5) ? 2 : 1, 1 << 30};
    EpiY E{(bf16*)(a.ws + WS_YG)};
    pg8::gemm_phase<EpiY, pg8::SchedGroup, true>(lds, S, E);
}
__device__ __forceinline__ void p3c_pair(const Args& a, LAS unsigned char* lds, int g, int pm) {
    pg8::SchedGroup S{(const bf16*)(a.ws + WS_U2), (const bf16*)(a.ws + WS_BTY), U2G, U2LD, U2G, NROW2 / 256, 2, NG, NROW2 / 256, g * 2 * (NROW2 / 256) + pm, (size_t)U2G, (size_t)512 * U2G, 1, 2};
    EpiY E{(bf16*)(a.ws + WS_YG)};
    pg8::gemm_phase<EpiY, pg8::SchedGroup, true>(lds, S, E);
}
__device__ __forceinline__ void p3b_scan(const Args& a, LAS float* sm, bool fused) {
    const float* SL = (const float*)(a.ws + WS_SLOC); bf16* U2 = (bf16*)(a.ws + WS_U2);
    const int t = threadIdx.x, p = t & 63, seg = t >> 6;
    for (int task = blockIdx.x; task < NB * NG; task += gridDim.x) {
        const int b = fused ? (task % (NROW2 / 256)) : (task / NG), g = fused ? (task / (NROW2 / 256)) : (task % NG);
        const float lr = a.in[I_LRE][g * NP + p], li = a.in[I_LIM][g * NP + p], dt = expf(a.in[I_LDT][g]);
        float ar, ai, br, bi;
        { const float m = expf(32.f * lr * dt); float s2, c2; sincosf(32.f * li * dt, &s2, &c2); ar = m * c2; ai = m * s2; }
        { const float m = expf(1024.f * lr * dt); float s2, c2; sincosf(1024.f * li * dt, &s2, &c2); br = m * c2; bi = m * s2; }
        const float* sl = SL + (size_t)(b * NCH + seg * 32) * (NG * 128) + g * 128 + p;
        float sr = 0.f, si = 0.f;
        float lre[32], lim[32];
#pragma unroll
        for (int c = 0; c < 32; ++c) { lre[c] = sl[(size_t)c * (NG * 128)]; lim[c] = sl[(size_t)c * (NG * 128) + 64]; }
#pragma unroll
        for (int c = 0; c < 32; ++c) { const float nr = ar * sr - ai * si + lre[c], ni = ar * si + ai * sr + lim[c]; sr = nr; si = ni; }
        sm[(seg * 64 + p) * 2] = sr; sm[(seg * 64 + p) * 2 + 1] = si;
        __syncthreads();
        float cr = 0.f, ci = 0.f;
        for (int s = 0; s < seg; ++s) { const float er = sm[(s * 64 + p) * 2], ei = sm[(s * 64 + p) * 2 + 1]; const float nr = br * cr - bi * ci + er, ni = br * ci + bi * cr + ei; cr = nr; ci = ni; }
        bf16* up = U2 + (size_t)(b * NCH + seg * 32) * U2LD + g * U2G + 512 + p;
        sr = cr; si = ci;
#pragma unroll
        for (int c = 0; c < 32; ++c) {
            up[(size_t)c * U2LD] = (bf16)f2bf(sr); up[(size_t)c * U2LD + 64] = (bf16)f2bf(si);
            const float nr = ar * sr - ai * si + lre[c], ni = ar * si + ai * sr + lim[c]; sr = nr; si = ni;
        }
        __syncthreads();
    }
}


#define XB_TMO      128
#define XB_XCNT(j)  (256  + 64 * (j))
#define XB_XSUB(j)  (1280 + 64 * (j))
#define XB_XGEN(j)  (2304 + 64 * (j))
#define XB_TOP      3328
#define XB_TOPGEN   3392
#define XCD_BAR_WORDS 3456
#define XB_SPIN_CAP (1u << 22)
__device__ __forceinline__ unsigned xb_ld(unsigned* p)              { return __hip_atomic_load(p, __ATOMIC_RELAXED, __HIP_MEMORY_SCOPE_AGENT); }
__device__ __forceinline__ unsigned xb_add(unsigned* p, unsigned v) { return __hip_atomic_fetch_add(p, v, __ATOMIC_RELAXED, __HIP_MEMORY_SCOPE_AGENT); }
__device__ __forceinline__ unsigned xb_xcc_id() { return (unsigned)__builtin_amdgcn_s_getreg((3 << 11) | 20) & 0xFu; }
#define XB_SPIN(cond, bar) do { unsigned _sp = 0; while (cond) { __builtin_amdgcn_s_sleep(1); \
    if ((++_sp & 255u) == 0u) { if (xb_ld(&(bar)[XB_TMO])) break; if (_sp > XB_SPIN_CAP) { atomicAdd(&(bar)[XB_TMO], 1u); break; } } } } while (0)
struct XcdBarrier { unsigned* bar; unsigned x; volatile LAS unsigned* st; };
__device__ __forceinline__ XcdBarrier xcd_barrier_post(unsigned* bar, volatile LAS unsigned* st) {
    XcdBarrier b; b.bar = bar; b.x = xb_xcc_id(); b.st = st;
    if (threadIdx.x == 0) (void)xb_add(&bar[XB_XCNT(b.x)], 1u);
    return b;
}
__device__ __forceinline__ void xcd_barrier_complete(unsigned* bar, unsigned x, unsigned& nloc, unsigned& nx) {
    const unsigned G = gridDim.x * gridDim.y * gridDim.z;
    unsigned sum, cnt, mine, sp = 0u;
    for (;;) {
        sum = 0u; cnt = 0u; mine = 0u;
#pragma unroll
        for (unsigned j = 0; j < 16; ++j) { const unsigned c = xb_ld(&bar[XB_XCNT(j)]); sum += c; cnt += (c > 0u) ? 1u : 0u; mine = (j == x) ? c : mine; }
        if (sum == G) break;
        __builtin_amdgcn_s_sleep(1);
        if ((++sp & 255u) == 0u) { if (xb_ld(&bar[XB_TMO])) break; if (sp > XB_SPIN_CAP) { atomicAdd(&bar[XB_TMO], 1u); break; } }
    }
    nloc = mine > 0u ? mine : 1u; nx = cnt > 0u ? cnt : 1u;
}
__device__ __forceinline__ void xcd_barrier(const XcdBarrier& b) {
    asm volatile("s_waitcnt vmcnt(0)" ::: "memory");
    __syncthreads();
    if (threadIdx.x == 0) {
        unsigned* bar = b.bar;
        __builtin_amdgcn_s_waitcnt(0);
        unsigned nloc = b.st[0], nx = b.st[1];
        if (nloc == 0u) { xcd_barrier_complete(bar, b.x, nloc, nx); b.st[0] = nloc; b.st[1] = nx; }
        const unsigned old = xb_add(&bar[XB_XSUB(b.x)], 1u);
        const unsigned gen = old / nloc;
        if (old + 1u == (gen + 1u) * nloc) {
            __builtin_amdgcn_fence(__ATOMIC_RELEASE, "agent");
            asm volatile("s_waitcnt vmcnt(0)" ::: "memory");
            const unsigned og = xb_add(&bar[XB_TOP], 1u);
            const unsigned tg = og / nx;
            if (og + 1u == (tg + 1u) * nx) xb_add(&bar[XB_TOPGEN], 1u);
            else XB_SPIN(xb_ld(&bar[XB_TOPGEN]) == tg, bar);
            __builtin_amdgcn_fence(__ATOMIC_ACQUIRE, "agent");
            xb_add(&bar[XB_XGEN(b.x)], 1u);
            asm volatile("s_waitcnt vmcnt(0)" ::: "memory");
        } else {
            XB_SPIN(xb_ld(&bar[XB_XGEN(b.x)]) == gen, bar);
            __builtin_amdgcn_fence(__ATOMIC_ACQUIRE, "agent");
            asm volatile("s_waitcnt vmcnt(0)" ::: "memory");
        }
    }
    __syncthreads();
}

__device__ __forceinline__ void p1_router_item(const Args& a, int it, int lane) {
    const float* rw = a.in[I_RW]; const float* g = a.in[I_N2G]; const float* mod = (const float*)(a.ws + WS_MOD);
    bf16* RWH = (bf16*)(a.ws + WS_RWT); bf16* RWL = RWH + NB * NE * D; float* rbias = (float*)(a.ws + WS_RWT + 524288);
    {
        const int b = it >> 5, e = it & 31; float bs = 0.f;
#pragma unroll 4
        for (int j = 0; j < 16; ++j) {
            const int k = lane + 64 * j; const float w = rw[k * NE + e], wp = w * g[k] * (1.0f + mod[b * 6 * D + 4 * D + k]);
            const unsigned hi = f2bf(wp), lo = f2bf(wp - bf2f(hi));
            RWH[(size_t)(b * NE + e) * D + k] = (bf16)hi; RWL[(size_t)(b * NE + e) * D + k] = (bf16)lo;
            bs += mod[b * 6 * D + 3 * D + k] * w;
        }
        bs = wave_sum(bs);
        if (lane == 0) rbias[b * NE + e] = bs + a.in[I_RB][e];
    }
}
__device__ __forceinline__ void top4_of8(float (&v)[8], const int (&e)[8], float (&tv)[4], int (&ti)[4]) {
#pragma unroll
    for (int r = 0; r < 4; ++r) {
        float bv = v[0]; int be = e[0];
#pragma unroll
        for (int i = 1; i < 8; ++i) { const bool t = v[i] > bv || (v[i] == bv && e[i] < be); bv = t ? v[i] : bv; be = t ? e[i] : be; }
        tv[r] = bv; ti[r] = be;
#pragma unroll
        for (int i = 0; i < 8; ++i) v[i] = (e[i] == be) ? -3.0e38f : v[i];
    }
}
__device__ __forceinline__ bf16x8 pack_hi8(const f32x4 x0, const f32x4 x1, bf16x8& lo) {
    const float f[8] = {x0[0], x0[1], x0[2], x0[3], x1[0], x1[1], x1[2], x1[3]};
    v4u h, l;
#pragma unroll
    for (int i = 0; i < 4; ++i) { const unsigned w = pk2(f[2 * i], f[2 * i + 1]); h[i] = w; l[i] = pk2(f[2 * i] - bflo(w), f[2 * i + 1] - bfhi(w)); }
    lo = __builtin_bit_cast(bf16x8, l);
    return __builtin_bit_cast(bf16x8, h);
}
__device__ __forceinline__ void p5_fast(const Args& a, LAS unsigned char* lds, int lane, int wave) {
    LAS unsigned* hist = (LAS unsigned*)(lds + 131072 + 1024);
    LAS unsigned* basearr = hist + 64;
    const bf16* RWH = (const bf16*)(a.ws + WS_RWT); const bf16* RWL = RWH + NB * NE * D; const float* rbias = (const float*)(a.ws + WS_RWT + 524288);
    const float* g = a.in[I_N2G]; const float* mod = (const float*)(a.ws + WS_MOD);
    bf16* H2 = (bf16*)(a.ws + WS_H2); float* topw = (float*)(a.ws + WS_TOPW); int* tokk = (int*)(a.ws + WS_TOKK); unsigned* cnt = (unsigned*)(a.ws + WS_CTL) + CW_CNT;
    const int col = lane & 15, q = lane >> 4;
    LAS float* gam = (LAS float*)(lds + 131072 + 8192); LAS float* bet = gam + D;
    int lds_batch = -1;
    if (threadIdx.x < 96) hist[threadIdx.x] = 0u;
    __syncthreads();
    int iter = 0;
    for (int task0 = blockIdx.x * NWAVES; task0 < NTOK / 16; task0 += gridDim.x * NWAVES, ++iter) {
        const int task = task0 + wave; const bool active = task < NTOK / 16;
        float tv[4] = {0.f, 0.f, 0.f, 0.f}; int ti[4] = {0, 1, 2, 3}; unsigned rank[4] = {0u, 0u, 0u, 0u};
        const int tok = task * 16 + col, b = (task * 16) >> 13;
        LAS unsigned* hcur = hist + (iter & 1) * 32;
        {
            const int bb = (task0 * 16) >> 13;
            if (bb != lds_batch) {
                __syncthreads();
                const v4u* srch = (const v4u*)(RWH + (size_t)bb * NE * D); const v4u* srcl = (const v4u*)(RWL + (size_t)bb * NE * D);
#pragma unroll
                for (int i = 0; i < 8; ++i) { const int ci = threadIdx.x + NTHR * i, e = ci >> 7, c = ci & 127, d = (e * 128 + (c ^ (e & 15))) * 16;
                    *(LAS v4u*)(lds + d) = srch[ci]; *(LAS v4u*)(lds + 65536 + d) = srcl[ci]; }
                for (int k = threadIdx.x; k < D; k += NTHR) { gam[k] = g[k] * (1.0f + mod[bb * 6 * D + 4 * D + k]); bet[k] = mod[bb * 6 * D + 3 * D + k]; }
                lds_batch = bb;
                __syncthreads();
            }
        }
        if (active) {
            float rstd;
            { const f32x4* sp = (const f32x4*)((const float*)(a.ws + WS_SSQ) + (size_t)tok * 16); const f32x4 s0 = sp[0], s1 = sp[1], s2 = sp[2], s3 = sp[3];
              const float ss = (((s0[0] + s0[1]) + (s0[2] + s0[3])) + ((s1[0] + s1[1]) + (s1[2] + s1[3]))) + (((s2[0] + s2[1]) + (s2[2] + s2[3])) + ((s3[0] + s3[1]) + (s3[2] + s3[3])));
              rstd = rsqrtf(ss * (1.f / D) + 1e-6f); }
            f32x4 acc0 = {0.f, 0.f, 0.f, 0.f}, acc1 = {0.f, 0.f, 0.f, 0.f};
            const bf16* hrow = (const bf16*)(a.out + (size_t)tok * D) + D + 8 * q; const bf16* lrow = (const bf16*)(a.out + (size_t)tok * D) + 8 * q;
            v4u rh[8], rl[8];
#pragma unroll
            for (int i = 0; i < 8; ++i) { rh[i] = __builtin_nontemporal_load((const v4u*)(hrow + 32 * i)); rl[i] = __builtin_nontemporal_load((const v4u*)(lrow + 32 * i)); }
            const int e0 = col, e1 = 16 + col;
#pragma unroll 1
            for (int so = 0; so < 32; so += 8) {
#pragma unroll
                for (int si = 0; si < 8; ++si) {
                    const int st = so + si, k0 = 32 * st, k = k0 + 8 * q, c = 4 * st + q;
                    const v4u xh = rh[si], xl = rl[si];
                    { const int kn = (st + 8 < 32) ? k0 + 256 : 0; rh[si] = __builtin_nontemporal_load((const v4u*)(hrow + kn)); rl[si] = __builtin_nontemporal_load((const v4u*)(lrow + kn)); }
                    asm volatile("" ::: "memory");
                    const bf16x8 a0h = *(const LAS bf16x8*)(lds + (e0 * 128 + (c ^ (e0 & 15))) * 16), a0l = *(const LAS bf16x8*)(lds + 65536 + (e0 * 128 + (c ^ (e0 & 15))) * 16);
                    const bf16x8 a1h = *(const LAS bf16x8*)(lds + (e1 * 128 + (c ^ (e1 & 15))) * 16), a1l = *(const LAS bf16x8*)(lds + 65536 + (e1 * 128 + (c ^ (e1 & 15))) * 16);
                    const f32x4 g0 = *(const LAS f32x4*)(gam + k), g1 = *(const LAS f32x4*)(gam + k + 4), s0 = *(const LAS f32x4*)(bet + k), s1 = *(const LAS f32x4*)(bet + k + 4);
                    const bf16x8 bh = __builtin_bit_cast(bf16x8, xh), bl = __builtin_bit_cast(bf16x8, xl);
                    acc0 = __builtin_amdgcn_mfma_f32_16x16x32_bf16(a0h, bh, acc0, 0, 0, 0); acc0 = __builtin_amdgcn_mfma_f32_16x16x32_bf16(a0h, bl, acc0, 0, 0, 0); acc0 = __builtin_amdgcn_mfma_f32_16x16x32_bf16(a0l, bh, acc0, 0, 0, 0);
                    acc1 = __builtin_amdgcn_mfma_f32_16x16x32_bf16(a1h, bh, acc1, 0, 0, 0); acc1 = __builtin_amdgcn_mfma_f32_16x16x32_bf16(a1h, bl, acc1, 0, 0, 0); acc1 = __builtin_amdgcn_mfma_f32_16x16x32_bf16(a1l, bh, acc1, 0, 0, 0);
                    const f32x4 x0 = {bflo(xh.x) + bflo(xl.x), bfhi(xh.x) + bfhi(xl.x), bflo(xh.y) + bflo(xl.y), bfhi(xh.y) + bfhi(xl.y)};
                    const f32x4 x1 = {bflo(xh.z) + bflo(xl.z), bfhi(xh.z) + bfhi(xl.z), bflo(xh.w) + bflo(xl.w), bfhi(xh.w) + bfhi(xl.w)};
                    const f32x4 h0 = x0 * rstd * g0 + s0, h1 = x1 * rstd * g1 + s1;
#if MOE1_F8
                    v2u hw; hw.x = pk_fp8x4(h0[0], h0[1], h0[2], h0[3]); hw.y = pk_fp8x4(h1[0], h1[1], h1[2], h1[3]);
                    *(v2u*)((unsigned char*)H2 + (size_t)tok * D + 8 * q + k0) = hw;
#else
                    v4u hw; hw.x = pk2(h0[0], h0[1]); hw.y = pk2(h0[2], h0[3]); hw.z = pk2(h1[0], h1[1]); hw.w = pk2(h1[2], h1[3]);
                    *(v4u*)(H2 + (size_t)tok * D + 8 * q + k0) = hw;
#endif
                    asm volatile("" ::: "memory");
                }
            }
            STAMP(19);
            float v[8]; int e[8];
#pragma unroll
            for (int j = 0; j < 4; ++j) { e[j] = 4 * q + j; e[4 + j] = 16 + 4 * q + j; v[j] = rstd * acc0[j] + rbias[b * NE + 4 * q + j]; v[4 + j] = rstd * acc1[j] + rbias[b * NE + 16 + 4 * q + j]; }
            top4_of8(v, e, tv, ti);
#pragma unroll
            for (int off = 16; off <= 32; off <<= 1) {
                float v2[8]; int e2[8];
#pragma unroll
                for (int r = 0; r < 4; ++r) { v2[r] = tv[r]; e2[r] = ti[r]; v2[4 + r] = __shfl_xor(tv[r], off); e2[4 + r] = __shfl_xor(ti[r], off); }
                top4_of8(v2, e2, tv, ti);
            }
            if (q == 0) {
#pragma unroll
                for (int r = 0; r < 4; ++r) rank[r] = __hip_atomic_fetch_add(hcur + ti[r], 1u, __ATOMIC_RELAXED, __HIP_MEMORY_SCOPE_WORKGROUP);
            }
        }
        STAMP(20);
        __syncthreads();
        STAMP(21);
        if (threadIdx.x < 32) { const unsigned n = hcur[threadIdx.x]; basearr[threadIdx.x] = n ? atomicAdd(cnt + 32 * threadIdx.x, n) : 0u; hist[((iter + 1) & 1) * 32 + threadIdx.x] = 0u; }
        __syncthreads();
        if (active && q == 0) {
            const float e1 = __expf(tv[1] - tv[0]), e2 = __expf(tv[2] - tv[0]), e3 = __expf(tv[3] - tv[0]), inv = 1.f / (1.f + e1 + e2 + e3);
            const float w[4] = {inv, e1 * inv, e2 * inv, e3 * inv};
#pragma unroll
            for (int r = 0; r < 4; ++r) { const unsigned slot = basearr[ti[r]] + rank[r]; tokk[(size_t)ti[r] * CAP + slot] = tok * 4 + r; }
            *(f32x4*)(topw + tok * 4) = (f32x4){w[0], w[1], w[2], w[3]};
        }
    }
}

constexpr int NPHASE = 13;
__global__ void __launch_bounds__(NTHR, 2) fwd_kernel(Args a) {
    extern __shared__ __attribute__((aligned(16))) unsigned char lds_raw[];
    LAS unsigned char* lds = (LAS unsigned char*)lds_raw;
    LAS float* sm = (LAS float*)lds;
    LAS int* T = (LAS int*)(lds + 131072);
#if USE_CG_SYNC
    cg::grid_group grid = cg::this_grid();
#else
    volatile LAS unsigned* MISC = (volatile LAS unsigned*)(lds + 131072 + 2048);
    if (threadIdx.x < 32) MISC[threadIdx.x] = 0u;
    __syncthreads();
    XcdBarrier xbar = xcd_barrier_post((unsigned*)(a.ws + WS_CTL) + CW_BAR, MISC + 8);
#endif
    const int tid = threadIdx.x, lane = tid & 63, wave = __builtin_amdgcn_readfirstlane(tid >> 6);
    const int gw = blockIdx.x * NWAVES + wave, ngw = gridDim.x * NWAVES;
    const int lo = a.ph_lo, hi = a.ph_hi;
#define IN(k) (lo <= (k) && (k) < hi)
#if TIME_PHASE >= 0
    LAS unsigned long long* TS = (LAS unsigned long long*)(lds + 131072 + 4096);
#endif
#if USE_CG_SYNC
#define SEAM(k) do { if (IN(k) && IN((k) + 1)) grid.sync(); } while (0)
#else
#define SEAM(k) do { if (IN(k) && IN((k) + 1)) xcd_barrier(xbar); } while (0)
#endif
#define REP(k) _Pragma("nounroll") for (int _r = 0; _r < (((REP_MASK >> (k)) & 1) ? a.rep_mask : 1); ++_r)
    STAMP(0); if (IN(0)) { REP(0) { p0_mod(a, sm); STAMP(16); p0_s5_mats(a, sm); __syncthreads(); STAMP(17); p0_convert(a, gw, ngw, lane); __syncthreads(); STAMP(18); } }
    STAMP(1); if (IN(0)) { mod_wait(a); p1_dynamic(a, lane); } SEAM(1);
    STAMP(2); if (IN(2)) { REP(2) { p2_fast(a, lds); } } SEAM(2);
    STAMP(3); if (IN(3)) { p3a_fast(a, lds); if (gridDim.x >= NB * NG) { asm volatile("s_waitcnt vmcnt(0)" ::: "memory"); __syncthreads(); if (blockIdx.x < NB * NG) { p3b_scan(a, sm, true); asm volatile("s_waitcnt vmcnt(0)" ::: "memory"); __syncthreads(); p3c_pair(a, lds, blockIdx.x / (NROW2 / 256), blockIdx.x % (NROW2 / 256)); } __syncthreads(); p3e_conv(a, sm, lane); } else p3e_conv(a, sm, lane); }
    if (gridDim.x < NB * NG) { SEAM(3); if (IN(4)) { p3b_scan(a, sm, false); __syncthreads(); p3e_conv(a, sm, lane); } }
    STAMP(4); if (gridDim.x < NB * NG) SEAM(4);
    STAMP(5); if (IN(5) && gridDim.x < NB * NG) { p3c_fast(a, lds); } SEAM(5);
    STAMP(6); if (IN(6)) { REP(6) { p3d_fast(a, lds); } } SEAM(6);
    STAMP(7); if (IN(7)) { p3e_norm(a, gw, ngw, lane); } SEAM(7);
    STAMP(8); if (IN(8)) { REP(8) { p4_fast(a, lds); } } SEAM(8);
    STAMP(9); if (IN(9)) { p5_fast(a, lds, lane, wave); } SEAM(9);
    STAMP(10); if (IN(10)) { moe_tables(a, T); REP(10) { p7_fast(a, lds, T); } } SEAM(10);
    STAMP(11); if (IN(11)) { moe_tables(a, T); REP(11) { p8_fast(a, lds, T); } } SEAM(11);
    STAMP(12); if (IN(12)) { p9_final(a, gw, ngw, lane); }
#undef REP
    STAMP(13);
#if TIME_PHASE >= 0
    if (blockIdx.x == 0 && threadIdx.x == 0) { const unsigned long long dt = TS[TIME_B] - TS[TIME_A], t1 = TS[13]; while (__builtin_amdgcn_s_memrealtime() - t1 < 8ull * dt) __builtin_amdgcn_s_sleep(8); }
#endif
#undef IN
#undef SEAM
}

#ifndef N_LAUNCHES
#define N_LAUNCHES 1
#endif
extern "C" void kernel_launch(void* const* d_in, const int* in_sizes, int n_in, void* d_out, int out_size, void* d_ws, size_t ws_size, hipStream_t stream) {
    static int grid = 0;
    if (grid == 0) {
        if (n_in != 32 || out_size != NTOK * D || ws_size < WS_END) { fprintf(stderr, "kernel_launch: unexpected problem (n_in %d out %d ws %zu)\n", n_in, out_size, ws_size); grid = -1; return; }
        int dev = 0, cus = 0, per_cu = 0;
        if (hipGetDevice(&dev) != hipSuccess || hipDeviceGetAttribute(&cus, hipDeviceAttributeMultiprocessorCount, dev) != hipSuccess) { grid = -1; return; }
        if (hipFuncSetAttribute((const void*)fwd_kernel, hipFuncAttributeMaxDynamicSharedMemorySize, LDS_BYTES) != hipSuccess) { fprintf(stderr, "kernel_launch: hipFuncSetAttribute failed\n"); grid = -1; return; }
        if (hipOccupancyMaxActiveBlocksPerMultiprocessor(&per_cu, (const void*)fwd_kernel, NTHR, LDS_BYTES) != hipSuccess || per_cu < 1) { fprintf(stderr, "kernel_launch: occupancy query says %d\n", per_cu); (void)hipGetLastError(); per_cu = 1; }
        grid = cus;
    }
    if (grid < 0) return;
    (void)hipMemsetAsync((char*)d_ws + WS_CTL, 0, 65536, stream);
    Args a{};
    for (int i = 0; i < 32; ++i) a.in[i] = (const float*)d_in[i];
    a.out = (float*)d_out; a.ws = (unsigned char*)d_ws; a.rep_mask = 2;
    for (int li = 0; li < N_LAUNCHES; ++li) {
        a.ph_lo = (N_LAUNCHES == 1) ? 0 : li; a.ph_hi = (N_LAUNCHES == 1) ? NPHASE : li + 1;
        void* args[] = {&a};
        hipError_t e = hipLaunchCooperativeKernel((const void*)fwd_kernel, dim3(grid), dim3(NTHR), args, LDS_BYTES, stream);
        if (e != hipSuccess) { fprintf(stderr, "kernel_launch: launch %d failed: %s\n", li, hipGetErrorString(e)); break; }
    }
}
```

```cpp
#include <hip/hip_runtime.h>
#include <hip/hip_cooperative_groups.h>
#include <cstdio>
#include <cstdint>
namespace cg = cooperative_groups;
#define MOE2_WIDE (MOE2_F8 && YS_F8)
#define MOE1_WIDE (MOE1_F8 && MOE2_F8)
#ifndef USE_CG_SYNC
#define USE_CG_SYNC 0
#endif
#ifndef YS_F8
#define YS_F8 1
#endif
#ifndef MOE2_F8
#define MOE2_F8 1
#endif
#ifndef MOE1_F8
#define MOE1_F8 1
#endif
#ifndef TIME_PHASE
#define TIME_PHASE -1
#endif
#ifndef TIME_A
#define TIME_A (TIME_PHASE)
#define TIME_B (TIME_PHASE + 1)
#endif
#ifndef X1_LO
#define X1_LO 0
#endif
#ifndef ALIGN_P4
#define ALIGN_P4 true
#endif
#ifndef ALIGN_MOE
#define ALIGN_MOE true
#endif
#ifndef TSTAMP_GEMM
#define TSTAMP_GEMM 0
#endif
#ifndef REP_EPI
#define REP_EPI 0
#endif
#ifndef REP_GEMM
#define REP_GEMM 0
#endif
#ifndef REP_MASK
#define REP_MASK 0
#endif

#define GAS __attribute__((address_space(1)))
#define LAS __attribute__((address_space(3)))
typedef unsigned short bf16;
typedef unsigned v4u __attribute__((ext_vector_type(4)));
typedef unsigned v2u __attribute__((ext_vector_type(2)));
typedef float f32x4 __attribute__((ext_vector_type(4)));
typedef float f32x2 __attribute__((ext_vector_type(2)));
typedef short bf16x8 __attribute__((ext_vector_type(8)));

constexpr int NB = 4, SEQ = 8192, D = 1024, NTOK = NB * SEQ;
constexpr int DSSM = 512, DCONV = 512, NG = 32, GH = 16, NP = 64, DIN = 1536, CW = 31;
constexpr int NE = 32, TOPK = 4, FF = 1024;
constexpr int TCH = 32, NCH = SEQ / TCH, NROW2 = NB * NCH, U2G = 640, U2LD = NG * U2G;
constexpr int NWAVES = 8, NTHR = 512;
constexpr int LDS_BYTES = 147456;
constexpr int CAP = NTOK;

enum { I_X = 0, I_C, I_ADAW, I_ADAB, I_N1G, I_WIN, I_LRE, I_LIM, I_LDT, I_BRE, I_BIM, I_CRE, I_CIM, I_DSK, I_WGLU, I_BGLU, I_CONVW, I_CONVB, I_LNG, I_LNB,
       I_ONG, I_WOUT, I_N2G, I_RW, I_RB, I_WG, I_BG, I_WU, I_BU, I_WD, I_BD, I_FG };

constexpr size_t MiB = 1u << 20;
constexpr size_t WS_WIN = 0 * MiB;
constexpr size_t WS_WGLU = 3 * MiB;
constexpr size_t WS_WOUT = 4 * MiB;
constexpr size_t WS_BTS = 6 * MiB;
constexpr size_t WS_BTY = 14 * MiB;
constexpr size_t WS_H2 = 0 * MiB;
constexpr size_t WS_YS3 = 0 * MiB;
constexpr size_t WS_CTL = 64 * MiB;
constexpr size_t WS_MOD = 64 * MiB + 65536;
constexpr size_t WS_TOPW = 65 * MiB;
constexpr size_t WS_TOKK = 66 * MiB;
constexpr size_t WS_RWT = 70 * MiB;
constexpr size_t WS_ACT = 72 * MiB;
constexpr size_t WS_SSQ = 72 * MiB;
constexpr size_t WS_H1 = 72 * MiB;
constexpr size_t WS_U2 = 136 * MiB;
constexpr size_t WS_Z = 176 * MiB;
constexpr size_t WS_SLOC = 208 * MiB;
constexpr size_t WS_YG = 224 * MiB;
constexpr size_t WS_MRG = 256 * MiB;
constexpr size_t WS_WD = 328 * MiB;
constexpr size_t WS_WGU = 392 * MiB;
constexpr size_t WS_YS12 = 392 * MiB;
constexpr size_t WS_END = 520 * MiB;
constexpr int CW_CNT = 8192  , CW_CONV = 64  , CW_MOD = 640, CW_P1 = 4608  , CW_CONVW = 5120  , CW_BAR = 1024;

struct Args { const float* in[32]; float* out; unsigned char* ws; int ph_lo, ph_hi, rep_mask, pad; };

__device__ __forceinline__ float bf2f(unsigned v) { return __builtin_bit_cast(float, v << 16); }
__device__ __forceinline__ unsigned f2bf(float f) { unsigned u = __builtin_bit_cast(unsigned, f); return (u + 0x7fffu + ((u >> 16) & 1u)) >> 16; }
__device__ __forceinline__ unsigned pk2(float lo, float hi) { unsigned r; asm("v_cvt_pk_bf16_f32 %0, %1, %2" : "=v"(r) : "v"(lo), "v"(hi)); return r; }
__device__ __forceinline__ float bflo(unsigned w) { return __builtin_bit_cast(float, w << 16); }
__device__ __forceinline__ float bfhi(unsigned w) { return __builtin_bit_cast(float, w & 0xffff0000u); }
__device__ __forceinline__ float sigmoidf_(float x) { return __builtin_amdgcn_rcpf(1.0f + __expf(-x)); }
__device__ __forceinline__ float siluf_(float x) { return x * sigmoidf_(x); }
__device__ __forceinline__ float gelu_tanh(float x) { const float u = 0.7978845608028654f * (x + 0.044715f * x * x * x); return x * sigmoidf_(2.0f * u); }
__device__ __forceinline__ f32x2 sig2(const f32x2 x, const float k  ) {
    const f32x2 t = x * k; f32x2 e; e.x = __builtin_amdgcn_exp2f(t.x); e.y = __builtin_amdgcn_exp2f(t.y);
    const f32x2 d = e + 1.0f; f32x2 r; r.x = __builtin_amdgcn_rcpf(d.x); r.y = __builtin_amdgcn_rcpf(d.y); return r; }
__device__ __forceinline__ f32x2 gelu2(const f32x2 x) {
    const f32x2 p = (x * x) * 0.044715f + 1.0f; return x * sig2(x * p, -1.4426950408889634f * 2.0f * 0.7978845608028654f); }
#define WS_DPP(v, ctrl, rmask) ((v) + __builtin_bit_cast(float, __builtin_amdgcn_update_dpp(0, __builtin_bit_cast(int, (v)), (ctrl), (rmask), 0xf, false)))
__device__ __forceinline__ float wave_sum(float v) {
    v = WS_DPP(v, 0x128, 0xf);
    v = WS_DPP(v, 0x124, 0xf);
    v = WS_DPP(v, 0x122, 0xf);
    v = WS_DPP(v, 0x121, 0xf);
    v = WS_DPP(v, 0x142, 0xa);
    v = WS_DPP(v, 0x143, 0xc);
    return __builtin_bit_cast(float, __builtin_amdgcn_readlane(__builtin_bit_cast(int, v), 63));
}
#define LDS_WAIT() asm volatile("s_waitcnt lgkmcnt(0)" ::: "memory")
#ifndef TIME_PHASE
#define TIME_PHASE -1
#endif
#if TIME_PHASE >= 0
extern __shared__ __attribute__((aligned(16))) unsigned char lds_raw_ts[];
#define STAMP(k) do { if (threadIdx.x == 0) ((LAS unsigned long long*)((LAS unsigned char*)lds_raw_ts + 131072 + 4096))[k] = __builtin_amdgcn_s_memrealtime(); } while (0)
#else
#define STAMP(k) do { } while (0)
#endif

__device__ __forceinline__ void p0_mod(const Args& a, LAS float* sm) {
    const float* c = a.in[I_C]; const float* W = a.in[I_ADAW]; const float* bias = a.in[I_ADAB];
    float* mod = (float*)(a.ws + WS_MOD);
    const int t = threadIdx.x, cl = t & 31, kq = t >> 5;
    if (blockIdx.x >= 192) return;
    LAS float* sc = sm + 2048;
    for (int i = t; i < NB * D; i += NTHR) sc[i] = siluf_(c[i]);
    __syncthreads();
    for (int item = blockIdx.x; item < 192; item += gridDim.x) {
        const int col = item * 32 + cl;
        float a0 = 0.f, a1 = 0.f, a2 = 0.f, a3 = 0.f;
#pragma unroll 16
        for (int k = kq; k < D; k += 16) {
            const float w = W[(size_t)k * (6 * D) + col];
            a0 += sc[k] * w; a1 += sc[D + k] * w; a2 += sc[2 * D + k] * w; a3 += sc[3 * D + k] * w;
        }
        sm[(kq * 32 + cl) * 4 + 0] = a0; sm[(kq * 32 + cl) * 4 + 1] = a1; sm[(kq * 32 + cl) * 4 + 2] = a2; sm[(kq * 32 + cl) * 4 + 3] = a3;
        __syncthreads();
        if (t < 128) { const int b = t >> 5; float s = 0.f;
#pragma unroll
            for (int q = 0; q < 16; ++q) s += sm[(q * 32 + cl) * 4 + b];
            mod[b * 6 * D + col] = s + bias[col]; }
        __syncthreads();
        if (t == 0) {
            __builtin_amdgcn_fence(__ATOMIC_RELEASE, "agent"); asm volatile("s_waitcnt vmcnt(0)" ::: "memory");
            __hip_atomic_fetch_add((unsigned*)(a.ws + WS_CTL) + CW_MOD, 1u, __ATOMIC_RELAXED, __HIP_MEMORY_SCOPE_AGENT);
        }
    }
}
__device__ __forceinline__ void mod_wait(const Args& a) {
    if (threadIdx.x == 0) {
        unsigned* f = (unsigned*)(a.ws + WS_CTL) + CW_MOD; unsigned sp = 0;
        while (__hip_atomic_load(f, __ATOMIC_RELAXED, __HIP_MEMORY_SCOPE_AGENT) < 192u) { __builtin_amdgcn_s_sleep(2); if (++sp > (1u << 24)) break; }
        __builtin_amdgcn_fence(__ATOMIC_ACQUIRE, "agent"); asm volatile("s_waitcnt vmcnt(0)" ::: "memory");
    }
    __syncthreads();
}

__device__ __forceinline__ void p1_router_item(const Args& a, int it, int lane);
__device__ __forceinline__ void p1_dynamic(const Args& a, int lane) {
    const float* x = a.in[I_X]; const float* g = a.in[I_N1G]; const float* mod = (const float*)(a.ws + WS_MOD); bf16* h1 = (bf16*)(a.ws + WS_H1);
    constexpr int NIT = NB * NE + NTOK / 4;
    const int xq = blockIdx.x & 7, lo = (int)(((long)NIT * xq) >> 3), hi = (int)(((long)NIT * (xq + 1)) >> 3);
    unsigned* ctr = (unsigned*)(a.ws + WS_CTL) + CW_P1 + 64 * xq;
    for (;;) {
        int it0 = 0; if (lane == 0) it0 = (int)atomicAdd(ctr, 2u); it0 = __builtin_amdgcn_readfirstlane(it0) + lo;
        if (it0 >= hi) break;
#pragma unroll 1
        for (int it = it0; it < it0 + 2 && it < hi; ++it) {
        if (it < NB * NE) { p1_router_item(a, it, lane); continue; }
        const int m0 = (it - NB * NE) * 4;
        f32x4 v[4][4];
#pragma unroll
        for (int u = 0; u < 4; ++u)
#pragma unroll
            for (int j = 0; j < 4; ++j) v[u][j] = __builtin_nontemporal_load((const f32x4*)(x + (size_t)(m0 + u) * D) + lane + 64 * j);
#pragma unroll
        for (int u = 0; u < 4; ++u) {
            const int m = m0 + u, b = m >> 13; float s = 0.f;
#pragma unroll
            for (int j = 0; j < 4; ++j) s += (v[u][j].x * v[u][j].x + v[u][j].y * v[u][j].y) + (v[u][j].z * v[u][j].z + v[u][j].w * v[u][j].w);
            const float rstd = rsqrtf(wave_sum(s) * (1.f / D) + 1e-6f);
            unsigned long long* o8 = (unsigned long long*)(h1 + (size_t)m * D) + lane;
#pragma unroll
            for (int j = 0; j < 4; ++j) {
                const int k = 4 * lane + 256 * j;
                const f32x4 gg = *(const f32x4*)(g + k), sh = *(const f32x4*)(mod + b * 6 * D + k), sc = *(const f32x4*)(mod + b * 6 * D + D + k);
                const f32x4 h = v[u][j] * rstd * gg * (sc + 1.0f) + sh;
                o8[64 * j] = (unsigned long long)pk2(h.x, h.y) | ((unsigned long long)pk2(h.z, h.w) << 32);
            }
        }
        }
    }
}

__device__ __forceinline__ void unpack8(const v4u w, float (&f)[8]) {
    f[0] = bflo(w.x); f[1] = bfhi(w.x); f[2] = bflo(w.y); f[3] = bfhi(w.y); f[4] = bflo(w.z); f[5] = bfhi(w.z); f[6] = bflo(w.w); f[7] = bfhi(w.w);
}
__device__ __forceinline__ void p3e_conv(const Args& a, LAS float* sm, int lane) {
    constexpr int CT = 4;
    for (int i = threadIdx.x; i < CW * DCONV / 4; i += NTHR) { const int w = i >> 7, c4 = i & 127, ln = c4 >> 1, hf = c4 & 1;
        *(LAS f32x4*)(sm + ((w * 2 + hf) * 64 + ln) * 4) = *(const f32x4*)(a.in[I_CONVW] + w * DCONV + c4 * 4); }
    __syncthreads();
    const bf16* Z = (const bf16*)(a.ws + WS_Z); bf16* MRG = (bf16*)(a.ws + WS_MRG);
    const float* cw = a.in[I_CONVW]; const float* cb = a.in[I_CONVB]; const float* lng = a.in[I_LNG]; const float* lnb = a.in[I_LNB]; const float* ong = a.in[I_ONG];
    const int ch = lane * 8;
    const int xq = blockIdx.x & 7, ilo = (int)(((long)(NTOK / CT) * xq) >> 3), ihi = (int)(((long)(NTOK / CT) * (xq + 1)) >> 3);
    unsigned* ctr = (unsigned*)(a.ws + WS_CTL) + CW_CONVW + 64 * xq;
    for (;;) {
      int it0 = 0; if (lane == 0) it0 = (int)atomicAdd(ctr, 4u); it0 = __builtin_amdgcn_readfirstlane(it0) + ilo;
      if (it0 >= ihi) break;
#pragma unroll 1
      for (int it = it0; it < it0 + 4 && it < ihi; ++it) {
        const int t0 = it * CT, l0 = t0 & (SEQ - 1);
        int chw = ch; asm volatile("" : "+v"(chw));
        const unsigned zo = (unsigned)(((t0 - (CW - 1)) * DCONV + chw) * 2), wo = (unsigned)(chw * 4);
#define ZROW(j) (*(const v4u*)((const char*)Z + (unsigned)(zo + (unsigned)(j) * (DCONV * 2))))
#define WROW(w, q) (*(const LAS f32x4*)(sm + (((w) * 2 + (q)) * 64 + lane) * 4))
        f32x2 acc[CT][4];
        { const f32x4 b0 = *(const f32x4*)(cb + chw), b1 = *(const f32x4*)(cb + chw + 4);
#pragma unroll
          for (int i = 0; i < CT; ++i) { acc[i][0] = (f32x2){b0.x, b0.y}; acc[i][1] = (f32x2){b0.z, b0.w}; acc[i][2] = (f32x2){b1.x, b1.y}; acc[i][3] = (f32x2){b1.z, b1.w}; } }
        f32x2 act[CT][4]; v4u ring[8];
#pragma unroll
        for (int j = 0; j < CT + 8; ++j) { v4u r = (v4u){0u, 0u, 0u, 0u}; if (l0 - (CW - 1) + j >= 0) r = ZROW(j);
            if (j < CT) { act[j][0] = (f32x2){bflo(r.x), bfhi(r.x)}; act[j][1] = (f32x2){bflo(r.y), bfhi(r.y)}; act[j][2] = (f32x2){bflo(r.z), bfhi(r.z)}; act[j][3] = (f32x2){bflo(r.w), bfhi(r.w)}; } else ring[(j - CT) & 7] = r; }
#pragma nounroll
        for (int wq = 0; wq < 4; ++wq) {
#pragma unroll
            for (int r = 0; r < 8; ++r) {
                const int w = wq * 8 + r;
                if (w < CW) {
                    const f32x4 w0 = WROW(w, 0), w1 = WROW(w, 1);
                    const f32x2 wv[4] = {(f32x2){w0.x, w0.y}, (f32x2){w0.z, w0.w}, (f32x2){w1.x, w1.y}, (f32x2){w1.z, w1.w}};
#pragma unroll
                    for (int i = 0; i < CT; ++i) {
#pragma unroll
                        for (int c = 0; c < 4; ++c) acc[i][c] += act[(r + i) % CT][c] * wv[c];
                    }
                    if (w < CW - 1) {
                        const v4u rr = ring[r];
                        act[r % CT][0] = (f32x2){bflo(rr.x), bfhi(rr.x)}; act[r % CT][1] = (f32x2){bflo(rr.y), bfhi(rr.y)}; act[r % CT][2] = (f32x2){bflo(rr.z), bfhi(rr.z)}; act[r % CT][3] = (f32x2){bflo(rr.w), bfhi(rr.w)};
                        if (w + 8 < CW - 1) { const int j = w + CT + 8; ring[r] = (v4u){0u, 0u, 0u, 0u}; if (l0 - (CW - 1) + j >= 0) ring[r] = ZROW(j); }
                    }
                }
            }
        }
#undef ZROW
#undef WROW
        const f32x4 g0 = *(const f32x4*)(lng + chw), g1 = *(const f32x4*)(lng + chw + 4), be0 = *(const f32x4*)(lnb + chw), be1 = *(const f32x4*)(lnb + chw + 4);
        const f32x4 o0 = *(const f32x4*)(ong + DSSM + chw), o1 = *(const f32x4*)(ong + DSSM + chw + 4);
        const float gv[8] = {g0.x, g0.y, g0.z, g0.w, g1.x, g1.y, g1.z, g1.w}, bv[8] = {be0.x, be0.y, be0.z, be0.w, be1.x, be1.y, be1.z, be1.w};
        const float ov[8] = {o0.x, o0.y, o0.z, o0.w, o1.x, o1.y, o1.z, o1.w};
        float mean[CT], rstd[CT];
        { float s[CT];
#pragma unroll
          for (int i = 0; i < CT; ++i) { const f32x2 t = (acc[i][0] + acc[i][1]) + (acc[i][2] + acc[i][3]); s[i] = t.x + t.y; }
#pragma unroll
          for (int i = 0; i < CT; ++i) s[i] = wave_sum(s[i]);
#pragma unroll
          for (int i = 0; i < CT; ++i) mean[i] = s[i] * (1.f / DCONV);
          float q[CT];
#pragma unroll
          for (int i = 0; i < CT; ++i) { f32x2 t = {0.f, 0.f};
#pragma unroll
              for (int c = 0; c < 4; ++c) { const f32x2 d = acc[i][c] - mean[i]; t += d * d; }
              q[i] = t.x + t.y; }
#pragma unroll
          for (int i = 0; i < CT; ++i) q[i] = wave_sum(q[i]);
#pragma unroll
          for (int i = 0; i < CT; ++i) rstd[i] = rsqrtf(q[i] * (1.f / DCONV) + 1e-5f); }
        float ss[CT];
#pragma unroll
        for (int i = 0; i < CT; ++i) { f32x2 t = {0.f, 0.f};
#pragma unroll
            for (int c = 0; c < 4; ++c) { f32x2 v = (acc[i][c] - mean[i]) * rstd[i] * (f32x2){gv[2 * c], gv[2 * c + 1]} + (f32x2){bv[2 * c], bv[2 * c + 1]}; v.x = siluf_(v.x); v.y = siluf_(v.y); acc[i][c] = v; t += v * v; }
            ss[i] = t.x + t.y; }
#pragma unroll
        for (int i = 0; i < CT; ++i) ss[i] = wave_sum(ss[i]);
#pragma unroll
        for (int i = 0; i < CT; ++i) {
            const float r2 = rsqrtf(ss[i] * (1.f / DCONV) + 1e-6f);
            v4u o; o.x = pk2(acc[i][0].x * r2 * ov[0], acc[i][0].y * r2 * ov[1]); o.y = pk2(acc[i][1].x * r2 * ov[2], acc[i][1].y * r2 * ov[3]);
            o.z = pk2(acc[i][2].x * r2 * ov[4], acc[i][2].y * r2 * ov[5]); o.w = pk2(acc[i][3].x * r2 * ov[6], acc[i][3].y * r2 * ov[7]);
            *(v4u*)(MRG + (size_t)(t0 + i) * D + DSSM + chw) = o;
        }
      }
    }
}
__device__ __forceinline__ void p3e_norm(const Args& a, int gw, int ngw, int lane) {
    bf16* MRG = (bf16*)(a.ws + WS_MRG); const float* ong = a.in[I_ONG]; const int ch = lane * 8;
    const f32x4 o0 = *(const f32x4*)(ong + ch), o1 = *(const f32x4*)(ong + ch + 4);
    const float ov[8] = {o0.x, o0.y, o0.z, o0.w, o1.x, o1.y, o1.z, o1.w};
    v4u r[8];
#pragma unroll
    for (int u = 0; u < 8; ++u) { const int m = (gw + u * ngw < NTOK) ? gw + u * ngw : gw; r[u] = *(const v4u*)(MRG + (size_t)m * D + ch); }
    for (int m0 = gw; m0 < NTOK; m0 += 8 * ngw) {
        v4u c[8];
#pragma unroll
        for (int u = 0; u < 8; ++u) c[u] = r[u];
#pragma unroll
        for (int u = 0; u < 8; ++u) { const int mn = m0 + (8 + u) * ngw, m = (mn < NTOK) ? mn : gw; r[u] = *(const v4u*)(MRG + (size_t)m * D + ch); }
        asm volatile("" ::: "memory");
#pragma unroll
        for (int u = 0; u < 8; ++u) {
            const int m = m0 + u * ngw;
            if (m < NTOK) {
                float f[8]; unpack8(c[u], f);
                float ss = 0.f;
#pragma unroll
                for (int q = 0; q < 8; ++q) ss += f[q] * f[q];
                const float r2 = rsqrtf(wave_sum(ss) * (1.f / DSSM) + 1e-6f);
                v4u o; o.x = pk2(f[0] * r2 * ov[0], f[1] * r2 * ov[1]); o.y = pk2(f[2] * r2 * ov[2], f[3] * r2 * ov[3]);
                o.z = pk2(f[4] * r2 * ov[4], f[5] * r2 * ov[5]); o.w = pk2(f[6] * r2 * ov[6], f[7] * r2 * ov[7]);
                *(v4u*)(MRG + (size_t)m * D + ch) = o;
            }
        }
        asm volatile("" ::: "memory");
    }
}

__device__ __forceinline__ void moe_tables(const Args& a, LAS int* T) {
    const unsigned* cnt = (const unsigned*)(a.ws + WS_CTL) + CW_CNT;
    if (threadIdx.x < 32) T[threadIdx.x] = (int)__hip_atomic_load(cnt + 32 * threadIdx.x, __ATOMIC_RELAXED, __HIP_MEMORY_SCOPE_AGENT);
    __syncthreads();
    if (threadIdx.x == 0) { int rb = 0, t64 = 0, t256 = 0;
        for (int e = 0; e < NE; ++e) { T[32 + e] = rb; T[65 + e] = t64; T[98 + e] = t256; const int c = T[e]; rb += c; t64 += (c + 63) >> 6; t256 += (c + 255) >> 8; }
        T[32 + NE] = rb; T[65 + NE] = t64; T[98 + NE] = t256; }
    __syncthreads();
    for (int t = threadIdx.x; t < 640; t += NTHR) { int e = 0;
#pragma unroll 4
        for (int q = 1; q < NE; ++q) if (T[98 + q] <= t) e = q;
        T[1280 + t] = e; }
    __syncthreads();
}

__device__ __forceinline__ bf16* ys_ptr(const Args& a, int tok, int k) {
    if (k == 0) return (bf16*)(a.out + (size_t)tok * D);
    if (k == 3) return (bf16*)(a.ws + WS_YS3) + (size_t)tok * D;
    return (bf16*)(a.ws + WS_YS12) + ((size_t)(k - 1) * NTOK + tok) * D;
}

#if YS_F8
typedef v2u ys8_t;
__device__ __forceinline__ void unpack_ys(const ys8_t w, float (&f)[8]) {
    const f32x2 a = __builtin_amdgcn_cvt_pk_f32_fp8(w.x, false), b = __builtin_amdgcn_cvt_pk_f32_fp8(w.x, true), c = __builtin_amdgcn_cvt_pk_f32_fp8(w.y, false), d = __builtin_amdgcn_cvt_pk_f32_fp8(w.y, true);
    f[0] = a.x; f[1] = a.y; f[2] = b.x; f[3] = b.y; f[4] = c.x; f[5] = c.y; f[6] = d.x; f[7] = d.y; }
__device__ __forceinline__ ys8_t load_ys(const Args& a, int tok, int k, int ch) {
    const unsigned char* p = (k == 0) ? (const unsigned char*)(a.out + (size_t)tok * D) : (k == 3) ? (a.ws + WS_YS3) + (size_t)tok * D : (a.ws + WS_YS12) + ((size_t)(k - 1) * NTOK + tok) * D;
    return __builtin_nontemporal_load((const ys8_t*)(p + ch)); }
#else
typedef v4u ys8_t;
__device__ __forceinline__ void unpack_ys(const ys8_t w, float (&f)[8]) { unpack8(w, f); }
__device__ __forceinline__ ys8_t load_ys(const Args& a, int tok, int k, int ch) { return *(const ys8_t*)(ys_ptr(a, tok, k) + ch); }
#endif
struct P9Ld { v4u x[2]; ys8_t y[4][2]; f32x4 w; };
__device__ __forceinline__ P9Ld p9_load(const Args& a, int tok, int lane) {
    P9Ld r; r.w = *(const f32x4*)((const float*)(a.ws + WS_TOPW) + tok * 4);
#pragma unroll
    for (int q = 0; q < 2; ++q) {
        const int ch = lane * 8 + 512 * q;
        r.x[q] = __builtin_nontemporal_load((const v4u*)((const bf16*)(a.out + (size_t)tok * D) + D + ch));
#pragma unroll
        for (int k = 0; k < 4; ++k) r.y[k][q] = load_ys(a, tok, k, ch);
    }
    return r;
}
__device__ __forceinline__ void p9_token(const Args& a, const P9Ld& r, int tok, int lane) {
    const float* mod = (const float*)(a.ws + WS_MOD); const float* fg = a.in[I_FG];
    const int b = tok >> 13;
    float xo[2][8], ss = 0.f;
#pragma unroll
    for (int q = 0; q < 2; ++q) {
        const int ch = lane * 8 + 512 * q;
        float x1[8], y0[8], y1[8], y2[8], y3[8];
        unpack8(r.x[q], x1); unpack_ys(r.y[0][q], y0); unpack_ys(r.y[1][q], y1); unpack_ys(r.y[2][q], y2); unpack_ys(r.y[3][q], y3);
        const f32x4 g0 = *(const f32x4*)(mod + b * 6 * D + 5 * D + ch), g1 = *(const f32x4*)(mod + b * 6 * D + 5 * D + ch + 4);
        const float g2[8] = {g0.x, g0.y, g0.z, g0.w, g1.x, g1.y, g1.z, g1.w};
#pragma unroll
        for (int c = 0; c < 8; ++c) { xo[q][c] = x1[c] + g2[c] * (((r.w.x * y0[c] + r.w.y * y1[c]) + r.w.z * y2[c]) + r.w.w * y3[c]); ss += xo[q][c] * xo[q][c]; }
    }
    const float rstd = rsqrtf(wave_sum(ss) * (1.f / D) + 1e-6f);
#pragma unroll
    for (int q = 0; q < 2; ++q) {
        const int ch = lane * 8 + 512 * q;
        const f32x4 f0 = *(const f32x4*)(fg + ch), f1 = *(const f32x4*)(fg + ch + 4);
        f32x4 o0, o1;
        o0.x = xo[q][0] * rstd * f0.x; o0.y = xo[q][1] * rstd * f0.y; o0.z = xo[q][2] * rstd * f0.z; o0.w = xo[q][3] * rstd * f0.w;
        o1.x = xo[q][4] * rstd * f1.x; o1.y = xo[q][5] * rstd * f1.y; o1.z = xo[q][6] * rstd * f1.z; o1.w = xo[q][7] * rstd * f1.w;
        f32x4* op = (f32x4*)(a.out + (size_t)tok * D + ch);
        __builtin_nontemporal_store(o0, op); __builtin_nontemporal_store(o1, op + 1);
    }
}
__device__ __forceinline__ void p9_final(const Args& a, int gw, int ngw, int lane) {
    P9Ld r0 = p9_load(a, gw < NTOK ? gw : 0, lane), r1 = p9_load(a, gw + ngw < NTOK ? gw + ngw : 0, lane);
    for (int tok = gw; tok < NTOK; tok += 2 * ngw) {
        { const P9Ld cu = r0; const int tn = tok + 2 * ngw; r0 = p9_load(a, tn < NTOK ? tn : tok, lane);
          asm volatile("" ::: "memory"); p9_token(a, cu, tok, lane); asm volatile("" ::: "memory"); }
        if (tok + ngw < NTOK) { const P9Ld cu = r1; const int tn = tok + 3 * ngw; r1 = p9_load(a, tn < NTOK ? tn : tok + ngw, lane);
          asm volatile("" ::: "memory"); p9_token(a, cu, tok + ngw, lane); asm volatile("" ::: "memory"); }
    }
}

namespace pg8 {
constexpr int BM = 256, BK = 64, HALF = 128, HTB = HALF * BK * 2  , STAGE_BYTES = 8 * HTB, NXCD = 8, WGM = 8;
__host__ __device__ __forceinline__ int lds_byte(int r, int c) { const int st = (r >> 4) * 2 + (c >> 5), rr = r & 15, cc = c & 31, ob = rr * 64 + cc * 2; return st * 1024 + (ob ^ (((ob >> 9) & 1) << 5)); }
__host__ __device__ __forceinline__ void stage_rc(int b, int& R, int& C) { const int st = b / 1024, sb = b % 1024, swz = sb ^ (((sb >> 9) & 1) << 5); R = (st >> 1) * 16 + swz / 64; C = (st & 1) * 32 + (swz % 64) / 2; }
__host__ __device__ __forceinline__ int perm32(int rho) { const int n = rho >> 4, i = rho & 15; return 8 * (i >> 2) + 4 * n + (i & 3); }
struct Unit { int pm, pn, e, row0, slot0, nvalid; };
typedef int v8i __attribute__((ext_vector_type(8)));
__device__ __forceinline__ v8i cat8(const bf16x8 lo, const bf16x8 hi) { typedef int v4i __attribute__((ext_vector_type(4))); const v4i a = __builtin_bit_cast(v4i, lo), b = __builtin_bit_cast(v4i, hi); return (v8i){a[0], a[1], a[2], a[3], b[0], b[1], b[2], b[3]}; }
__device__ __forceinline__ bf16x8 lo8(const v8i v) { typedef int v4i __attribute__((ext_vector_type(4))); return __builtin_bit_cast(bf16x8, __builtin_shufflevector(v, v, 0, 1, 2, 3)); }
__device__ __forceinline__ bf16x8 hi8(const v8i v) { typedef int v4i __attribute__((ext_vector_type(4))); return __builtin_bit_cast(bf16x8, __builtin_shufflevector(v, v, 4, 5, 6, 7)); }
__device__ __forceinline__ unsigned cvt_pk_bf16(float lo, float hi) { unsigned r; asm volatile("v_cvt_pk_bf16_f32 %0, %1, %2" : "=v"(r) : "v"(lo), "v"(hi)); return r; }

template <class Epi, class Sched, bool ALIGN_EPI, bool F8 = false>
__device__ __forceinline__ void gemm_phase(LAS unsigned char* lds, const Sched& S, const Epi& E) {
    const int tid = threadIdx.x, wid = __builtin_amdgcn_readfirstlane(tid >> 6), lane = tid & 63, wr = wid >> 2, wc = wid & 3, fr = lane & 15, fq = lane >> 4;
    constexpr int EB = F8 ? 1 : 2;
    const int nt = S.K / (128 / EB);
    int R[2], C[2]; unsigned voffB[2];
#pragma unroll
    for (int i = 0; i < 2; ++i) { stage_rc(tid * 16 + i * 8192, R[i], C[i]); const int Rb = Epi::PERM ? ((R[i] & ~31) + perm32(R[i] & 31)) : R[i]; voffB[i] = (unsigned)(Rb * S.ldb * EB + C[i] * 2); }
    const size_t kstep = (size_t)(BK * 2);
    const size_t bhstep = (size_t)HALF * S.ldb * EB;
    const unsigned ldsw = (unsigned)wid * 1024u;
    const int aoff = lds_byte(wr * 64 + fr, fq * 8), boff = lds_byte(wc * 32 + fr, fq * 8);
#define PG8_SA(b, h) (((b) * 2 + (h)) * HTB)
#define PG8_SB(b, h) ((4 + (b) * 2 + (h)) * HTB)
#define PG8_STAGE(bufoff, gbase, voff) do { _Pragma("unroll") for (int _i = 0; _i < 2; ++_i) \
        __builtin_amdgcn_global_load_lds((const unsigned*)((const char*)(gbase) + (voff)[_i]), (LAS unsigned*)(lds + (bufoff) + ldsw + _i * 8192), 16, 0, 0); } while (0)
#define PG8_LDA(dst, b, h) do { _Pragma("unroll") for (int m = 0; m < 4; ++m) dst[m] = cat8(*(const LAS bf16x8*)(lds + PG8_SA(b, h) + aoff + m * 2048), *(const LAS bf16x8*)(lds + PG8_SA(b, h) + aoff + m * 2048 + 1024)); } while (0)
#define PG8_LDB(dst, b, h) do { _Pragma("unroll") for (int n = 0; n < 2; ++n) dst[n] = cat8(*(const LAS bf16x8*)(lds + PG8_SB(b, h) + boff + n * 2048), *(const LAS bf16x8*)(lds + PG8_SB(b, h) + boff + n * 2048 + 1024)); } while (0)
#define PG8_MMA(ai, bj, At, Bt) do { __builtin_amdgcn_s_setprio(1); _Pragma("unroll") for (int m = 0; m < 4; ++m) _Pragma("unroll") for (int n = 0; n < 2; ++n) { \
        if constexpr (F8) { asm volatile("v_mfma_scale_f32_16x16x128_f8f6f4 %0, %1, %2, %0, %3, %4 op_sel_hi:[0,0,0]" : "+v"(acc[ai][bj][m][n]) : "v"(Bt[n]), "v"(At[m]), "v"(f8sb), "v"(f8sa)); } \
        else { acc[ai][bj][m][n] = __builtin_amdgcn_mfma_f32_16x16x32_bf16(lo8(Bt[n]), lo8(At[m]), acc[ai][bj][m][n], 0, 0, 0); acc[ai][bj][m][n] = __builtin_amdgcn_mfma_f32_16x16x32_bf16(hi8(Bt[n]), hi8(At[m]), acc[ai][bj][m][n], 0, 0, 0); } } \
        __builtin_amdgcn_s_setprio(0); } while (0)
#define PG8_WAIT_V(n) asm volatile("s_waitcnt vmcnt(" #n ")" ::: "memory")
#define PG8_WAIT_L(n) asm volatile("s_waitcnt lgkmcnt(" #n ")" ::: "memory")
#define PG8_BAR __builtin_amdgcn_s_barrier()
#define PG8_SCHED __builtin_amdgcn_sched_barrier(0)
    Unit cur, nxt; int ui = 0; cur.e = 0;
    if (!S.next(0, cur)) return;
    nxt = cur;
    f32x4 acc[2][2][4][2];
#pragma unroll
    for (int a = 0; a < 2; ++a)
#pragma unroll
        for (int b = 0; b < 2; ++b)
#pragma unroll
            for (int m = 0; m < 4; ++m)
#pragma unroll
                for (int n = 0; n < 2; ++n) acc[a][b][m][n] = (f32x4){0.f, 0.f, 0.f, 0.f};
    const int f8sa = S.scale_a, f8sb = S.scale_b;
    v8i At[4], B0[2], B1[2];
    unsigned ao[2][2], an[2][2];
    S.a_offsets(cur, R, C, ao);
    const char* cA = S.a_base(cur); const char* cB = S.b_base(cur);
    PG8_STAGE(PG8_SB(0, 0), cB, voffB); PG8_STAGE(PG8_SB(0, 1), cB + bhstep, voffB); PG8_STAGE(PG8_SA(0, 0), cA, ao[0]); PG8_STAGE(PG8_SA(0, 1), cA, ao[1]);
    if (wr == 1) PG8_BAR;
    PG8_WAIT_V(2); PG8_BAR;
    PG8_STAGE(PG8_SB(1, 0), cB + kstep, voffB); PG8_STAGE(PG8_SA(1, 0), cA + kstep, ao[0]); PG8_STAGE(PG8_SB(1, 1), cB + bhstep + kstep, voffB);
    PG8_WAIT_V(6); PG8_BAR;
#if TIME_PHASE >= 0
    unsigned long long tk0 = 0, tk1 = 0, tacc_k = 0, tacc_e = 0;
#endif
    for (;;) {
#if TIME_PHASE >= 0
        if (S.tstamp) tk0 = __builtin_amdgcn_s_memrealtime();
#endif
        const bool has_next = S.next(ui + 1, nxt);
        const char* nA = cA; const char* nB = cB;
#pragma unroll
        for (int h = 0; h < 2; ++h)
#pragma unroll
            for (int i = 0; i < 2; ++i) an[h][i] = ao[h][i];
        if (has_next) { nA = S.a_base(nxt); nB = S.b_base(nxt); S.a_offsets(nxt, R, C, an); }
        for (int t = 0; t < nt; t += 2) {
            const bool last = (t == nt - 2);
            const char* a1 = cA + (size_t)(t + 1) * kstep;
            const char* a2 = last ? nA : cA + (size_t)(t + 2) * kstep; const char* b2 = last ? nB : cB + (size_t)(t + 2) * kstep;
            const char* a3 = a2 + kstep; const char* b3 = b2 + kstep;
            unsigned o2[2][2];
#pragma unroll
            for (int h = 0; h < 2; ++h)
#pragma unroll
                for (int i = 0; i < 2; ++i) o2[h][i] = last ? an[h][i] : ao[h][i];
            PG8_LDB(B0, 0, 0); PG8_LDB(B1, 0, 1); PG8_SCHED; PG8_LDA(At, 0, 0); PG8_STAGE(PG8_SA(1, 1), a1, ao[1]);
            PG8_WAIT_V(8); PG8_WAIT_L(0); PG8_BAR; PG8_MMA(0, 0, At, B0); PG8_MMA(0, 1, At, B1); PG8_BAR; PG8_SCHED;
            PG8_LDA(At, 0, 1); PG8_STAGE(PG8_SB(0, 0), b2, voffB); PG8_STAGE(PG8_SB(0, 1), b2 + bhstep, voffB); PG8_STAGE(PG8_SA(0, 0), a2, o2[0]);
            PG8_WAIT_V(8); PG8_WAIT_L(0); PG8_BAR; PG8_MMA(1, 0, At, B0); PG8_MMA(1, 1, At, B1); PG8_BAR; PG8_SCHED;
            PG8_LDB(B0, 1, 0); PG8_LDB(B1, 1, 1); PG8_SCHED; PG8_LDA(At, 1, 0); PG8_STAGE(PG8_SA(0, 1), a2, o2[1]);
            PG8_WAIT_V(8); PG8_WAIT_L(0); PG8_BAR; PG8_MMA(0, 0, At, B0); PG8_MMA(0, 1, At, B1); PG8_BAR; PG8_SCHED;
            PG8_LDA(At, 1, 1); PG8_STAGE(PG8_SB(1, 0), b3, voffB); PG8_STAGE(PG8_SB(1, 1), b3 + bhstep, voffB); PG8_STAGE(PG8_SA(1, 0), a3, o2[0]);
            PG8_WAIT_V(8); PG8_WAIT_L(0); PG8_BAR; PG8_MMA(1, 0, At, B0); PG8_MMA(1, 1, At, B1); PG8_BAR; PG8_SCHED;
        }
#if TIME_PHASE >= 0
        if (S.tstamp) { tk1 = __builtin_amdgcn_s_memrealtime(); tacc_k += tk1 - tk0; }
#endif
        if constexpr (ALIGN_EPI) { if (wr == 0) PG8_BAR; }
        if constexpr (F8) { asm volatile("s_nop 15\n\ts_nop 15" ::: "memory"); }
        E(acc, cur, wr, wc, fr, fq);
        if (S.rep_epi) { asm volatile("" ::: "memory"); E(acc, cur, wr, wc, fr, fq); }
#if TIME_PHASE >= 0
        if (S.tstamp) { tacc_e += __builtin_amdgcn_s_memrealtime() - tk1; }
#endif
        if (!has_next) break;
#pragma unroll
        for (int a = 0; a < 2; ++a)
#pragma unroll
            for (int b = 0; b < 2; ++b)
#pragma unroll
                for (int m = 0; m < 4; ++m)
#pragma unroll
                    for (int n = 0; n < 2; ++n) acc[a][b][m][n] = (f32x4){0.f, 0.f, 0.f, 0.f};
        cur = nxt; cA = nA; cB = nB; ++ui;
#pragma unroll
        for (int h = 0; h < 2; ++h)
#pragma unroll
            for (int i = 0; i < 2; ++i) ao[h][i] = an[h][i];
        if constexpr (ALIGN_EPI) { if (wr == 1) PG8_BAR; }
    }
    PG8_WAIT_V(0);
    if constexpr (!ALIGN_EPI) { if (wr == 0) PG8_BAR; }
    PG8_BAR;
#if TIME_PHASE >= 0
    if (S.tstamp && threadIdx.x == 0) { LAS unsigned long long* TSg = (LAS unsigned long long*)(lds + 131072 + 4096); TSg[24] = 0; TSg[25] = tacc_k; TSg[26] = tacc_k + tacc_e; }
#endif
#undef PG8_SA
#undef PG8_SB
#undef PG8_STAGE
#undef PG8_LDA
#undef PG8_LDB
#undef PG8_MMA
#undef PG8_WAIT_V
#undef PG8_WAIT_L
#undef PG8_BAR
#undef PG8_SCHED
}

struct SchedDense {
    static constexpr int scale_a = 127, scale_b = 127, rep_epi = 0;
    const bf16* A; const bf16* Bt; int K, lda, ldb; int nM, nN, nwg, G, c, rep, tstamp = 0;
    __device__ __forceinline__ void init(const bf16* A_, const bf16* Bt_, int M, int N, int K_, int lda_, int ldb_, int G_, int c_, int rep_ = 1) { A = A_; Bt = Bt_; K = K_; lda = lda_; ldb = ldb_; nM = M / BM; nN = N / BM; nwg = nM * nN; G = G_; c = c_; rep = rep_; }
    __device__ __forceinline__ bool next(int i, Unit& u) const {
        const long L = (long)(i / rep) * G + c; if (L >= nwg) return false;
        int wgid = (int)L; { const int q = nwg / NXCD, r = nwg % NXCD, xcd = wgid % NXCD, off = wgid / NXCD; wgid = (xcd < r ? xcd * (q + 1) : r * (q + 1) + (xcd - r) * q) + off; }
        const int nig = WGM * nN, gid = wgid / nig, fm = gid * WGM, gsz = (nM - fm) < WGM ? (nM - fm) : WGM;
        u.pm = fm + ((wgid % nig) % gsz); u.pn = (wgid % nig) / gsz; u.e = 0; u.row0 = u.pm * BM; u.slot0 = 0; u.nvalid = BM; return true;
    }
    __device__ __forceinline__ const char* a_base(const Unit& u) const { return (const char*)A + (size_t)u.pm * BM * lda * 2; }
    __device__ __forceinline__ const char* b_base(const Unit& u) const { return (const char*)Bt + (size_t)u.pn * BM * ldb * 2; }
    __device__ __forceinline__ void a_offsets(const Unit&, const int (&R)[2], const int (&C)[2], unsigned (&off)[2][2]) const {
#pragma unroll
        for (int h = 0; h < 2; ++h)
#pragma unroll
            for (int i = 0; i < 2; ++i) off[h][i] = (unsigned)((R[i] + HALF * h) * lda + C[i]) * 2u;
    }
};
struct SchedGroup {
    static constexpr int scale_a = 127, scale_b = 127, rep_epi = 0, tstamp = 0;
    const bf16* A; const bf16* Bt; int K, lda, ldb; int nM, nN, ng, G, c; size_t astride, bstride; int rep, nmax;
    __device__ __forceinline__ bool next(int i, Unit& u) const {
        const int L = (i / rep) * G + c; if (L >= ng * nM * nN || i >= nmax) return false;
        const int g = L / (nM * nN), rem = L % (nM * nN);
        u.e = g; u.pm = rem % nM; u.pn = rem / nM; u.row0 = u.pm * BM; u.slot0 = 0; u.nvalid = BM; return true;
    }
    __device__ __forceinline__ const char* a_base(const Unit& u) const { return (const char*)(A + (size_t)u.e * astride) + (size_t)u.pm * BM * lda * 2; }
    __device__ __forceinline__ const char* b_base(const Unit& u) const { return (const char*)(Bt + (size_t)u.e * bstride) + (size_t)u.pn * BM * ldb * 2; }
    __device__ __forceinline__ void a_offsets(const Unit&, const int (&R)[2], const int (&C)[2], unsigned (&off)[2][2]) const {
#pragma unroll
        for (int h = 0; h < 2; ++h)
#pragma unroll
            for (int i = 0; i < 2; ++i) off[h][i] = (unsigned)((R[i] + HALF * h) * lda + C[i]) * 2u;
    }
};
}

__device__ __forceinline__ unsigned pk_fp8x4(float a, float b, float c, float d) { unsigned r = __builtin_amdgcn_cvt_pk_fp8_f32(a, b, 0u, false); return __builtin_amdgcn_cvt_pk_fp8_f32(c, d, r, true); }
struct TItem { const float* W; unsigned char* WT; int K, N, k0, n0, drow0, f8, perm; };
__device__ __forceinline__ int wd_perm_row(int c) { return (c & ~255) + ((c >> 3) & 1) * 128 + ((c >> 6) & 3) * 32 + ((c >> 4) & 3) * 8 + (c & 7); }
__device__ __forceinline__ void titem_load(const TItem& t, int lane, f32x4 (&v)[8]) {
    const float* p = t.W + (size_t)(t.k0 + 8 * (lane >> 3)) * t.N + t.n0 + 4 * (lane & 7);
#pragma unroll
    for (int i = 0; i < 8; ++i) v[i] = __builtin_nontemporal_load((const f32x4*)(p + (size_t)i * t.N));
}
__device__ __forceinline__ void titem_store(const TItem& t, int lane, const f32x4 (&v)[8], float f8scale) {
    const int n4 = lane & 7, kb = lane >> 3;
#pragma unroll
    for (int j = 0; j < 4; ++j) {
        const int cc = 4 * n4 + j;
        const size_t row = (size_t)(t.perm == 1 ? wd_perm_row(t.drow0 + cc) : t.perm == 2 ? t.drow0 + 8 * ((((cc >> 3) & 1) << 1) | (cc >> 4)) + (cc & 7) : t.drow0 + cc);
        if (t.f8) { v2u o; o.x = pk_fp8x4(v[0][j] * f8scale, v[1][j] * f8scale, v[2][j] * f8scale, v[3][j] * f8scale); o.y = pk_fp8x4(v[4][j] * f8scale, v[5][j] * f8scale, v[6][j] * f8scale, v[7][j] * f8scale);
            *(v2u*)(t.WT + row * t.K + t.k0 + 8 * kb) = o; }
        else { v4u o; o.x = pk2(v[0][j], v[1][j]); o.y = pk2(v[2][j], v[3][j]); o.z = pk2(v[4][j], v[5][j]); o.w = pk2(v[6][j], v[7][j]);
            *(v4u*)(t.WT + (row * t.K + t.k0 + 8 * kb) * 2) = o; }
    }
}
constexpr float WGU_F8_SCALE = 32.0f;
__device__ __forceinline__ TItem p0_item(const Args& a, int it) {
    constexpr int I_IN = 16 * 48, I_GLU = 8 * 16, I_OUT = 16 * 32, I_EXP = 16 * 32;
    TItem t; t.f8 = 0; t.perm = 0; int r = it;
    if (r < I_IN) { const int kb = r / 48, nb = r % 48, n0 = nb * 32; int drow;
        if (n0 < 512) drow = n0; else if (n0 < 1024) { const int j = n0 - 512; drow = 512 + (j >> 7) * 256 + (j & 127); } else { const int j = n0 - 1024; drow = 512 + (j >> 7) * 256 + 128 + (j & 127); }
        t.W = a.in[I_WIN]; t.WT = a.ws + WS_WIN; t.K = D; t.N = DIN; t.k0 = kb * 64; t.n0 = n0; t.drow0 = drow; return t; } r -= I_IN;
    if (r < I_GLU) { const int kb = r / 16, nb = r % 16; t.W = a.in[I_WGLU]; t.WT = a.ws + WS_WGLU; t.K = DSSM; t.N = DSSM; t.k0 = kb * 64; t.n0 = nb * 32; t.drow0 = nb * 32; return t; } r -= I_GLU;
    if (r < I_OUT) { const int kb = r / 32, nb = r % 32; t.W = a.in[I_WOUT]; t.WT = a.ws + WS_WOUT; t.K = D; t.N = D; t.k0 = kb * 64; t.n0 = nb * 32; t.drow0 = nb * 32; return t; } r -= I_OUT;
    const int e = r / (3 * I_EXP), q = r % (3 * I_EXP), which = q / I_EXP, sidx = q % I_EXP, kb = sidx / 32, nb = sidx % 32, n0 = nb * 32;
    t.K = D; t.N = FF; t.k0 = kb * 64; t.n0 = n0;
    if (which == 0) { t.W = a.in[I_WG] + (size_t)e * D * FF; t.WT = a.ws + WS_WGU + (size_t)e * 2048 * D * (MOE1_F8 ? 1 : 2); t.drow0 = (n0 >> 7) * 256 + (n0 & 127); t.f8 = MOE1_F8; t.perm = MOE1_WIDE ? 2 : 0; }
    else if (which == 1) { t.W = a.in[I_WU] + (size_t)e * D * FF; t.WT = a.ws + WS_WGU + (size_t)e * 2048 * D * (MOE1_F8 ? 1 : 2); t.drow0 = (n0 >> 7) * 256 + 128 + (n0 & 127); t.f8 = MOE1_F8; t.perm = MOE1_WIDE ? 2 : 0; }
    else { t.W = a.in[I_WD] + (size_t)e * FF * D; t.WT = a.ws + WS_WD + (size_t)e * D * FF * (MOE2_F8 ? 1 : 2); t.drow0 = n0; t.f8 = MOE2_F8; t.perm = MOE2_WIDE; }
    return t;
}
__device__ __forceinline__ void p0_convert(const Args& a, int gw, int ngw, int lane) {
    constexpr int NITEMS = 16 * 48 + 8 * 16 + 16 * 32 + 3 * NE * 16 * 32;
    const int x = blockIdx.x & 7, lo = (int)(((long)NITEMS * x) >> 3), hi = (int)(((long)NITEMS * (x + 1)) >> 3);
    unsigned* ctr = (unsigned*)(a.ws + WS_CTL) + CW_CONV + 64 * x;
    int it = 0, nleft = 0;
    auto grab = [&]() { if (nleft == 0) { int g0 = 0; if (lane == 0) g0 = (int)atomicAdd(ctr, 8u); it = __builtin_amdgcn_readfirstlane(g0) + lo; nleft = 8; } };
    grab();
    bool have = it < hi; TItem c0{}, c1{}; bool ctwo = false; f32x4 v0[8], v1[8];
    if (have) { c0 = p0_item(a, it); ctwo = it + 1 < hi; c1 = p0_item(a, ctwo ? it + 1 : it); titem_load(c0, lane, v0); titem_load(c1, lane, v1); it += 2; nleft -= 2; }
    while (have) {
        grab();
        const bool hn = it < hi; TItem n0{}, n1{}; bool ntwo = false; f32x4 w0[8], w1[8];
        if (hn) { n0 = p0_item(a, it); ntwo = it + 1 < hi; n1 = p0_item(a, ntwo ? it + 1 : it); titem_load(n0, lane, w0); titem_load(n1, lane, w1); it += 2; nleft -= 2; }
        asm volatile("" ::: "memory");
        titem_store(c0, lane, v0, WGU_F8_SCALE);
        if (ctwo) titem_store(c1, lane, v1, WGU_F8_SCALE);
        asm volatile("" ::: "memory");
        have = hn; c0 = n0; c1 = n1; ctwo = ntwo;
#pragma unroll
        for (int i = 0; i < 8; ++i) { v0[i] = w0[i]; v1[i] = w1[i]; }
    }
}
__device__ __forceinline__ void p0_s5_mats(const Args& a, LAS float* sm) {
    LAS float* Ptau = sm; LAS float* Pt1 = sm + 128; LAS float* Ps = sm + 256; LAS float* LD = sm + 384;
    LAS float* Bb = sm + 512; LAS float* Kt = sm + 512 + 2048; LAS float* Cs = sm + 512 + 2048 + 256;
    bf16* BTS = (bf16*)(a.ws + WS_BTS); bf16* BTY = (bf16*)(a.ws + WS_BTY);
    const int t = threadIdx.x;
    for (int it0 = blockIdx.x * 4; it0 < NG * TCH; it0 += gridDim.x * 4) {
        const int g = it0 >> 5;
        if (t < 64) {
            const int p = t;
            const float lr = a.in[I_LRE][g * NP + p], li = a.in[I_LIM][g * NP + p], dt = expf(a.in[I_LDT][g]);
            const float mag = expf(lr * dt); float sn, cs; sincosf(li * dt, &sn, &cs);
            const float ar = mag * cs, ai = mag * sn, den = lr * lr + li * li, nr = ar - 1.f;
            const float qr = (nr * lr + ai * li) / den, qi = (ai * lr - nr * li) / den;
            LD[2 * p] = lr * dt; LD[2 * p + 1] = li * dt;
#pragma unroll
            for (int h = 0; h < 16; ++h) {
                const float br = a.in[I_BRE][(g * NP + p) * GH + h], bi = a.in[I_BIM][(g * NP + p) * GH + h];
                Bb[(p * 16 + h) * 2] = qr * br - qi * bi; Bb[(p * 16 + h) * 2 + 1] = qr * bi + qi * br;
            }
        }
        for (int i = t; i < GH * NP; i += NTHR) { Cs[2 * i] = a.in[I_CRE][g * GH * NP + i]; Cs[2 * i + 1] = a.in[I_CIM][g * GH * NP + i]; }
        __syncthreads();
        for (int tau = it0 & 31; tau < (it0 & 31) + 4; ++tau) {
        if (t < 192) {
            const int p = t & 63, which = t >> 6; const float e = which == 0 ? (float)tau : which == 1 ? (float)(tau + 1) : (float)(31 - tau);
            const float m = expf(e * LD[2 * p]); float s2, c2; sincosf(e * LD[2 * p + 1], &s2, &c2);
            LAS float* dst = which == 0 ? Ptau : which == 1 ? Pt1 : Ps; dst[2 * p] = m * c2; dst[2 * p + 1] = m * s2;
        }
        __syncthreads();
        if (t < 256) {
            const int h = t >> 4, h2 = t & 15; float s = 0.f;
#pragma unroll 8
            for (int p = 0; p < NP; ++p) {
                const float cr = Cs[(h * NP + p) * 2], ci = Cs[(h * NP + p) * 2 + 1];
                const float pr = Ptau[2 * p], pi = Ptau[2 * p + 1], br = Bb[(p * 16 + h2) * 2], bi = Bb[(p * 16 + h2) * 2 + 1];
                const float xr = pr * br - pi * bi, xi = pr * bi + pi * br;
                s += cr * xr - ci * xi;
            }
            if (tau == 0 && h == h2) s += a.in[I_DSK][g * GH + h];
            Kt[t] = s;
        }
        __syncthreads();
        bf16* by = BTY + (size_t)g * 512 * U2G;
        for (int idx = t; idx < (TCH - tau) * 32; idx += NTHR) {
            const int j = idx >> 5, h = (idx >> 1) & 15, half = idx & 1, tt = tau + j, sidx = j;
            const LAS float* k = Kt + h * 16 + half * 8;
            v4u o; o.x = pk2(k[0], k[1]); o.y = pk2(k[2], k[3]); o.z = pk2(k[4], k[5]); o.w = pk2(k[6], k[7]);
            *(v4u*)(by + (size_t)(tt * 16 + h) * U2G + sidx * 16 + half * 8) = o;
        }
        if (tau >= 1) for (int idx = t; idx < (TCH - tau) * 32; idx += NTHR) {
            const int j = idx >> 5, h = (idx >> 1) & 15, half = idx & 1, tt = j, sidx = tau + j;
            *(v4u*)(by + (size_t)(tt * 16 + h) * U2G + sidx * 16 + half * 8) = (v4u){0u, 0u, 0u, 0u};
        }
        if (t < 256) {
            const int h = t >> 4, piece = t & 15; float v[8];
#pragma unroll
            for (int q = 0; q < 8; ++q) { const int pp = piece * 8 + q, p = pp & 63;
                const float cr = Cs[(h * NP + p) * 2], ci = Cs[(h * NP + p) * 2 + 1], pr = Pt1[2 * p], pi = Pt1[2 * p + 1];
                v[q] = (pp < 64) ? (cr * pr - ci * pi) : -(cr * pi + ci * pr); }
            v4u o; o.x = pk2(v[0], v[1]); o.y = pk2(v[2], v[3]); o.z = pk2(v[4], v[5]); o.w = pk2(v[6], v[7]);
            *(v4u*)(by + (size_t)(tau * 16 + h) * U2G + 512 + piece * 8) = o;
        } else {
            const int u = t - 256, n = u >> 1, half = u & 1, p = n & 63; float v[8];
#pragma unroll
            for (int q = 0; q < 8; ++q) { const int h = half * 8 + q; const float pr = Ps[2 * p], pi = Ps[2 * p + 1], br = Bb[(p * 16 + h) * 2], bi = Bb[(p * 16 + h) * 2 + 1];
                v[q] = (n < 64) ? (pr * br - pi * bi) : (pr * bi + pi * br); }
            v4u o; o.x = pk2(v[0], v[1]); o.y = pk2(v[2], v[3]); o.z = pk2(v[4], v[5]); o.w = pk2(v[6], v[7]);
            bf16* bs = BTS + (size_t)g * 256 * 512;
            *(v4u*)(bs + (size_t)n * 512 + tau * 16 + half * 8) = o;
            *(v4u*)(bs + (size_t)(128 + n) * 512 + tau * 16 + half * 8) = (v4u){0u, 0u, 0u, 0u};
        }
        __syncthreads();
        }
    }
}

using pg8::Unit; using pg8::cvt_pk_bf16;
struct EpiInProj {
    static constexpr bool PERM = true;
    bf16* U2; bf16* Z;
    __device__ __forceinline__ void operator()(const f32x4 (&acc)[2][2][4][2], const Unit& u, int wr, int wc, int fr, int fq) const {
#pragma unroll
        for (int ai = 0; ai < 2; ++ai)
#pragma unroll
            for (int m = 0; m < 4; ++m) {
                const int tok = u.pm * 256 + ai * 128 + wr * 64 + m * 16 + fr;
                if (u.pn < 2) {
                    const int b = tok >> 13, l = tok & 8191;
                    bf16* rowp = U2 + (size_t)(b * NCH + (l >> 5)) * U2LD + (l & 31) * 16;
#pragma unroll
                    for (int bj = 0; bj < 2; ++bj) { const int c0 = u.pn * 256 + bj * 128 + wc * 32 + 8 * fq; const f32x4 v0 = acc[ai][bj][m][0], v1 = acc[ai][bj][m][1];
                        v4u w; w.x = cvt_pk_bf16(v0[0], v0[1]); w.y = cvt_pk_bf16(v0[2], v0[3]); w.z = cvt_pk_bf16(v1[0], v1[1]); w.w = cvt_pk_bf16(v1[2], v1[3]);
                        *(v4u*)(rowp + (c0 >> 4) * U2G + (c0 & 15)) = w; }
                } else {
                    const int j0 = (u.pn - 2) * 128 + wc * 32 + 8 * fq;
                    const f32x4 a0 = acc[ai][0][m][0], a1 = acc[ai][0][m][1], g0 = acc[ai][1][m][0], g1 = acc[ai][1][m][1];
                    constexpr float KS = -1.4426950408889634f;
                    const f32x2 z0 = (f32x2){a0[0], a0[1]} * sig2((f32x2){g0[0], g0[1]}, KS), z1 = (f32x2){a0[2], a0[3]} * sig2((f32x2){g0[2], g0[3]}, KS);
                    const f32x2 z2 = (f32x2){a1[0], a1[1]} * sig2((f32x2){g1[0], g1[1]}, KS), z3 = (f32x2){a1[2], a1[3]} * sig2((f32x2){g1[2], g1[3]}, KS);
                    v4u w; w.x = cvt_pk_bf16(z0.x, z0.y); w.y = cvt_pk_bf16(z1.x, z1.y); w.z = cvt_pk_bf16(z2.x, z2.y); w.w = cvt_pk_bf16(z3.x, z3.y);
                    *(v4u*)(Z + (size_t)tok * DCONV + j0) = w;
                }
            }
    }
};
struct EpiGlu {
    static constexpr bool PERM = true;
    const bf16* YG; bf16* MRG; const float* bias;
    __device__ __forceinline__ void operator()(const f32x4 (&acc)[2][2][4][2], const Unit& u, int wr, int wc, int fr, int fq) const {
#pragma unroll
        for (int bj = 0; bj < 2; ++bj) {
            const int c0 = u.pn * 256 + bj * 128 + wc * 32 + 8 * fq;
            const f32x4 b0 = *(const f32x4*)(bias + c0), b1 = *(const f32x4*)(bias + c0 + 4);
#pragma unroll
            for (int ai = 0; ai < 2; ++ai)
#pragma unroll
                for (int m = 0; m < 4; ++m) {
                    const int tok = u.pm * 256 + ai * 128 + wr * 64 + m * 16 + fr;
                    float y[8]; unpack8(*(const v4u*)(YG + (size_t)tok * DSSM + c0), y);
                    const f32x4 v0 = acc[ai][bj][m][0] + b0, v1 = acc[ai][bj][m][1] + b1;
                    constexpr float KS = -1.4426950408889634f;
                    const f32x2 z0 = (f32x2){y[0], y[1]} * sig2((f32x2){v0[0], v0[1]}, KS), z1 = (f32x2){y[2], y[3]} * sig2((f32x2){v0[2], v0[3]}, KS);
                    const f32x2 z2 = (f32x2){y[4], y[5]} * sig2((f32x2){v1[0], v1[1]}, KS), z3 = (f32x2){y[6], y[7]} * sig2((f32x2){v1[2], v1[3]}, KS);
                    v4u w; w.x = cvt_pk_bf16(z0.x, z0.y); w.y = cvt_pk_bf16(z1.x, z1.y); w.z = cvt_pk_bf16(z2.x, z2.y); w.w = cvt_pk_bf16(z3.x, z3.y);
                    *(v4u*)(MRG + (size_t)tok * D + c0) = w;
                }
        }
    }
};
struct EpiOut {
    static constexpr bool PERM = true;
    const float* x; float* out; const float* mod; float* ssq;
    __device__ __forceinline__ void operator()(const f32x4 (&acc)[2][2][4][2], const Unit& u, int wr, int wc, int fr, int fq) const {
        const int b = (u.pm * 256) >> 13;
        f32x4 g1[2][2];
#pragma unroll
        for (int bj = 0; bj < 2; ++bj)
#pragma unroll
            for (int n = 0; n < 2; ++n) g1[bj][n] = *(const f32x4*)(mod + b * 6 * D + 2 * D + u.pn * 256 + bj * 128 + wc * 32 + 8 * fq + 4 * n);
#pragma unroll
        for (int ai = 0; ai < 2; ++ai)
#pragma unroll
            for (int m = 0; m < 4; ++m) {
                const int row = u.pm * 256 + ai * 128 + wr * 64 + m * 16 + fr; float sq = 0.f;
                bf16* drow = (bf16*)(out + (size_t)row * D);
#pragma unroll
                for (int bj = 0; bj < 2; ++bj) {
                    const int c0 = u.pn * 256 + bj * 128 + wc * 32 + 8 * fq;
                    const f32x4 o0 = *(const f32x4*)(x + (size_t)row * D + c0) + g1[bj][0] * acc[ai][bj][m][0], o1 = *(const f32x4*)(x + (size_t)row * D + c0 + 4) + g1[bj][1] * acc[ai][bj][m][1];
                    sq += ((o0[0] * o0[0] + o0[1] * o0[1]) + (o0[2] * o0[2] + o0[3] * o0[3])) + ((o1[0] * o1[0] + o1[1] * o1[1]) + (o1[2] * o1[2] + o1[3] * o1[3]));
                    v4u hi, lo;
                    hi.x = pk2(o0[0], o0[1]); hi.y = pk2(o0[2], o0[3]); hi.z = pk2(o1[0], o1[1]); hi.w = pk2(o1[2], o1[3]);
#if X1_LO
                    lo.x = pk2(o0[0] - bflo(hi.x), o0[1] - bfhi(hi.x)); lo.y = pk2(o0[2] - bflo(hi.y), o0[3] - bfhi(hi.y));
                    lo.z = pk2(o1[0] - bflo(hi.z), o1[1] - bfhi(hi.z)); lo.w = pk2(o1[2] - bflo(hi.w), o1[3] - bfhi(hi.w));
                    *(v4u*)(drow + c0) = lo;
#else
                    (void)lo;
#endif
                    *(v4u*)(drow + D + c0) = hi;
                }
                sq += __shfl_xor(sq, 16); sq += __shfl_xor(sq, 32);
                if (fq == 0) ssq[row * 16 + u.pn * 4 + wc] = sq;
            }
    }
};

__device__ __forceinline__ void p2_fast(const Args& a, LAS unsigned char* lds) {
    pg8::SchedDense S; S.init((const bf16*)(a.ws + WS_H1), (const bf16*)(a.ws + WS_WIN), NTOK, DIN, D, D, D, gridDim.x, blockIdx.x, (REP_GEMM == 2) ? 2 : 1); S.tstamp = (TSTAMP_GEMM == 2) ? 1 : 0;
    EpiInProj E{(bf16*)(a.ws + WS_U2), (bf16*)(a.ws + WS_Z)};
    pg8::gemm_phase<EpiInProj, pg8::SchedDense, true>(lds, S, E);
}
__device__ __forceinline__ void p3d_fast(const Args& a, LAS unsigned char* lds) {
    pg8::SchedDense S; S.init((const bf16*)(a.ws + WS_YG), (const bf16*)(a.ws + WS_WGLU), NTOK, DSSM, DSSM, DSSM, DSSM, gridDim.x, blockIdx.x, (REP_GEMM == 6) ? 2 : 1);
    EpiGlu E{(const bf16*)(a.ws + WS_YG), (bf16*)(a.ws + WS_MRG), a.in[I_BGLU]};
    pg8::gemm_phase<EpiGlu, pg8::SchedDense, true>(lds, S, E);
}
__device__ __forceinline__ void p4_fast(const Args& a, LAS unsigned char* lds) {
    pg8::SchedDense S; S.init((const bf16*)(a.ws + WS_MRG), (const bf16*)(a.ws + WS_WOUT), NTOK, D, D, D, D, gridDim.x, blockIdx.x, (REP_GEMM == 8) ? 2 : 1);
    EpiOut E{a.in[I_X], a.out, (const float*)(a.ws + WS_MOD), (float*)(a.ws + WS_SSQ)};
    pg8::gemm_phase<EpiOut, pg8::SchedDense, ALIGN_P4>(lds, S, E);
}

template <bool GATHER>
struct SchedMoE {
    const LAS int* T; const char* Abase; const char* Bt; const int* tokk; int K, lda, ldb, nN, G, c; size_t bstride; int rep, eb, scale_a, scale_b, rep_epi, tstamp;
    __device__ __forceinline__ bool next(int i_, Unit& u) const {
        const int i = i_ / rep;
        const int NT = __builtin_amdgcn_readfirstlane(T[98 + NE]); int Tt, pn;
        if ((G & 7) == 0 && ((G >> 3) % nN) == 0) {
            const int x = c & 7, j = c >> 3, rtpr = (G >> 3) / nN, Ts = (x * NT) >> 3, Te = ((x + 1) * NT) >> 3;
            pn = j / rtpr; Tt = Ts + i * rtpr + (j % rtpr); if (Tt >= Te) return false;
            if (!GATHER) Tt = Te - 1 - (Tt - Ts);
        } else { const int L = i * G + c; Tt = L / nN; pn = L % nN; if (Tt >= NT) return false; }
        int e = 0;
        if (GATHER) { e = u.e;
            while (e + 1 < NE && __builtin_amdgcn_readfirstlane(T[98 + e + 1]) <= Tt) ++e; e = __builtin_amdgcn_readfirstlane(e); }
        else e = __builtin_amdgcn_readfirstlane(T[1280 + Tt]);
        u.e = e; u.pn = pn; u.pm = Tt; u.slot0 = __builtin_amdgcn_readfirstlane((Tt - T[98 + e]) * 256); u.row0 = __builtin_amdgcn_readfirstlane(T[32 + e] + u.slot0);
        const int left = __builtin_amdgcn_readfirstlane(T[e] - u.slot0); u.nvalid = left < 256 ? left : 256; return true;
    }
    __device__ __forceinline__ const char* a_base(const Unit& u) const { return GATHER ? Abase : Abase + (size_t)u.row0 * lda * eb; }
    __device__ __forceinline__ const char* b_base(const Unit& u) const { return Bt + ((size_t)u.e * bstride + (size_t)u.pn * 256 * ldb) * eb; }
    __device__ __forceinline__ void a_offsets(const Unit& u, const int (&R)[2], const int (&C)[2], unsigned (&off)[2][2]) const {
#pragma unroll
        for (int h = 0; h < 2; ++h)
#pragma unroll
            for (int i = 0; i < 2; ++i) {
                const int row = R[i] + 128 * h;
                if (GATHER) { int tok = 0; if (row < u.nvalid) tok = tokk[(size_t)u.e * CAP + u.slot0 + row] >> 2; off[h][i] = (unsigned)tok * (unsigned)(lda * eb) + (unsigned)C[i] * 2u; }
                else off[h][i] = (unsigned)(row * lda * eb + C[i] * 2);
            }
    }
};
struct EpiMoe1 {
    static constexpr bool PERM = true;
    bf16* ACT; const float* bg; const float* bu;
#if MOE1_WIDE
    __device__ __forceinline__ void operator()(f32x4 (&acc)[2][2][4][2], const Unit& u, int wr, int wc, int fr, int fq) const {
        asm volatile("" : "+v"(fr), "+v"(fq));
        const int gq = ((fq & 1) << 1) | (fq >> 1);
        const int f0 = u.pn * 128 + wc * 32 + 8 * gq;
        {
            const f32x4 g0 = *(const f32x4*)(bg + u.e * FF + f0), g1 = *(const f32x4*)(bg + u.e * FF + f0 + 4);
            const f32x4 u0 = *(const f32x4*)(bu + u.e * FF + f0) + 1.0f, u1 = *(const f32x4*)(bu + u.e * FF + f0 + 4) + 1.0f;
#pragma unroll
            for (int ai = 0; ai < 2; ++ai)
#pragma unroll
                for (int m = 0; m < 4; ++m) { acc[ai][0][m][0] += g0; acc[ai][0][m][1] += g1; acc[ai][1][m][0] += u0; acc[ai][1][m][1] += u1; }
            __builtin_amdgcn_sched_barrier(0);
        }
        unsigned char* dstu = (unsigned char*)ACT + (size_t)u.row0 * FF + u.pn * 128;
        const unsigned voff = (unsigned)((wr * 64 + (fq >> 1) * 16 + fr) * FF + wc * 32 + 16 * (fq & 1));
#pragma unroll
        for (int ai = 0; ai < 2; ++ai)
#pragma unroll
            for (int mp = 0; mp < 2; ++mp) {
                unsigned w[2][2];
#pragma unroll
                for (int mm = 0; mm < 2; ++mm) {
                    const int m = 2 * mp + mm;
                    float o[8];
#pragma unroll
                    for (int n = 0; n < 2; ++n) {
                        const f32x4 gv = acc[ai][0][m][n], uv = acc[ai][1][m][n];
#pragma unroll
                        for (int q = 0; q < 4; q += 2) {
                            const f32x2 gate = {fminf(gv[q], 7.0f), fminf(gv[q + 1], 7.0f)};
                            const f32x2 up1 = {__builtin_amdgcn_fmed3f(uv[q], -6.0f, 8.0f), __builtin_amdgcn_fmed3f(uv[q + 1], -6.0f, 8.0f)};
                            const f32x2 r = up1 * (gate * sig2(gate, -1.4426950408889634f * 1.702f));
                            o[n * 4 + q] = r.x; o[n * 4 + q + 1] = r.y;
                        }
                    }
                    w[mm][0] = pk_fp8x4(o[0], o[1], o[2], o[3]); w[mm][1] = pk_fp8x4(o[4], o[5], o[6], o[7]);
                    __builtin_amdgcn_sched_barrier(0);
                }
                const auto r0 = __builtin_amdgcn_permlane32_swap(w[0][0], w[1][0], false, false), r1 = __builtin_amdgcn_permlane32_swap(w[0][1], w[1][1], false, false);
                const v4u W = {r0[0], r1[0], r0[1], r1[1]};
                const int rl = ai * 128 + wr * 64 + (2 * mp + (fq >> 1)) * 16 + fr;
                if (rl < u.nvalid) *(v4u*)(dstu + (voff + (unsigned)((ai * 128 + mp * 32) * FF))) = W;
            }
#else
    __device__ __forceinline__ void operator()(const f32x4 (&acc)[2][2][4][2], const Unit& u, int wr, int wc, int fr, int fq) const {
        const int f0 = u.pn * 128 + wc * 32 + 8 * fq;
        const f32x4 g0 = *(const f32x4*)(bg + u.e * FF + f0), g1 = *(const f32x4*)(bg + u.e * FF + f0 + 4), u0 = *(const f32x4*)(bu + u.e * FF + f0), u1 = *(const f32x4*)(bu + u.e * FF + f0 + 4);
#pragma unroll
        for (int ai = 0; ai < 2; ++ai)
#pragma unroll
            for (int m = 0; m < 4; ++m) {
                const int rl = ai * 128 + wr * 64 + m * 16 + fr;
                if (rl < u.nvalid) {
                    float o[8];
#pragma unroll
                    for (int n = 0; n < 2; ++n) {
                        const f32x4 gv = acc[ai][0][m][n] + (n ? g1 : g0), uv = acc[ai][1][m][n] + (n ? u1 : u0);
#pragma unroll
                        for (int q = 0; q < 4; q += 2) {
                            const f32x2 gate = {fminf(gv[q], 7.0f), fminf(gv[q + 1], 7.0f)};
                            const f32x2 up = {__builtin_amdgcn_fmed3f(uv[q], -7.0f, 7.0f), __builtin_amdgcn_fmed3f(uv[q + 1], -7.0f, 7.0f)};
                            const f32x2 r = (up + 1.0f) * (gate * sig2(gate, -1.4426950408889634f * 1.702f));
                            o[n * 4 + q] = r.x; o[n * 4 + q + 1] = r.y;
                        }
                    }
#if MOE2_F8
                    v2u w; w.x = pk_fp8x4(o[0], o[1], o[2], o[3]); w.y = pk_fp8x4(o[4], o[5], o[6], o[7]);
                    *(v2u*)((unsigned char*)ACT + (size_t)(u.row0 + rl) * FF + f0) = w;
#else
                    v4u w; w.x = cvt_pk_bf16(o[0], o[1]); w.y = cvt_pk_bf16(o[2], o[3]); w.z = cvt_pk_bf16(o[4], o[5]); w.w = cvt_pk_bf16(o[6], o[7]);
                    *(v4u*)(ACT + (size_t)(u.row0 + rl) * FF + f0) = w;
#endif
                }
            }
#endif
    }
};
struct EpiMoe2 {
    static constexpr bool PERM = true;
    float* out; unsigned char* ws; const int* tokk; const float* bd;
    __device__ __forceinline__ void operator()(const f32x4 (&acc)[2][2][4][2], const Unit& u, int wr, int wc, int fr, int fq) const {
#if MOE2_WIDE
        const int c0 = u.pn * 256 + wc * 64 + 16 * fq;
#else
        const int c0 = u.pn * 256 + wc * 32 + 8 * fq;
#endif
        f32x4 bv[2][2];
#pragma unroll
        for (int bj = 0; bj < 2; ++bj)
#pragma unroll
            for (int n = 0; n < 2; ++n) bv[bj][n] = *(const f32x4*)(bd + u.e * D + c0 + (MOE2_WIDE ? bj * 8 : bj * 128) + 4 * n);
        int tks[2][4];
#pragma unroll
        for (int ai = 0; ai < 2; ++ai)
#pragma unroll
            for (int m = 0; m < 4; ++m) { const int rl = ai * 128 + wr * 64 + m * 16 + fr; tks[ai][m] = (rl < u.nvalid) ? tokk[(size_t)u.e * CAP + u.slot0 + rl] : 0; }
#pragma unroll
        for (int ai = 0; ai < 2; ++ai)
#pragma unroll
            for (int m = 0; m < 4; ++m) {
                const int rl = ai * 128 + wr * 64 + m * 16 + fr;
                if (rl < u.nvalid) {
                    const int tk = tks[ai][m], tok = tk >> 2, k = tk & 3;
#if YS_F8
                    unsigned char* dst = (k == 0) ? (unsigned char*)(out + (size_t)tok * D) : (k == 3) ? (ws + WS_YS3) + (size_t)tok * D : (ws + WS_YS12) + ((size_t)(k - 1) * NTOK + tok) * D;
#if MOE2_WIDE
                    const f32x4 v0 = acc[ai][0][m][0] + bv[0][0], v1 = acc[ai][0][m][1] + bv[0][1], v2 = acc[ai][1][m][0] + bv[1][0], v3 = acc[ai][1][m][1] + bv[1][1];
                    v4u w; w.x = pk_fp8x4(v0[0], v0[1], v0[2], v0[3]); w.y = pk_fp8x4(v1[0], v1[1], v1[2], v1[3]); w.z = pk_fp8x4(v2[0], v2[1], v2[2], v2[3]); w.w = pk_fp8x4(v3[0], v3[1], v3[2], v3[3]);
                    *(v4u*)(dst + c0) = w;
#else
#pragma unroll
                    for (int bj = 0; bj < 2; ++bj) { const f32x4 v0 = acc[ai][bj][m][0] + bv[bj][0], v1 = acc[ai][bj][m][1] + bv[bj][1];
                        v2u w; w.x = pk_fp8x4(v0[0], v0[1], v0[2], v0[3]); w.y = pk_fp8x4(v1[0], v1[1], v1[2], v1[3]);
                        *(v2u*)(dst + c0 + bj * 128) = w; }
#endif
#else
                    bf16* dst = (k == 0) ? (bf16*)(out + (size_t)tok * D) : (k == 3) ? (bf16*)(ws + WS_YS3) + (size_t)tok * D : (bf16*)(ws + WS_YS12) + ((size_t)(k - 1) * NTOK + tok) * D;
#pragma unroll
                    for (int bj = 0; bj < 2; ++bj) { const f32x4 v0 = acc[ai][bj][m][0] + bv[bj][0], v1 = acc[ai][bj][m][1] + bv[bj][1];
                        v4u w; w.x = cvt_pk_bf16(v0[0], v0[1]); w.y = cvt_pk_bf16(v0[2], v0[3]); w.z = cvt_pk_bf16(v1[0], v1[1]); w.w = cvt_pk_bf16(v1[2], v1[3]);
                        *(v4u*)(dst + c0 + bj * 128) = w; }
#endif
                }
            }
    }
};
__device__ __forceinline__ void p7_fast(const Args& a, LAS unsigned char* lds, LAS int* T) {
    SchedMoE<true> S{T, (const char*)(a.ws + WS_H2), (const char*)(a.ws + WS_WGU), (const int*)(a.ws + WS_TOKK), D, D, D, 8, (int)gridDim.x, (int)blockIdx.x, (size_t)2048 * D, (REP_GEMM == 10) ? 2 : 1, MOE1_F8 ? 1 : 2, 127, 127 - 5, (REP_EPI == 10) ? 1 : 0, (TSTAMP_GEMM == 10) ? 1 : 0};
    EpiMoe1 E{(bf16*)(a.ws + WS_ACT), a.in[I_BG], a.in[I_BU]};
    pg8::gemm_phase<EpiMoe1, SchedMoE<true>, ALIGN_MOE, MOE1_F8 != 0>(lds, S, E);
}
__device__ __forceinline__ void p8_fast(const Args& a, LAS unsigned char* lds, LAS int* T) {
    SchedMoE<false> S{T, (const char*)(a.ws + WS_ACT), (const char*)(a.ws + WS_WD), (const int*)(a.ws + WS_TOKK), FF, FF, FF, 4, (int)gridDim.x, (int)blockIdx.x, (size_t)D * FF, (REP_GEMM == 11) ? 2 : 1, MOE2_F8 ? 1 : 2, 127, MOE2_F8 ? 127 - 5 : 127, (REP_EPI == 11) ? 1 : 0, (TSTAMP_GEMM == 11) ? 1 : 0};
    EpiMoe2 E{a.out, a.ws, (const int*)(a.ws + WS_TOKK), a.in[I_BD]};
    pg8::gemm_phase<EpiMoe2, SchedMoE<false>, ALIGN_MOE, MOE2_F8 != 0>(lds, S, E);
}

struct EpiSloc {
    static constexpr bool PERM = false;
    float* SL;
    __device__ __forceinline__ void operator()(const f32x4 (&acc)[2][2][4][2], const Unit& u, int wr, int wc, int fr, int fq) const {
#pragma unroll
        for (int ai = 0; ai < 2; ++ai)
#pragma unroll
            for (int m = 0; m < 4; ++m) {
                float* rowp = SL + (size_t)(u.pm * 256 + ai * 128 + wr * 64 + m * 16 + fr) * (NG * 128) + u.e * 128 + wc * 32 + 4 * fq;
#pragma unroll
                for (int n = 0; n < 2; ++n) *(f32x4*)(rowp + n * 16) = acc[ai][0][m][n];
            }
    }
};
struct EpiY {
    static constexpr bool PERM = true;
    bf16* YG;
    __device__ __forceinline__ void operator()(const f32x4 (&acc)[2][2][4][2], const Unit& u, int wr, int wc, int fr, int fq) const {
#pragma unroll
        for (int ai = 0; ai < 2; ++ai)
#pragma unroll
            for (int m = 0; m < 4; ++m) {
                const int r = u.pm * 256 + ai * 128 + wr * 64 + m * 16 + fr;
#pragma unroll
                for (int bj = 0; bj < 2; ++bj) {
                    const int c0 = u.pn * 256 + bj * 128 + wc * 32 + 8 * fq, t = c0 >> 4, h0 = c0 & 15;
                    const f32x4 v0 = acc[ai][bj][m][0], v1 = acc[ai][bj][m][1];
                    const f32x2 z0 = gelu2((f32x2){v0[0], v0[1]}), z1 = gelu2((f32x2){v0[2], v0[3]}), z2 = gelu2((f32x2){v1[0], v1[1]}), z3 = gelu2((f32x2){v1[2], v1[3]});
                    v4u w; w.x = cvt_pk_bf16(z0.x, z0.y); w.y = cvt_pk_bf16(z1.x, z1.y); w.z = cvt_pk_bf16(z2.x, z2.y); w.w = cvt_pk_bf16(z3.x, z3.y);
                    *(v4u*)(YG + (size_t)(r * 32 + t) * DSSM + u.e * GH + h0) = w;
                }
            }
    }
};
__device__ __forceinline__ void p3a_fast(const Args& a, LAS unsigned char* lds) {
    pg8::SchedGroup S{(const bf16*)(a.ws + WS_U2), (const bf16*)(a.ws + WS_BTS), 512, U2LD, 512, NROW2 / 256, 1, NG, (int)gridDim.x, (int)blockIdx.x, (size_t)U2G, (size_t)256 * 512, (REP_GEMM == 3) ? 2 : 1, 1 << 30};
    EpiSloc E{(float*)(a.ws + WS_SLOC)};
    pg8::gemm_phase<EpiSloc, pg8::SchedGroup, true>(lds, S, E);
}
__device__ __forceinline__ void p3c_fast(const Args& a, LAS unsigned char* lds) {
    pg8::SchedGroup S{(const bf16*)(a.ws + WS_U2), (const bf16*)(a.ws + WS_BTY), U2G, U2LD, U2G, NROW2 / 256, 2, NG, (int)gridDim.x, (int)blockIdx.x, (size_t)U2G, (size_t)512 * U2G, (REP_GEMM == 5) ? 2 : 1, 1 << 30};
    EpiY E{(bf16*)(a.ws + WS_YG)};
    pg8::gemm_phase<EpiY, pg8::SchedGroup, true>(lds, S, E);
}
__device__ __forceinline__ void p3c_pair(const Args& a, LAS unsigned char* lds, int g, int pm) {
    pg8::SchedGroup S{(const bf16*)(a.ws + WS_U2), (const bf16*)(a.ws + WS_BTY), U2G, U2LD, U2G, NROW2 / 256, 2, NG, NROW2 / 256, g * 2 * (NROW2 / 256) + pm, (size_t)U2G, (size_t)512 * U2G, 1, 2};
    EpiY E{(bf16*)(a.ws + WS_YG)};
    pg8::gemm_phase<EpiY, pg8::SchedGroup, true>(lds, S, E);
}
__device__ __forceinline__ void p3b_scan(const Args& a, LAS float* sm, bool fused) {
    const float* SL = (const float*)(a.ws + WS_SLOC); bf16* U2 = (bf16*)(a.ws + WS_U2);
    const int t = threadIdx.x, p = t & 63, seg = t >> 6;
    for (int task = blockIdx.x; task < NB * NG; task += gridDim.x) {
        const int b = fused ? (task % (NROW2 / 256)) : (task / NG), g = fused ? (task / (NROW2 / 256)) : (task % NG);
        const float lr = a.in[I_LRE][g * NP + p], li = a.in[I_LIM][g * NP + p], dt = expf(a.in[I_LDT][g]);
        float ar, ai, br, bi;
        { const float m = expf(32.f * lr * dt); float s2, c2; sincosf(32.f * li * dt, &s2, &c2); ar = m * c2; ai = m * s2; }
        { const float m = expf(1024.f * lr * dt); float s2, c2; sincosf(1024.f * li * dt, &s2, &c2); br = m * c2; bi = m * s2; }
        const float* sl = SL + (size_t)(b * NCH + seg * 32) * (NG * 128) + g * 128 + p;
        float sr = 0.f, si = 0.f;
        float lre[32], lim[32];
#pragma unroll
        for (int c = 0; c < 32; ++c) { lre[c] = sl[(size_t)c * (NG * 128)]; lim[c] = sl[(size_t)c * (NG * 128) + 64]; }
#pragma unroll
        for (int c = 0; c < 32; ++c) { const float nr = ar * sr - ai * si + lre[c], ni = ar * si + ai * sr + lim[c]; sr = nr; si = ni; }
        sm[(seg * 64 + p) * 2] = sr; sm[(seg * 64 + p) * 2 + 1] = si;
        __syncthreads();
        float cr = 0.f, ci = 0.f;
        for (int s = 0; s < seg; ++s) { const float er = sm[(s * 64 + p) * 2], ei = sm[(s * 64 + p) * 2 + 1]; const float nr = br * cr - bi * ci + er, ni = br * ci + bi * cr + ei; cr = nr; ci = ni; }
        bf16* up = U2 + (size_t)(b * NCH + seg * 32) * U2LD + g * U2G + 512 + p;
        sr = cr; si = ci;
#pragma unroll
        for (int c = 0; c < 32; ++c) {
            up[(size_t)c * U2LD] = (bf16)f2bf(sr); up[(size_t)c * U2LD + 64] = (bf16)f2bf(si);
            const float nr = ar * sr - ai * si + lre[c], ni = ar * si + ai * sr + lim[c]; sr = nr; si = ni;
        }
        __syncthreads();
    }
}


#define XB_TMO      128
#define XB_XCNT(j)  (256  + 64 * (j))
#define XB_XSUB(j)  (1280 + 64 * (j))
#define XB_XGEN(j)  (2304 + 64 * (j))
#define XB_TOP      3328
#define XB_TOPGEN   3392
#define XCD_BAR_WORDS 3456
#define XB_SPIN_CAP (1u << 22)
__device__ __forceinline__ unsigned xb_ld(unsigned* p)              { return __hip_atomic_load(p, __ATOMIC_RELAXED, __HIP_MEMORY_SCOPE_AGENT); }
__device__ __forceinline__ unsigned xb_add(unsigned* p, unsigned v) { return __hip_atomic_fetch_add(p, v, __ATOMIC_RELAXED, __HIP_MEMORY_SCOPE_AGENT); }
__device__ __forceinline__ unsigned xb_xcc_id() { return (unsigned)__builtin_amdgcn_s_getreg((3 << 11) | 20) & 0xFu; }
#define XB_SPIN(cond, bar) do { unsigned _sp = 0; while (cond) { __builtin_amdgcn_s_sleep(1); \
    if ((++_sp & 255u) == 0u) { if (xb_ld(&(bar)[XB_TMO])) break; if (_sp > XB_SPIN_CAP) { atomicAdd(&(bar)[XB_TMO], 1u); break; } } } } while (0)
struct XcdBarrier { unsigned* bar; unsigned x; volatile LAS unsigned* st; };
__device__ __forceinline__ XcdBarrier xcd_barrier_post(unsigned* bar, volatile LAS unsigned* st) {
    XcdBarrier b; b.bar = bar; b.x = xb_xcc_id(); b.st = st;
    if (threadIdx.x == 0) (void)xb_add(&bar[XB_XCNT(b.x)], 1u);
    return b;
}
__device__ __forceinline__ void xcd_barrier_complete(unsigned* bar, unsigned x, unsigned& nloc, unsigned& nx) {
    const unsigned G = gridDim.x * gridDim.y * gridDim.z;
    unsigned sum, cnt, mine, sp = 0u;
    for (;;) {
        sum = 0u; cnt = 0u; mine = 0u;
#pragma unroll
        for (unsigned j = 0; j < 16; ++j) { const unsigned c = xb_ld(&bar[XB_XCNT(j)]); sum += c; cnt += (c > 0u) ? 1u : 0u; mine = (j == x) ? c : mine; }
        if (sum == G) break;
        __builtin_amdgcn_s_sleep(1);
        if ((++sp & 255u) == 0u) { if (xb_ld(&bar[XB_TMO])) break; if (sp > XB_SPIN_CAP) { atomicAdd(&bar[XB_TMO], 1u); break; } }
    }
    nloc = mine > 0u ? mine : 1u; nx = cnt > 0u ? cnt : 1u;
}
__device__ __forceinline__ void xcd_barrier(const XcdBarrier& b) {
    asm volatile("s_waitcnt vmcnt(0)" ::: "memory");
    __syncthreads();
    if (threadIdx.x == 0) {
        unsigned* bar = b.bar;
        __builtin_amdgcn_s_waitcnt(0);
        unsigned nloc = b.st[0], nx = b.st[1];
        if (nloc == 0u) { xcd_barrier_complete(bar, b.x, nloc, nx); b.st[0] = nloc; b.st[1] = nx; }
        const unsigned old = xb_add(&bar[XB_XSUB(b.x)], 1u);
        const unsigned gen = old / nloc;
        if (old + 1u == (gen + 1u) * nloc) {
            __builtin_amdgcn_fence(__ATOMIC_RELEASE, "agent");
            asm volatile("s_waitcnt vmcnt(0)" ::: "memory");
            const unsigned og = xb_add(&bar[XB_TOP], 1u);
            const unsigned tg = og / nx;
            if (og + 1u == (tg + 1u) * nx) xb_add(&bar[XB_TOPGEN], 1u);
            else XB_SPIN(xb_ld(&bar[XB_TOPGEN]) == tg, bar);
            __builtin_amdgcn_fence(__ATOMIC_ACQUIRE, "agent");
            xb_add(&bar[XB_XGEN(b.x)], 1u);
            asm volatile("s_waitcnt vmcnt(0)" ::: "memory");
        } else {
            XB_SPIN(xb_ld(&bar[XB_XGEN(b.x)]) == gen, bar);
            __builtin_amdgcn_fence(__ATOMIC_ACQUIRE, "agent");
            asm volatile("s_waitcnt vmcnt(0)" ::: "memory");
        }
    }
    __syncthreads();
}

__device__ __forceinline__ void p1_router_item(const Args& a, int it, int lane) {
    const float* rw = a.in[I_RW]; const float* g = a.in[I_N2G]; const float* mod = (const float*)(a.ws + WS_MOD);
    bf16* RWH = (bf16*)(a.ws + WS_RWT); bf16* RWL = RWH + NB * NE * D; float* rbias = (float*)(a.ws + WS_RWT + 524288);
    {
        const int b = it >> 5, e = it & 31; float bs = 0.f;
#pragma unroll 4
        for (int j = 0; j < 16; ++j) {
            const int k = lane + 64 * j; const float w = rw[k * NE + e], wp = w * g[k] * (1.0f + mod[b * 6 * D + 4 * D + k]);
            const unsigned hi = f2bf(wp), lo = f2bf(wp - bf2f(hi));
            RWH[(size_t)(b * NE + e) * D + k] = (bf16)hi; RWL[(size_t)(b * NE + e) * D + k] = (bf16)lo;
            bs += mod[b * 6 * D + 3 * D + k] * w;
        }
        bs = wave_sum(bs);
        if (lane == 0) rbias[b * NE + e] = bs + a.in[I_RB][e];
    }
}
__device__ __forceinline__ void top4_of8(float (&v)[8], const int (&e)[8], float (&tv)[4], int (&ti)[4]) {
#pragma unroll
    for (int r = 0; r < 4; ++r) {
        float bv = v[0]; int be = e[0];
#pragma unroll
        for (int i = 1; i < 8; ++i) { const bool t = v[i] > bv || (v[i] == bv && e[i] < be); bv = t ? v[i] : bv; be = t ? e[i] : be; }
        tv[r] = bv; ti[r] = be;
#pragma unroll
        for (int i = 0; i < 8; ++i) v[i] = (e[i] == be) ? -3.0e38f : v[i];
    }
}
__device__ __forceinline__ bf16x8 pack_hi8(const f32x4 x0, const f32x4 x1, bf16x8& lo) {
    const float f[8] = {x0[0], x0[1], x0[2], x0[3], x1[0], x1[1], x1[2], x1[3]};
    v4u h, l;
#pragma unroll
    for (int i = 0; i < 4; ++i) { const unsigned w = pk2(f[2 * i], f[2 * i + 1]); h[i] = w; l[i] = pk2(f[2 * i] - bflo(w), f[2 * i + 1] - bfhi(w)); }
    lo = __builtin_bit_cast(bf16x8, l);
    return __builtin_bit_cast(bf16x8, h);
}
__device__ __forceinline__ void p5_fast(const Args& a, LAS unsigned char* lds, int lane, int wave) {
    LAS unsigned* hist = (LAS unsigned*)(lds + 131072 + 1024);
    LAS unsigned* basearr = hist + 64;
    const bf16* RWH = (const bf16*)(a.ws + WS_RWT); const bf16* RWL = RWH + NB * NE * D; const float* rbias = (const float*)(a.ws + WS_RWT + 524288);
    const float* g = a.in[I_N2G]; const float* mod = (const float*)(a.ws + WS_MOD);
    bf16* H2 = (bf16*)(a.ws + WS_H2); float* topw = (float*)(a.ws + WS_TOPW); int* tokk = (int*)(a.ws + WS_TOKK); unsigned* cnt = (unsigned*)(a.ws + WS_CTL) + CW_CNT;
    const int col = lane & 15, q = lane >> 4;
    LAS float* gam = (LAS float*)(lds + 131072 + 8192); LAS float* bet = gam + D;
    int lds_batch = -1;
    if (threadIdx.x < 96) hist[threadIdx.x] = 0u;
    __syncthreads();
    int iter = 0;
    for (int task0 = blockIdx.x * NWAVES; task0 < NTOK / 16; task0 += gridDim.x * NWAVES, ++iter) {
        const int task = task0 + wave; const bool active = task < NTOK / 16;
        float tv[4] = {0.f, 0.f, 0.f, 0.f}; int ti[4] = {0, 1, 2, 3}; unsigned rank[4] = {0u, 0u, 0u, 0u};
        const int tok = task * 16 + col, b = (task * 16) >> 13;
        LAS unsigned* hcur = hist + (iter & 1) * 32;
        {
            const int bb = (task0 * 16) >> 13;
            if (bb != lds_batch) {
                __syncthreads();
                const v4u* srch = (const v4u*)(RWH + (size_t)bb * NE * D); const v4u* srcl = (const v4u*)(RWL + (size_t)bb * NE * D);
#pragma unroll
                for (int i = 0; i < 8; ++i) { const int ci = threadIdx.x + NTHR * i, e = ci >> 7, c = ci & 127, d = (e * 128 + (c ^ (e & 15))) * 16;
                    *(LAS v4u*)(lds + d) = srch[ci]; *(LAS v4u*)(lds + 65536 + d) = srcl[ci]; }
                for (int k = threadIdx.x; k < D; k += NTHR) { gam[k] = g[k] * (1.0f + mod[bb * 6 * D + 4 * D + k]); bet[k] = mod[bb * 6 * D + 3 * D + k]; }
                lds_batch = bb;
                __syncthreads();
            }
        }
        if (active) {
            float rstd;
            { const f32x4* sp = (const f32x4*)((const float*)(a.ws + WS_SSQ) + (size_t)tok * 16); const f32x4 s0 = sp[0], s1 = sp[1], s2 = sp[2], s3 = sp[3];
              const float ss = (((s0[0] + s0[1]) + (s0[2] + s0[3])) + ((s1[0] + s1[1]) + (s1[2] + s1[3]))) + (((s2[0] + s2[1]) + (s2[2] + s2[3])) + ((s3[0] + s3[1]) + (s3[2] + s3[3])));
              rstd = rsqrtf(ss * (1.f / D) + 1e-6f); }
            f32x4 acc0 = {0.f, 0.f, 0.f, 0.f}, acc1 = {0.f, 0.f, 0.f, 0.f};
            const bf16* hrow = (const bf16*)(a.out + (size_t)tok * D) + D + 8 * q; const bf16* lrow = (const bf16*)(a.out + (size_t)tok * D) + 8 * q;
            v4u rh[8], rl[8];
#pragma unroll
            for (int i = 0; i < 8; ++i) { rh[i] = __builtin_nontemporal_load((const v4u*)(hrow + 32 * i)); rl[i] = X1_LO ? __builtin_nontemporal_load((const v4u*)(lrow + 32 * i)) : (v4u){0u, 0u, 0u, 0u}; }
            const int e0 = col, e1 = 16 + col;
#pragma unroll 1
            for (int so = 0; so < 32; so += 8) {
#pragma unroll
                for (int si = 0; si < 8; ++si) {
                    const int st = so + si, k0 = 32 * st, k = k0 + 8 * q, c = 4 * st + q;
                    const v4u xh = rh[si], xl = rl[si];
                    { const int kn = (st + 8 < 32) ? k0 + 256 : 0; rh[si] = __builtin_nontemporal_load((const v4u*)(hrow + kn)); if (X1_LO) rl[si] = __builtin_nontemporal_load((const v4u*)(lrow + kn)); }
                    asm volatile("" ::: "memory");
                    const bf16x8 a0h = *(const LAS bf16x8*)(lds + (e0 * 128 + (c ^ (e0 & 15))) * 16), a0l = *(const LAS bf16x8*)(lds + 65536 + (e0 * 128 + (c ^ (e0 & 15))) * 16);
                    const bf16x8 a1h = *(const LAS bf16x8*)(lds + (e1 * 128 + (c ^ (e1 & 15))) * 16), a1l = *(const LAS bf16x8*)(lds + 65536 + (e1 * 128 + (c ^ (e1 & 15))) * 16);
                    const f32x4 g0 = *(const LAS f32x4*)(gam + k), g1 = *(const LAS f32x4*)(gam + k + 4), s0 = *(const LAS f32x4*)(bet + k), s1 = *(const LAS f32x4*)(bet + k + 4);
                    const bf16x8 bh = __builtin_bit_cast(bf16x8, xh), bl = __builtin_bit_cast(bf16x8, xl);
                    acc0 = __builtin_amdgcn_mfma_f32_16x16x32_bf16(a0h, bh, acc0, 0, 0, 0); if (X1_LO) acc0 = __builtin_amdgcn_mfma_f32_16x16x32_bf16(a0h, bl, acc0, 0, 0, 0); acc0 = __builtin_amdgcn_mfma_f32_16x16x32_bf16(a0l, bh, acc0, 0, 0, 0);
                    acc1 = __builtin_amdgcn_mfma_f32_16x16x32_bf16(a1h, bh, acc1, 0, 0, 0); if (X1_LO) acc1 = __builtin_amdgcn_mfma_f32_16x16x32_bf16(a1h, bl, acc1, 0, 0, 0); acc1 = __builtin_amdgcn_mfma_f32_16x16x32_bf16(a1l, bh, acc1, 0, 0, 0);
#if X1_LO
                    const f32x4 x0 = {bflo(xh.x) + bflo(xl.x), bfhi(xh.x) + bfhi(xl.x), bflo(xh.y) + bflo(xl.y), bfhi(xh.y) + bfhi(xl.y)};
                    const f32x4 x1 = {bflo(xh.z) + bflo(xl.z), bfhi(xh.z) + bfhi(xl.z), bflo(xh.w) + bflo(xl.w), bfhi(xh.w) + bfhi(xl.w)};
#else
                    const f32x4 x0 = {bflo(xh.x), bfhi(xh.x), bflo(xh.y), bfhi(xh.y)}, x1 = {bflo(xh.z), bfhi(xh.z), bflo(xh.w), bfhi(xh.w)};
#endif
                    const f32x4 h0 = x0 * rstd * g0 + s0, h1 = x1 * rstd * g1 + s1;
#if MOE1_F8
                    v2u hw; hw.x = pk_fp8x4(h0[0], h0[1], h0[2], h0[3]); hw.y = pk_fp8x4(h1[0], h1[1], h1[2], h1[3]);
                    *(v2u*)((unsigned char*)H2 + (size_t)tok * D + 8 * q + k0) = hw;
#else
                    v4u hw; hw.x = pk2(h0[0], h0[1]); hw.y = pk2(h0[2], h0[3]); hw.z = pk2(h1[0], h1[1]); hw.w = pk2(h1[2], h1[3]);
                    *(v4u*)(H2 + (size_t)tok * D + 8 * q + k0) = hw;
#endif
                    asm volatile("" ::: "memory");
                }
            }
            STAMP(19);
            float v[8]; int e[8];
#pragma unroll
            for (int j = 0; j < 4; ++j) { e[j] = 4 * q + j; e[4 + j] = 16 + 4 * q + j; v[j] = rstd * acc0[j] + rbias[b * NE + 4 * q + j]; v[4 + j] = rstd * acc1[j] + rbias[b * NE + 16 + 4 * q + j]; }
            top4_of8(v, e, tv, ti);
#pragma unroll
            for (int off = 16; off <= 32; off <<= 1) {
                float v2[8]; int e2[8];
#pragma unroll
                for (int r = 0; r < 4; ++r) { v2[r] = tv[r]; e2[r] = ti[r]; v2[4 + r] = __shfl_xor(tv[r], off); e2[4 + r] = __shfl_xor(ti[r], off); }
                top4_of8(v2, e2, tv, ti);
            }
            if (q == 0) {
#pragma unroll
                for (int r = 0; r < 4; ++r) rank[r] = __hip_atomic_fetch_add(hcur + ti[r], 1u, __ATOMIC_RELAXED, __HIP_MEMORY_SCOPE_WORKGROUP);
            }
        }
        STAMP(20);
        __syncthreads();
        STAMP(21);
        if (threadIdx.x < 32) { const unsigned n = hcur[threadIdx.x]; basearr[threadIdx.x] = n ? atomicAdd(cnt + 32 * threadIdx.x, n) : 0u; hist[((iter + 1) & 1) * 32 + threadIdx.x] = 0u; }
        __syncthreads();
        if (active && q == 0) {
            const float e1 = __expf(tv[1] - tv[0]), e2 = __expf(tv[2] - tv[0]), e3 = __expf(tv[3] - tv[0]), inv = 1.f / (1.f + e1 + e2 + e3);
            const float w[4] = {inv, e1 * inv, e2 * inv, e3 * inv};
#pragma unroll
            for (int r = 0; r < 4; ++r) { const unsigned slot = basearr[ti[r]] + rank[r]; tokk[(size_t)ti[r] * CAP + slot] = tok * 4 + r; }
            *(f32x4*)(topw + tok * 4) = (f32x4){w[0], w[1], w[2], w[3]};
        }
    }
}

constexpr int NPHASE = 13;
__global__ void __launch_bounds__(NTHR, 2) fwd_kernel(Args a) {
    extern __shared__ __attribute__((aligned(16))) unsigned char lds_raw[];
    LAS unsigned char* lds = (LAS unsigned char*)lds_raw;
    LAS float* sm = (LAS float*)lds;
    LAS int* T = (LAS int*)(lds + 131072);
#if USE_CG_SYNC
    cg::grid_group grid = cg::this_grid();
#else
    volatile LAS unsigned* MISC = (volatile LAS unsigned*)(lds + 131072 + 2048);
    if (threadIdx.x < 32) MISC[threadIdx.x] = 0u;
    __syncthreads();
    XcdBarrier xbar = xcd_barrier_post((unsigned*)(a.ws + WS_CTL) + CW_BAR, MISC + 8);
#endif
    const int tid = threadIdx.x, lane = tid & 63, wave = __builtin_amdgcn_readfirstlane(tid >> 6);
    const int gw = blockIdx.x * NWAVES + wave, ngw = gridDim.x * NWAVES;
    const int lo = a.ph_lo, hi = a.ph_hi;
#define IN(k) (lo <= (k) && (k) < hi)
#if TIME_PHASE >= 0
    LAS unsigned long long* TS = (LAS unsigned long long*)(lds + 131072 + 4096);
#endif
#if USE_CG_SYNC
#define SEAM(k) do { if (IN(k) && IN((k) + 1)) grid.sync(); } while (0)
#else
#define SEAM(k) do { if (IN(k) && IN((k) + 1)) xcd_barrier(xbar); } while (0)
#endif
#define REP(k) _Pragma("nounroll") for (int _r = 0; _r < (((REP_MASK >> (k)) & 1) ? a.rep_mask : 1); ++_r)
    STAMP(0); if (IN(0)) { REP(0) { p0_mod(a, sm); STAMP(16); p0_s5_mats(a, sm); __syncthreads(); STAMP(17); p0_convert(a, gw, ngw, lane); __syncthreads(); STAMP(18); } }
    STAMP(1); if (IN(0)) { mod_wait(a); p1_dynamic(a, lane); } SEAM(1);
    STAMP(2); if (IN(2)) { REP(2) { p2_fast(a, lds); } } SEAM(2);
    STAMP(3); if (IN(3)) { p3a_fast(a, lds); if (gridDim.x >= NB * NG) { asm volatile("s_waitcnt vmcnt(0)" ::: "memory"); __syncthreads(); if (blockIdx.x < NB * NG) { p3b_scan(a, sm, true); asm volatile("s_waitcnt vmcnt(0)" ::: "memory"); __syncthreads(); p3c_pair(a, lds, blockIdx.x / (NROW2 / 256), blockIdx.x % (NROW2 / 256)); } __syncthreads(); p3e_conv(a, sm, lane); } else p3e_conv(a, sm, lane); }
    if (gridDim.x < NB * NG) { SEAM(3); if (IN(4)) { p3b_scan(a, sm, false); __syncthreads(); p3e_conv(a, sm, lane); } }
    STAMP(4); if (gridDim.x < NB * NG) SEAM(4);
    STAMP(5); if (IN(5) && gridDim.x < NB * NG) { p3c_fast(a, lds); } SEAM(5);
    STAMP(6); if (IN(6)) { REP(6) { p3d_fast(a, lds); } } SEAM(6);
    STAMP(7); if (IN(7)) { p3e_norm(a, gw, ngw, lane); } SEAM(7);
    STAMP(8); if (IN(8)) { REP(8) { p4_fast(a, lds); } } SEAM(8);
    STAMP(9); if (IN(9)) { p5_fast(a, lds, lane, wave); } SEAM(9);
    STAMP(10); if (IN(10)) { moe_tables(a, T); REP(10) { p7_fast(a, lds, T); } } SEAM(10);
    STAMP(11); if (IN(11)) { moe_tables(a, T); REP(11) { p8_fast(a, lds, T); } } SEAM(11);
    STAMP(12); if (IN(12)) { p9_final(a, gw, ngw, lane); }
#undef REP
    STAMP(13);
#if TIME_PHASE >= 0
    if (blockIdx.x == 0 && threadIdx.x == 0) { const unsigned long long dt = TS[TIME_B] - TS[TIME_A], t1 = TS[13]; while (__builtin_amdgcn_s_memrealtime() - t1 < 8ull * dt) __builtin_amdgcn_s_sleep(8); }
#endif
#undef IN
#undef SEAM
}

#ifndef N_LAUNCHES
#define N_LAUNCHES 1
#endif
extern "C" void kernel_launch(void* const* d_in, const int* in_sizes, int n_in, void* d_out, int out_size, void* d_ws, size_t ws_size, hipStream_t stream) {
    static int grid = 0;
    if (grid == 0) {
        if (n_in != 32 || out_size != NTOK * D || ws_size < WS_END) { fprintf(stderr, "kernel_launch: unexpected problem (n_in %d out %d ws %zu)\n", n_in, out_size, ws_size); grid = -1; return; }
        int dev = 0, cus = 0, per_cu = 0;
        if (hipGetDevice(&dev) != hipSuccess || hipDeviceGetAttribute(&cus, hipDeviceAttributeMultiprocessorCount, dev) != hipSuccess) { grid = -1; return; }
        if (hipFuncSetAttribute((const void*)fwd_kernel, hipFuncAttributeMaxDynamicSharedMemorySize, LDS_BYTES) != hipSuccess) { fprintf(stderr, "kernel_launch: hipFuncSetAttribute failed\n"); grid = -1; return; }
        if (hipOccupancyMaxActiveBlocksPerMultiprocessor(&per_cu, (const void*)fwd_kernel, NTHR, LDS_BYTES) != hipSuccess || per_cu < 1) { fprintf(stderr, "kernel_launch: occupancy query says %d\n", per_cu); (void)hipGetLastError(); per_cu = 1; }
        grid = cus;
    }
    if (grid < 0) return;
    (void)hipMemsetAsync((char*)d_ws + WS_CTL, 0, 65536, stream);
    Args a{};
    for (int i = 0; i < 32; ++i) a.in[i] = (const float*)d_in[i];
    a.out = (float*)d_out; a.ws = (unsigned char*)d_ws; a.rep_mask = 2;
    for (int li = 0; li < N_LAUNCHES; ++li) {
        a.ph_lo = (N_LAUNCHES == 1) ? 0 : li; a.ph_hi = (N_LAUNCHES == 1) ? NPHASE : li + 1;
        void* args[] = {&a};
        hipError_t e = hipLaunchCooperativeKernel((const void*)fwd_kernel, dim3(grid), dim3(NTHR), args, LDS_BYTES, stream);
        if (e != hipSuccess) { fprintf(stderr, "kernel_launch: launch %d failed: %s\n", li, hipGetErrorString(e)); break; }
    }
}
```

```cpp
#include <hip/hip_runtime.h>
#include <hip/hip_cooperative_groups.h>
#include <cstdio>
#include <cstdint>
namespace cg = cooperative_groups;
#define MOE2_WIDE (MOE2_F8 && YS_F8)
#define MOE1_WIDE (MOE1_F8 && MOE2_F8)
#ifndef USE_CG_SYNC
#define USE_CG_SYNC 0
#endif
#ifndef YS_F8
#define YS_F8 1
#endif
#ifndef MOE2_F8
#define MOE2_F8 1
#endif
#ifndef MOE1_F8
#define MOE1_F8 1
#endif
#ifndef TIME_PHASE
#define TIME_PHASE -1
#endif
#ifndef TIME_A
#define TIME_A (TIME_PHASE)
#define TIME_B (TIME_PHASE + 1)
#endif
#ifndef X1_LO
#define X1_LO 0
#endif
#ifndef ALIGN_P4
#define ALIGN_P4 true
#endif
#ifndef ALIGN_MOE
#define ALIGN_MOE true
#endif
#ifndef TSTAMP_GEMM
#define TSTAMP_GEMM 0
#endif
#ifndef REP_EPI
#define REP_EPI 0
#endif
#ifndef REP_GEMM
#define REP_GEMM 0
#endif
#ifndef REP_MASK
#define REP_MASK 0
#endif

#define GAS __attribute__((address_space(1)))
#define LAS __attribute__((address_space(3)))
typedef unsigned short bf16;
typedef unsigned v4u __attribute__((ext_vector_type(4)));
typedef unsigned v2u __attribute__((ext_vector_type(2)));
typedef float f32x4 __attribute__((ext_vector_type(4)));
typedef float f32x2 __attribute__((ext_vector_type(2)));
typedef short bf16x8 __attribute__((ext_vector_type(8)));

constexpr int NB = 4, SEQ = 8192, D = 1024, NTOK = NB * SEQ;
constexpr int DSSM = 512, DCONV = 512, NG = 32, GH = 16, NP = 64, DIN = 1536, CW = 31;
constexpr int NE = 32, TOPK = 4, FF = 1024;
constexpr int TCH = 32, NCH = SEQ / TCH, NROW2 = NB * NCH, U2G = 640, U2LD = NG * U2G;
constexpr int NWAVES = 8, NTHR = 512;
constexpr int LDS_BYTES = 147456;
constexpr int CAP = NTOK;

enum { I_X = 0, I_C, I_ADAW, I_ADAB, I_N1G, I_WIN, I_LRE, I_LIM, I_LDT, I_BRE, I_BIM, I_CRE, I_CIM, I_DSK, I_WGLU, I_BGLU, I_CONVW, I_CONVB, I_LNG, I_LNB,
       I_ONG, I_WOUT, I_N2G, I_RW, I_RB, I_WG, I_BG, I_WU, I_BU, I_WD, I_BD, I_FG };

constexpr size_t MiB = 1u << 20;
constexpr size_t WS_WIN = 0 * MiB;
constexpr size_t WS_WGLU = 3 * MiB;
constexpr size_t WS_WOUT = 4 * MiB;
constexpr size_t WS_BTS = 6 * MiB;
constexpr size_t WS_BTY = 14 * MiB;
constexpr size_t WS_H2 = 0 * MiB;
constexpr size_t WS_YS3 = 0 * MiB;
constexpr size_t WS_CTL = 64 * MiB;
constexpr size_t WS_MOD = 64 * MiB + 65536;
constexpr size_t WS_TOPW = 65 * MiB;
constexpr size_t WS_TOKK = 66 * MiB;
constexpr size_t WS_RWT = 70 * MiB;
constexpr size_t WS_ACT = 72 * MiB;
constexpr size_t WS_SSQ = 72 * MiB;
constexpr size_t WS_H1 = 72 * MiB;
constexpr size_t WS_U2 = 136 * MiB;
constexpr size_t WS_Z = 176 * MiB;
constexpr size_t WS_SLOC = 208 * MiB;
constexpr size_t WS_YG = 224 * MiB;
constexpr size_t WS_MRG = 256 * MiB;
constexpr size_t WS_WD = 328 * MiB;
constexpr size_t WS_WGU = 392 * MiB;
constexpr size_t WS_YS12 = 392 * MiB;
constexpr size_t WS_END = 520 * MiB;
constexpr int CW_CNT = 8192  , CW_CONV = 64  , CW_MOD = 640, CW_P1 = 4608  , CW_CONVW = 5120  , CW_BAR = 1024;

struct Args { const float* in[32]; float* out; unsigned char* ws; int ph_lo, ph_hi, rep_mask, pad; };

__device__ __forceinline__ float bf2f(unsigned v) { return __builtin_bit_cast(float, v << 16); }
__device__ __forceinline__ unsigned f2bf(float f) { unsigned u = __builtin_bit_cast(unsigned, f); return (u + 0x7fffu + ((u >> 16) & 1u)) >> 16; }
__device__ __forceinline__ unsigned pk2(float lo, float hi) { unsigned r; asm("v_cvt_pk_bf16_f32 %0, %1, %2" : "=v"(r) : "v"(lo), "v"(hi)); return r; }
__device__ __forceinline__ float bflo(unsigned w) { return __builtin_bit_cast(float, w << 16); }
__device__ __forceinline__ float bfhi(unsigned w) { return __builtin_bit_cast(float, w & 0xffff0000u); }
__device__ __forceinline__ float sigmoidf_(float x) { return __builtin_amdgcn_rcpf(1.0f + __expf(-x)); }
__device__ __forceinline__ float siluf_(float x) { return x * sigmoidf_(x); }
__device__ __forceinline__ float gelu_tanh(float x) { const float u = 0.7978845608028654f * (x + 0.044715f * x * x * x); return x * sigmoidf_(2.0f * u); }
__device__ __forceinline__ f32x2 sig2(const f32x2 x, const float k  ) {
    const f32x2 t = x * k; f32x2 e; e.x = __builtin_amdgcn_exp2f(t.x); e.y = __builtin_amdgcn_exp2f(t.y);
    const f32x2 d = e + 1.0f; f32x2 r; r.x = __builtin_amdgcn_rcpf(d.x); r.y = __builtin_amdgcn_rcpf(d.y); return r; }
__device__ __forceinline__ f32x2 gelu2(const f32x2 x) {
    const f32x2 p = (x * x) * 0.044715f + 1.0f; return x * sig2(x * p, -1.4426950408889634f * 2.0f * 0.7978845608028654f); }
#define WS_DPP(v, ctrl, rmask) ((v) + __builtin_bit_cast(float, __builtin_amdgcn_update_dpp(0, __builtin_bit_cast(int, (v)), (ctrl), (rmask), 0xf, false)))
__device__ __forceinline__ float wave_sum(float v) {
    v = WS_DPP(v, 0x128, 0xf);
    v = WS_DPP(v, 0x124, 0xf);
    v = WS_DPP(v, 0x122, 0xf);
    v = WS_DPP(v, 0x121, 0xf);
    v = WS_DPP(v, 0x142, 0xa);
    v = WS_DPP(v, 0x143, 0xc);
    return __builtin_bit_cast(float, __builtin_amdgcn_readlane(__builtin_bit_cast(int, v), 63));
}
#define LDS_WAIT() asm volatile("s_waitcnt lgkmcnt(0)" ::: "memory")
#ifndef TIME_PHASE
#define TIME_PHASE -1
#endif
#if TIME_PHASE >= 0
extern __shared__ __attribute__((aligned(16))) unsigned char lds_raw_ts[];
#define STAMP(k) do { if (threadIdx.x == 0) ((LAS unsigned long long*)((LAS unsigned char*)lds_raw_ts + 131072 + 4096))[k] = __builtin_amdgcn_s_memrealtime(); } while (0)
#else
#define STAMP(k) do { } while (0)
#endif

__device__ __forceinline__ void p0_mod(const Args& a, LAS float* sm) {
    const float* c = a.in[I_C]; const float* W = a.in[I_ADAW]; const float* bias = a.in[I_ADAB];
    float* mod = (float*)(a.ws + WS_MOD);
    const int t = threadIdx.x, cl = t & 31, kq = t >> 5;
    if (blockIdx.x >= 192) return;
    LAS float* sc = sm + 2048;
    for (int i = t; i < NB * D; i += NTHR) sc[i] = siluf_(c[i]);
    __syncthreads();
    for (int item = blockIdx.x; item < 192; item += gridDim.x) {
        const int col = item * 32 + cl;
        float a0 = 0.f, a1 = 0.f, a2 = 0.f, a3 = 0.f;
#pragma unroll 16
        for (int k = kq; k < D; k += 16) {
            const float w = W[(size_t)k * (6 * D) + col];
            a0 += sc[k] * w; a1 += sc[D + k] * w; a2 += sc[2 * D + k] * w; a3 += sc[3 * D + k] * w;
        }
        sm[(kq * 32 + cl) * 4 + 0] = a0; sm[(kq * 32 + cl) * 4 + 1] = a1; sm[(kq * 32 + cl) * 4 + 2] = a2; sm[(kq * 32 + cl) * 4 + 3] = a3;
        __syncthreads();
        if (t < 128) { const int b = t >> 5; float s = 0.f;
#pragma unroll
            for (int q = 0; q < 16; ++q) s += sm[(q * 32 + cl) * 4 + b];
            mod[b * 6 * D + col] = s + bias[col]; }
        __syncthreads();
        if (t == 0) {
            __builtin_amdgcn_fence(__ATOMIC_RELEASE, "agent"); asm volatile("s_waitcnt vmcnt(0)" ::: "memory");
            __hip_atomic_fetch_add((unsigned*)(a.ws + WS_CTL) + CW_MOD, 1u, __ATOMIC_RELAXED, __HIP_MEMORY_SCOPE_AGENT);
        }
    }
}
__device__ __forceinline__ void mod_wait(const Args& a) {
    if (threadIdx.x == 0) {
        unsigned* f = (unsigned*)(a.ws + WS_CTL) + CW_MOD; unsigned sp = 0;
        while (__hip_atomic_load(f, __ATOMIC_RELAXED, __HIP_MEMORY_SCOPE_AGENT) < 192u) { __builtin_amdgcn_s_sleep(2); if (++sp > (1u << 24)) break; }
        __builtin_amdgcn_fence(__ATOMIC_ACQUIRE, "agent"); asm volatile("s_waitcnt vmcnt(0)" ::: "memory");
    }
    __syncthreads();
}

__device__ __forceinline__ void p1_router_item(const Args& a, int it, int lane);
__device__ __forceinline__ void p1_dynamic(const Args& a, int lane) {
    const float* x = a.in[I_X]; const float* g = a.in[I_N1G]; const float* mod = (const float*)(a.ws + WS_MOD); bf16* h1 = (bf16*)(a.ws + WS_H1);
    constexpr int NIT = NB * NE + NTOK / 4;
    const int xq = blockIdx.x & 7, lo = (int)(((long)NIT * xq) >> 3), hi = (int)(((long)NIT * (xq + 1)) >> 3);
    unsigned* ctr = (unsigned*)(a.ws + WS_CTL) + CW_P1 + 64 * xq;
    for (;;) {
        int it0 = 0; if (lane == 0) it0 = (int)atomicAdd(ctr, 2u); it0 = __builtin_amdgcn_readfirstlane(it0) + lo;
        if (it0 >= hi) break;
#pragma unroll 1
        for (int it = it0; it < it0 + 2 && it < hi; ++it) {
        if (it < NB * NE) { p1_router_item(a, it, lane); continue; }
        const int m0 = (it - NB * NE) * 4;
        f32x4 v[4][4];
#pragma unroll
        for (int u = 0; u < 4; ++u)
#pragma unroll
            for (int j = 0; j < 4; ++j) v[u][j] = __builtin_nontemporal_load((const f32x4*)(x + (size_t)(m0 + u) * D) + lane + 64 * j);
#pragma unroll
        for (int u = 0; u < 4; ++u) {
            const int m = m0 + u, b = m >> 13; float s = 0.f;
#pragma unroll
            for (int j = 0; j < 4; ++j) s += (v[u][j].x * v[u][j].x + v[u][j].y * v[u][j].y) + (v[u][j].z * v[u][j].z + v[u][j].w * v[u][j].w);
            const float rstd = rsqrtf(wave_sum(s) * (1.f / D) + 1e-6f);
            unsigned long long* o8 = (unsigned long long*)(h1 + (size_t)m * D) + lane;
#pragma unroll
            for (int j = 0; j < 4; ++j) {
                const int k = 4 * lane + 256 * j;
                const f32x4 gg = *(const f32x4*)(g + k), sh = *(const f32x4*)(mod + b * 6 * D + k), sc = *(const f32x4*)(mod + b * 6 * D + D + k);
                const f32x4 h = v[u][j] * rstd * gg * (sc + 1.0f) + sh;
                o8[64 * j] = (unsigned long long)pk2(h.x, h.y) | ((unsigned long long)pk2(h.z, h.w) << 32);
            }
        }
        }
    }
}

__device__ __forceinline__ void unpack8(const v4u w, float (&f)[8]) {
    f[0] = bflo(w.x); f[1] = bfhi(w.x); f[2] = bflo(w.y); f[3] = bfhi(w.y); f[4] = bflo(w.z); f[5] = bfhi(w.z); f[6] = bflo(w.w); f[7] = bfhi(w.w);
}
__device__ __forceinline__ void p3e_conv(const Args& a, LAS float* sm, int lane) {
    constexpr int CT = 4;
    for (int i = threadIdx.x; i < CW * DCONV / 4; i += NTHR) { const int w = i >> 7, c4 = i & 127, ln = c4 >> 1, hf = c4 & 1;
        *(LAS f32x4*)(sm + ((w * 2 + hf) * 64 + ln) * 4) = *(const f32x4*)(a.in[I_CONVW] + w * DCONV + c4 * 4); }
    __syncthreads();
    const bf16* Z = (const bf16*)(a.ws + WS_Z); bf16* MRG = (bf16*)(a.ws + WS_MRG);
    const float* cw = a.in[I_CONVW]; const float* cb = a.in[I_CONVB]; const float* lng = a.in[I_LNG]; const float* lnb = a.in[I_LNB]; const float* ong = a.in[I_ONG];
    const int ch = lane * 8;
    const int xq = blockIdx.x & 7, ilo = (int)(((long)(NTOK / CT) * xq) >> 3), ihi = (int)(((long)(NTOK / CT) * (xq + 1)) >> 3);
    unsigned* ctr = (unsigned*)(a.ws + WS_CTL) + CW_CONVW + 64 * xq;
    for (;;) {
      int it0 = 0; if (lane == 0) it0 = (int)atomicAdd(ctr, 4u); it0 = __builtin_amdgcn_readfirstlane(it0) + ilo;
      if (it0 >= ihi) break;
#pragma unroll 1
      for (int it = it0; it < it0 + 4 && it < ihi; ++it) {
        const int t0 = it * CT, l0 = t0 & (SEQ - 1);
        int chw = ch; asm volatile("" : "+v"(chw));
        const unsigned zo = (unsigned)(((t0 - (CW - 1)) * DCONV + chw) * 2), wo = (unsigned)(chw * 4);
#define ZROW(j) (*(const v4u*)((const char*)Z + (unsigned)(zo + (unsigned)(j) * (DCONV * 2))))
#define WROW(w, q) (*(const LAS f32x4*)(sm + (((w) * 2 + (q)) * 64 + lane) * 4))
        f32x2 acc[CT][4];
        { const f32x4 b0 = *(const f32x4*)(cb + chw), b1 = *(const f32x4*)(cb + chw + 4);
#pragma unroll
          for (int i = 0; i < CT; ++i) { acc[i][0] = (f32x2){b0.x, b0.y}; acc[i][1] = (f32x2){b0.z, b0.w}; acc[i][2] = (f32x2){b1.x, b1.y}; acc[i][3] = (f32x2){b1.z, b1.w}; } }
        f32x2 act[CT][4]; v4u ring[8];
#pragma unroll
        for (int j = 0; j < CT + 8; ++j) { v4u r = (v4u){0u, 0u, 0u, 0u}; if (l0 - (CW - 1) + j >= 0) r = ZROW(j);
            if (j < CT) { act[j][0] = (f32x2){bflo(r.x), bfhi(r.x)}; act[j][1] = (f32x2){bflo(r.y), bfhi(r.y)}; act[j][2] = (f32x2){bflo(r.z), bfhi(r.z)}; act[j][3] = (f32x2){bflo(r.w), bfhi(r.w)}; } else ring[(j - CT) & 7] = r; }
#pragma nounroll
        for (int wq = 0; wq < 4; ++wq) {
#pragma unroll
            for (int r = 0; r < 8; ++r) {
                const int w = wq * 8 + r;
                if (w < CW) {
                    const f32x4 w0 = WROW(w, 0), w1 = WROW(w, 1);
                    const f32x2 wv[4] = {(f32x2){w0.x, w0.y}, (f32x2){w0.z, w0.w}, (f32x2){w1.x, w1.y}, (f32x2){w1.z, w1.w}};
#pragma unroll
                    for (int i = 0; i < CT; ++i) {
#pragma unroll
                        for (int c = 0; c < 4; ++c) acc[i][c] += act[(r + i) % CT][c] * wv[c];
                    }
                    if (w < CW - 1) {
                        const v4u rr = ring[r];
                        act[r % CT][0] = (f32x2){bflo(rr.x), bfhi(rr.x)}; act[r % CT][1] = (f32x2){bflo(rr.y), bfhi(rr.y)}; act[r % CT][2] = (f32x2){bflo(rr.z), bfhi(rr.z)}; act[r % CT][3] = (f32x2){bflo(rr.w), bfhi(rr.w)};
                        if (w + 8 < CW - 1) { const int j = w + CT + 8; ring[r] = (v4u){0u, 0u, 0u, 0u}; if (l0 - (CW - 1) + j >= 0) ring[r] = ZROW(j); }
                    }
                }
            }
        }
#undef ZROW
#undef WROW
        const f32x4 g0 = *(const f32x4*)(lng + chw), g1 = *(const f32x4*)(lng + chw + 4), be0 = *(const f32x4*)(lnb + chw), be1 = *(const f32x4*)(lnb + chw + 4);
        const f32x4 o0 = *(const f32x4*)(ong + DSSM + chw), o1 = *(const f32x4*)(ong + DSSM + chw + 4);
        const float gv[8] = {g0.x, g0.y, g0.z, g0.w, g1.x, g1.y, g1.z, g1.w}, bv[8] = {be0.x, be0.y, be0.z, be0.w, be1.x, be1.y, be1.z, be1.w};
        const float ov[8] = {o0.x, o0.y, o0.z, o0.w, o1.x, o1.y, o1.z, o1.w};
        float mean[CT], rstd[CT];
        { float s[CT];
#pragma unroll
          for (int i = 0; i < CT; ++i) { const f32x2 t = (acc[i][0] + acc[i][1]) + (acc[i][2] + acc[i][3]); s[i] = t.x + t.y; }
#pragma unroll
          for (int i = 0; i < CT; ++i) s[i] = wave_sum(s[i]);
#pragma unroll
          for (int i = 0; i < CT; ++i) mean[i] = s[i] * (1.f / DCONV);
          float q[CT];
#pragma unroll
          for (int i = 0; i < CT; ++i) { f32x2 t = {0.f, 0.f};
#pragma unroll
              for (int c = 0; c < 4; ++c) { const f32x2 d = acc[i][c] - mean[i]; t += d * d; }
              q[i] = t.x + t.y; }
#pragma unroll
          for (int i = 0; i < CT; ++i) q[i] = wave_sum(q[i]);
#pragma unroll
          for (int i = 0; i < CT; ++i) rstd[i] = rsqrtf(q[i] * (1.f / DCONV) + 1e-5f); }
        float ss[CT];
#pragma unroll
        for (int i = 0; i < CT; ++i) { f32x2 t = {0.f, 0.f};
#pragma unroll
            for (int c = 0; c < 4; ++c) { f32x2 v = (acc[i][c] - mean[i]) * rstd[i] * (f32x2){gv[2 * c], gv[2 * c + 1]} + (f32x2){bv[2 * c], bv[2 * c + 1]}; v.x = siluf_(v.x); v.y = siluf_(v.y); acc[i][c] = v; t += v * v; }
            ss[i] = t.x + t.y; }
#pragma unroll
        for (int i = 0; i < CT; ++i) ss[i] = wave_sum(ss[i]);
#pragma unroll
        for (int i = 0; i < CT; ++i) {
            const float r2 = rsqrtf(ss[i] * (1.f / DCONV) + 1e-6f);
            v4u o; o.x = pk2(acc[i][0].x * r2 * ov[0], acc[i][0].y * r2 * ov[1]); o.y = pk2(acc[i][1].x * r2 * ov[2], acc[i][1].y * r2 * ov[3]);
            o.z = pk2(acc[i][2].x * r2 * ov[4], acc[i][2].y * r2 * ov[5]); o.w = pk2(acc[i][3].x * r2 * ov[6], acc[i][3].y * r2 * ov[7]);
            *(v4u*)(MRG + (size_t)(t0 + i) * D + DSSM + chw) = o;
        }
      }
    }
}
__device__ __forceinline__ void p3e_norm(const Args& a, int gw, int ngw, int lane) {
    bf16* MRG = (bf16*)(a.ws + WS_MRG); const float* ong = a.in[I_ONG]; const int ch = lane * 8;
    const f32x4 o0 = *(const f32x4*)(ong + ch), o1 = *(const f32x4*)(ong + ch + 4);
    const float ov[8] = {o0.x, o0.y, o0.z, o0.w, o1.x, o1.y, o1.z, o1.w};
    v4u r[8];
#pragma unroll
    for (int u = 0; u < 8; ++u) { const int m = (gw + u * ngw < NTOK) ? gw + u * ngw : gw; r[u] = *(const v4u*)(MRG + (size_t)m * D + ch); }
    for (int m0 = gw; m0 < NTOK; m0 += 8 * ngw) {
        v4u c[8];
#pragma unroll
        for (int u = 0; u < 8; ++u) c[u] = r[u];
#pragma unroll
        for (int u = 0; u < 8; ++u) { const int mn = m0 + (8 + u) * ngw, m = (mn < NTOK) ? mn : gw; r[u] = *(const v4u*)(MRG + (size_t)m * D + ch); }
        asm volatile("" ::: "memory");
#pragma unroll
        for (int u = 0; u < 8; ++u) {
            const int m = m0 + u * ngw;
            if (m < NTOK) {
                float f[8]; unpack8(c[u], f);
                float ss = 0.f;
#pragma unroll
                for (int q = 0; q < 8; ++q) ss += f[q] * f[q];
                const float r2 = rsqrtf(wave_sum(ss) * (1.f / DSSM) + 1e-6f);
                v4u o; o.x = pk2(f[0] * r2 * ov[0], f[1] * r2 * ov[1]); o.y = pk2(f[2] * r2 * ov[2], f[3] * r2 * ov[3]);
                o.z = pk2(f[4] * r2 * ov[4], f[5] * r2 * ov[5]); o.w = pk2(f[6] * r2 * ov[6], f[7] * r2 * ov[7]);
                *(v4u*)(MRG + (size_t)m * D + ch) = o;
            }
        }
        asm volatile("" ::: "memory");
    }
}

__device__ __forceinline__ void moe_tables(const Args& a, LAS int* T) {
    const unsigned* cnt = (const unsigned*)(a.ws + WS_CTL) + CW_CNT;
    if (threadIdx.x < 32) T[threadIdx.x] = (int)__hip_atomic_load(cnt + 32 * threadIdx.x, __ATOMIC_RELAXED, __HIP_MEMORY_SCOPE_AGENT);
    __syncthreads();
    if (threadIdx.x == 0) { int rb = 0, t64 = 0, t256 = 0;
        for (int e = 0; e < NE; ++e) { T[32 + e] = rb; T[65 + e] = t64; T[98 + e] = t256; const int c = T[e]; rb += c; t64 += (c + 63) >> 6; t256 += (c + 255) >> 8; }
        T[32 + NE] = rb; T[65 + NE] = t64; T[98 + NE] = t256; }
    __syncthreads();
    for (int t = threadIdx.x; t < 640; t += NTHR) { int e = 0;
#pragma unroll 4
        for (int q = 1; q < NE; ++q) if (T[98 + q] <= t) e = q;
        T[1280 + t] = e; }
    __syncthreads();
}

__device__ __forceinline__ bf16* ys_ptr(const Args& a, int tok, int k) {
    if (k == 0) return (bf16*)(a.out + (size_t)tok * D);
    if (k == 3) return (bf16*)(a.ws + WS_YS3) + (size_t)tok * D;
    return (bf16*)(a.ws + WS_YS12) + ((size_t)(k - 1) * NTOK + tok) * D;
}

#if YS_F8
typedef v2u ys8_t;
__device__ __forceinline__ void unpack_ys(const ys8_t w, float (&f)[8]) {
    const f32x2 a = __builtin_amdgcn_cvt_pk_f32_fp8(w.x, false), b = __builtin_amdgcn_cvt_pk_f32_fp8(w.x, true), c = __builtin_amdgcn_cvt_pk_f32_fp8(w.y, false), d = __builtin_amdgcn_cvt_pk_f32_fp8(w.y, true);
    f[0] = a.x; f[1] = a.y; f[2] = b.x; f[3] = b.y; f[4] = c.x; f[5] = c.y; f[6] = d.x; f[7] = d.y; }
__device__ __forceinline__ ys8_t load_ys(const Args& a, int tok, int k, int ch) {
    const unsigned char* p = (k == 0) ? (const unsigned char*)(a.out + (size_t)tok * D) : (k == 3) ? (a.ws + WS_YS3) + (size_t)tok * D : (a.ws + WS_YS12) + ((size_t)(k - 1) * NTOK + tok) * D;
    return __builtin_nontemporal_load((const ys8_t*)(p + ch)); }
#else
typedef v4u ys8_t;
__device__ __forceinline__ void unpack_ys(const ys8_t w, float (&f)[8]) { unpack8(w, f); }
__device__ __forceinline__ ys8_t load_ys(const Args& a, int tok, int k, int ch) { return *(const ys8_t*)(ys_ptr(a, tok, k) + ch); }
#endif
struct P9Ld { v4u x[2]; ys8_t y[4][2]; f32x4 w; };
__device__ __forceinline__ P9Ld p9_load(const Args& a, int tok, int lane) {
    P9Ld r; r.w = *(const f32x4*)((const float*)(a.ws + WS_TOPW) + tok * 4);
#pragma unroll
    for (int q = 0; q < 2; ++q) {
        const int ch = lane * 8 + 512 * q;
        r.x[q] = __builtin_nontemporal_load((const v4u*)((const bf16*)(a.out + (size_t)tok * D) + D + ch));
#pragma unroll
        for (int k = 0; k < 4; ++k) r.y[k][q] = load_ys(a, tok, k, ch);
    }
    return r;
}
__device__ __forceinline__ void p9_token(const Args& a, const P9Ld& r, int tok, int lane) {
    const float* mod = (const float*)(a.ws + WS_MOD); const float* fg = a.in[I_FG];
    const int b = tok >> 13;
    float xo[2][8], ss = 0.f;
#pragma unroll
    for (int q = 0; q < 2; ++q) {
        const int ch = lane * 8 + 512 * q;
        float x1[8], y0[8], y1[8], y2[8], y3[8];
        unpack8(r.x[q], x1); unpack_ys(r.y[0][q], y0); unpack_ys(r.y[1][q], y1); unpack_ys(r.y[2][q], y2); unpack_ys(r.y[3][q], y3);
        const f32x4 g0 = *(const f32x4*)(mod + b * 6 * D + 5 * D + ch), g1 = *(const f32x4*)(mod + b * 6 * D + 5 * D + ch + 4);
        const float g2[8] = {g0.x, g0.y, g0.z, g0.w, g1.x, g1.y, g1.z, g1.w};
#pragma unroll
        for (int c = 0; c < 8; ++c) { xo[q][c] = x1[c] + g2[c] * (((r.w.x * y0[c] + r.w.y * y1[c]) + r.w.z * y2[c]) + r.w.w * y3[c]); ss += xo[q][c] * xo[q][c]; }
    }
    const float rstd = rsqrtf(wave_sum(ss) * (1.f / D) + 1e-6f);
#pragma unroll
    for (int q = 0; q < 2; ++q) {
        const int ch = lane * 8 + 512 * q;
        const f32x4 f0 = *(const f32x4*)(fg + ch), f1 = *(const f32x4*)(fg + ch + 4);
        f32x4 o0, o1;
        o0.x = xo[q][0] * rstd * f0.x; o0.y = xo[q][1] * rstd * f0.y; o0.z = xo[q][2] * rstd * f0.z; o0.w = xo[q][3] * rstd * f0.w;
        o1.x = xo[q][4] * rstd * f1.x; o1.y = xo[q][5] * rstd * f1.y; o1.z = xo[q][6] * rstd * f1.z; o1.w = xo[q][7] * rstd * f1.w;
        f32x4* op = (f32x4*)(a.out + (size_t)tok * D + ch);
        __builtin_nontemporal_store(o0, op); __builtin_nontemporal_store(o1, op + 1);
    }
}
__device__ __forceinline__ void p9_final(const Args& a, int gw, int ngw, int lane) {
    P9Ld r0 = p9_load(a, gw < NTOK ? gw : 0, lane), r1 = p9_load(a, gw + ngw < NTOK ? gw + ngw : 0, lane);
    for (int tok = gw; tok < NTOK; tok += 2 * ngw) {
        { const P9Ld cu = r0; const int tn = tok + 2 * ngw; r0 = p9_load(a, tn < NTOK ? tn : tok, lane);
          asm volatile("" ::: "memory"); p9_token(a, cu, tok, lane); asm volatile("" ::: "memory"); }
        if (tok + ngw < NTOK) { const P9Ld cu = r1; const int tn = tok + 3 * ngw; r1 = p9_load(a, tn < NTOK ? tn : tok + ngw, lane);
          asm volatile("" ::: "memory"); p9_token(a, cu, tok + ngw, lane); asm volatile("" ::: "memory"); }
    }
}

namespace pg8 {
constexpr int BM = 256, BK = 64, HALF = 128, HTB = HALF * BK * 2  , STAGE_BYTES = 8 * HTB, NXCD = 8, WGM = 8;
__host__ __device__ __forceinline__ int lds_byte(int r, int c) { const int st = (r >> 4) * 2 + (c >> 5), rr = r & 15, cc = c & 31, ob = rr * 64 + cc * 2; return st * 1024 + (ob ^ (((ob >> 9) & 1) << 5)); }
__host__ __device__ __forceinline__ void stage_rc(int b, int& R, int& C) { const int st = b / 1024, sb = b % 1024, swz = sb ^ (((sb >> 9) & 1) << 5); R = (st >> 1) * 16 + swz / 64; C = (st & 1) * 32 + (swz % 64) / 2; }
__host__ __device__ __forceinline__ int perm32(int rho) { const int n = rho >> 4, i = rho & 15; return 8 * (i >> 2) + 4 * n + (i & 3); }
struct Unit { int pm, pn, e, row0, slot0, nvalid; };
typedef int v8i __attribute__((ext_vector_type(8)));
__device__ __forceinline__ v8i cat8(const bf16x8 lo, const bf16x8 hi) { typedef int v4i __attribute__((ext_vector_type(4))); const v4i a = __builtin_bit_cast(v4i, lo), b = __builtin_bit_cast(v4i, hi); return (v8i){a[0], a[1], a[2], a[3], b[0], b[1], b[2], b[3]}; }
__device__ __forceinline__ bf16x8 lo8(const v8i v) { typedef int v4i __attribute__((ext_vector_type(4))); return __builtin_bit_cast(bf16x8, __builtin_shufflevector(v, v, 0, 1, 2, 3)); }
__device__ __forceinline__ bf16x8 hi8(const v8i v) { typedef int v4i __attribute__((ext_vector_type(4))); return __builtin_bit_cast(bf16x8, __builtin_shufflevector(v, v, 4, 5, 6, 7)); }
__device__ __forceinline__ unsigned cvt_pk_bf16(float lo, float hi) { unsigned r; asm volatile("v_cvt_pk_bf16_f32 %0, %1, %2" : "=v"(r) : "v"(lo), "v"(hi)); return r; }

template <class Epi, class Sched, bool ALIGN_EPI, bool F8 = false>
__device__ __forceinline__ void gemm_phase(LAS unsigned char* lds, const Sched& S, const Epi& E) {
    const int tid = threadIdx.x, wid = __builtin_amdgcn_readfirstlane(tid >> 6), lane = tid & 63, wr = wid >> 2, wc = wid & 3, fr = lane & 15, fq = lane >> 4;
    constexpr int EB = F8 ? 1 : 2;
    const int nt = S.K / (128 / EB);
    int R[2], C[2]; unsigned voffB[2];
#pragma unroll
    for (int i = 0; i < 2; ++i) { stage_rc(tid * 16 + i * 8192, R[i], C[i]); const int Rb = Epi::PERM ? ((R[i] & ~31) + perm32(R[i] & 31)) : R[i]; voffB[i] = (unsigned)(Rb * S.ldb * EB + C[i] * 2); }
    const size_t kstep = (size_t)(BK * 2);
    const size_t bhstep = (size_t)HALF * S.ldb * EB;
    const unsigned ldsw = (unsigned)wid * 1024u;
    const int aoff = lds_byte(wr * 64 + fr, fq * 8), boff = lds_byte(wc * 32 + fr, fq * 8);
#define PG8_SA(b, h) (((b) * 2 + (h)) * HTB)
#define PG8_SB(b, h) ((4 + (b) * 2 + (h)) * HTB)
#define PG8_STAGE(bufoff, gbase, voff) do { _Pragma("unroll") for (int _i = 0; _i < 2; ++_i) \
        __builtin_amdgcn_global_load_lds((const unsigned*)((const char*)(gbase) + (voff)[_i]), (LAS unsigned*)(lds + (bufoff) + ldsw + _i * 8192), 16, 0, 0); } while (0)
#define PG8_LDA(dst, b, h) do { _Pragma("unroll") for (int m = 0; m < 4; ++m) dst[m] = cat8(*(const LAS bf16x8*)(lds + PG8_SA(b, h) + aoff + m * 2048), *(const LAS bf16x8*)(lds + PG8_SA(b, h) + aoff + m * 2048 + 1024)); } while (0)
#define PG8_LDB(dst, b, h) do { _Pragma("unroll") for (int n = 0; n < 2; ++n) dst[n] = cat8(*(const LAS bf16x8*)(lds + PG8_SB(b, h) + boff + n * 2048), *(const LAS bf16x8*)(lds + PG8_SB(b, h) + boff + n * 2048 + 1024)); } while (0)
#define PG8_MMA(ai, bj, At, Bt) do { __builtin_amdgcn_s_setprio(1); _Pragma("unroll") for (int m = 0; m < 4; ++m) _Pragma("unroll") for (int n = 0; n < 2; ++n) { \
        if constexpr (F8) { asm volatile("v_mfma_scale_f32_16x16x128_f8f6f4 %0, %1, %2, %0, %3, %4 op_sel_hi:[0,0,0]" : "+v"(acc[ai][bj][m][n]) : "v"(Bt[n]), "v"(At[m]), "v"(f8sb), "v"(f8sa)); } \
        else { acc[ai][bj][m][n] = __builtin_amdgcn_mfma_f32_16x16x32_bf16(lo8(Bt[n]), lo8(At[m]), acc[ai][bj][m][n], 0, 0, 0); acc[ai][bj][m][n] = __builtin_amdgcn_mfma_f32_16x16x32_bf16(hi8(Bt[n]), hi8(At[m]), acc[ai][bj][m][n], 0, 0, 0); } } \
        __builtin_amdgcn_s_setprio(0); } while (0)
#define PG8_WAIT_V(n) asm volatile("s_waitcnt vmcnt(" #n ")" ::: "memory")
#define PG8_WAIT_L(n) asm volatile("s_waitcnt lgkmcnt(" #n ")" ::: "memory")
#define PG8_BAR __builtin_amdgcn_s_barrier()
#define PG8_SCHED __builtin_amdgcn_sched_barrier(0)
    Unit cur, nxt; int ui = 0; cur.e = 0;
    if (!S.next(0, cur)) return;
    nxt = cur;
    f32x4 acc[2][2][4][2];
#pragma unroll
    for (int a = 0; a < 2; ++a)
#pragma unroll
        for (int b = 0; b < 2; ++b)
#pragma unroll
            for (int m = 0; m < 4; ++m)
#pragma unroll
                for (int n = 0; n < 2; ++n) acc[a][b][m][n] = (f32x4){0.f, 0.f, 0.f, 0.f};
    const int f8sa = S.scale_a, f8sb = S.scale_b;
    v8i At[4], B0[2], B1[2];
    unsigned ao[2][2], an[2][2];
    S.a_offsets(cur, R, C, ao);
    const char* cA = S.a_base(cur); const char* cB = S.b_base(cur);
    PG8_STAGE(PG8_SB(0, 0), cB, voffB); PG8_STAGE(PG8_SB(0, 1), cB + bhstep, voffB); PG8_STAGE(PG8_SA(0, 0), cA, ao[0]); PG8_STAGE(PG8_SA(0, 1), cA, ao[1]);
    if (wr == 1) PG8_BAR;
    PG8_WAIT_V(2); PG8_BAR;
    PG8_STAGE(PG8_SB(1, 0), cB + kstep, voffB); PG8_STAGE(PG8_SA(1, 0), cA + kstep, ao[0]); PG8_STAGE(PG8_SB(1, 1), cB + bhstep + kstep, voffB);
    PG8_WAIT_V(6); PG8_BAR;
#if TIME_PHASE >= 0
    unsigned long long tk0 = 0, tk1 = 0, tacc_k = 0, tacc_e = 0;
#endif
    for (;;) {
#if TIME_PHASE >= 0
        if (S.tstamp) tk0 = __builtin_amdgcn_s_memrealtime();
#endif
        const bool has_next = S.next(ui + 1, nxt);
        const char* nA = cA; const char* nB = cB;
#pragma unroll
        for (int h = 0; h < 2; ++h)
#pragma unroll
            for (int i = 0; i < 2; ++i) an[h][i] = ao[h][i];
        if (has_next) { nA = S.a_base(nxt); nB = S.b_base(nxt); S.a_offsets(nxt, R, C, an); }
        for (int t = 0; t < nt; t += 2) {
            const bool last = (t == nt - 2);
            const char* a1 = cA + (size_t)(t + 1) * kstep;
            const char* a2 = last ? nA : cA + (size_t)(t + 2) * kstep; const char* b2 = last ? nB : cB + (size_t)(t + 2) * kstep;
            const char* a3 = a2 + kstep; const char* b3 = b2 + kstep;
            unsigned o2[2][2];
#pragma unroll
            for (int h = 0; h < 2; ++h)
#pragma unroll
                for (int i = 0; i < 2; ++i) o2[h][i] = last ? an[h][i] : ao[h][i];
            PG8_LDB(B0, 0, 0); PG8_LDB(B1, 0, 1); PG8_SCHED; PG8_LDA(At, 0, 0); PG8_STAGE(PG8_SA(1, 1), a1, ao[1]);
            PG8_WAIT_V(8); PG8_WAIT_L(0); PG8_BAR; PG8_MMA(0, 0, At, B0); PG8_MMA(0, 1, At, B1); PG8_BAR; PG8_SCHED;
            PG8_LDA(At, 0, 1); PG8_STAGE(PG8_SB(0, 0), b2, voffB); PG8_STAGE(PG8_SB(0, 1), b2 + bhstep, voffB); PG8_STAGE(PG8_SA(0, 0), a2, o2[0]);
            PG8_WAIT_V(8); PG8_WAIT_L(0); PG8_BAR; PG8_MMA(1, 0, At, B0); PG8_MMA(1, 1, At, B1); PG8_BAR; PG8_SCHED;
            PG8_LDB(B0, 1, 0); PG8_LDB(B1, 1, 1); PG8_SCHED; PG8_LDA(At, 1, 0); PG8_STAGE(PG8_SA(0, 1), a2, o2[1]);
            PG8_WAIT_V(8); PG8_WAIT_L(0); PG8_BAR; PG8_MMA(0, 0, At, B0); PG8_MMA(0, 1, At, B1); PG8_BAR; PG8_SCHED;
            PG8_LDA(At, 1, 1); PG8_STAGE(PG8_SB(1, 0), b3, voffB); PG8_STAGE(PG8_SB(1, 1), b3 + bhstep, voffB); PG8_STAGE(PG8_SA(1, 0), a3, o2[0]);
            PG8_WAIT_V(8); PG8_WAIT_L(0); PG8_BAR; PG8_MMA(1, 0, At, B0); PG8_MMA(1, 1, At, B1); PG8_BAR; PG8_SCHED;
        }
#if TIME_PHASE >= 0
        if (S.tstamp) { tk1 = __builtin_amdgcn_s_memrealtime(); tacc_k += tk1 - tk0; }
#endif
        if constexpr (ALIGN_EPI) { if (wr == 0) PG8_BAR; }
        if constexpr (F8) { asm volatile("s_nop 15\n\ts_nop 15" ::: "memory"); }
        E(acc, cur, wr, wc, fr, fq);
        if (S.rep_epi) { asm volatile("" ::: "memory"); E(acc, cur, wr, wc, fr, fq); }
#if TIME_PHASE >= 0
        if (S.tstamp) { tacc_e += __builtin_amdgcn_s_memrealtime() - tk1; }
#endif
        if (!has_next) break;
#pragma unroll
        for (int a = 0; a < 2; ++a)
#pragma unroll
            for (int b = 0; b < 2; ++b)
#pragma unroll
                for (int m = 0; m < 4; ++m)
#pragma unroll
                    for (int n = 0; n < 2; ++n) acc[a][b][m][n] = (f32x4){0.f, 0.f, 0.f, 0.f};
        cur = nxt; cA = nA; cB = nB; ++ui;
#pragma unroll
        for (int h = 0; h < 2; ++h)
#pragma unroll
            for (int i = 0; i < 2; ++i) ao[h][i] = an[h][i];
        if constexpr (ALIGN_EPI) { if (wr == 1) PG8_BAR; }
    }
    PG8_WAIT_V(0);
    if constexpr (!ALIGN_EPI) { if (wr == 0) PG8_BAR; }
    PG8_BAR;
#if TIME_PHASE >= 0
    if (S.tstamp && threadIdx.x == 0) { LAS unsigned long long* TSg = (LAS unsigned long long*)(lds + 131072 + 4096); TSg[24] = 0; TSg[25] = tacc_k; TSg[26] = tacc_k + tacc_e; }
#endif
#undef PG8_SA
#undef PG8_SB
#undef PG8_STAGE
#undef PG8_LDA
#undef PG8_LDB
#undef PG8_MMA
#undef PG8_WAIT_V
#undef PG8_WAIT_L
#undef PG8_BAR
#undef PG8_SCHED
}

struct SchedDense {
    static constexpr int scale_a = 127, scale_b = 127, rep_epi = 0;
    const bf16* A; const bf16* Bt; int K, lda, ldb; int nM, nN, nwg, G, c, rep, tstamp = 0;
    __device__ __forceinline__ void init(const bf16* A_, const bf16* Bt_, int M, int N, int K_, int lda_, int ldb_, int G_, int c_, int rep_ = 1) { A = A_; Bt = Bt_; K = K_; lda = lda_; ldb = ldb_; nM = M / BM; nN = N / BM; nwg = nM * nN; G = G_; c = c_; rep = rep_; }
    __device__ __forceinline__ bool next(int i, Unit& u) const {
        const long L = (long)(i / rep) * G + c; if (L >= nwg) return false;
        int wgid = (int)L; { const int q = nwg / NXCD, r = nwg % NXCD, xcd = wgid % NXCD, off = wgid / NXCD; wgid = (xcd < r ? xcd * (q + 1) : r * (q + 1) + (xcd - r) * q) + off; }
        const int nig = WGM * nN, gid = wgid / nig, fm = gid * WGM, gsz = (nM - fm) < WGM ? (nM - fm) : WGM;
        u.pm = fm + ((wgid % nig) % gsz); u.pn = (wgid % nig) / gsz; u.e = 0; u.row0 = u.pm * BM; u.slot0 = 0; u.nvalid = BM; return true;
    }
    __device__ __forceinline__ const char* a_base(const Unit& u) const { return (const char*)A + (size_t)u.pm * BM * lda * 2; }
    __device__ __forceinline__ const char* b_base(const Unit& u) const { return (const char*)Bt + (size_t)u.pn * BM * ldb * 2; }
    __device__ __forceinline__ void a_offsets(const Unit&, const int (&R)[2], const int (&C)[2], unsigned (&off)[2][2]) const {
#pragma unroll
        for (int h = 0; h < 2; ++h)
#pragma unroll
            for (int i = 0; i < 2; ++i) off[h][i] = (unsigned)((R[i] + HALF * h) * lda + C[i]) * 2u;
    }
};
struct SchedGroup {
    static constexpr int scale_a = 127, scale_b = 127, rep_epi = 0, tstamp = 0;
    const bf16* A; const bf16* Bt; int K, lda, ldb; int nM, nN, ng, G, c; size_t astride, bstride; int rep, nmax;
    __device__ __forceinline__ bool next(int i, Unit& u) const {
        const int L = (i / rep) * G + c; if (L >= ng * nM * nN || i >= nmax) return false;
        const int g = L / (nM * nN), rem = L % (nM * nN);
        u.e = g; u.pm = rem % nM; u.pn = rem / nM; u.row0 = u.pm * BM; u.slot0 = 0; u.nvalid = BM; return true;
    }
    __device__ __forceinline__ const char* a_base(const Unit& u) const { return (const char*)(A + (size_t)u.e * astride) + (size_t)u.pm * BM * lda * 2; }
    __device__ __forceinline__ const char* b_base(const Unit& u) const { return (const char*)(Bt + (size_t)u.e * bstride) + (size_t)u.pn * BM * ldb * 2; }
    __device__ __forceinline__ void a_offsets(const Unit&, const int (&R)[2], const int (&C)[2], unsigned (&off)[2][2]) const {
#pragma unroll
        for (int h = 0; h < 2; ++h)
#pragma unroll
            for (int i = 0; i < 2; ++i) off[h][i] = (unsigned)((R[i] + HALF * h) * lda + C[i]) * 2u;
    }
};
}

__device__ __forceinline__ unsigned pk_fp8x4(float a, float b, float c, float d) { unsigned r = __builtin_amdgcn_cvt_pk_fp8_f32(a, b, 0u, false); return __builtin_amdgcn_cvt_pk_fp8_f32(c, d, r, true); }
struct TItem { const float* W; unsigned char* WT; int K, N, k0, n0, drow0, f8, perm; };
__device__ __forceinline__ int wd_perm_row(int c) { return (c & ~255) + ((c >> 3) & 1) * 128 + ((c >> 6) & 3) * 32 + ((c >> 4) & 3) * 8 + (c & 7); }
__device__ __forceinline__ void titem_load(const TItem& t, int lane, f32x4 (&v)[8]) {
    const float* p = t.W + (size_t)(t.k0 + 8 * (lane >> 3)) * t.N + t.n0 + 4 * (lane & 7);
#pragma unroll
    for (int i = 0; i < 8; ++i) v[i] = __builtin_nontemporal_load((const f32x4*)(p + (size_t)i * t.N));
}
__device__ __forceinline__ void titem_store(const TItem& t, int lane, const f32x4 (&v)[8], float f8scale) {
    const int n4 = lane & 7, kb = lane >> 3;
#pragma unroll
    for (int j = 0; j < 4; ++j) {
        const int cc = 4 * n4 + j;
        const size_t row = (size_t)(t.perm == 1 ? wd_perm_row(t.drow0 + cc) : t.perm == 2 ? t.drow0 + 8 * ((((cc >> 3) & 1) << 1) | (cc >> 4)) + (cc & 7) : t.drow0 + cc);
        if (t.f8) { v2u o; o.x = pk_fp8x4(v[0][j] * f8scale, v[1][j] * f8scale, v[2][j] * f8scale, v[3][j] * f8scale); o.y = pk_fp8x4(v[4][j] * f8scale, v[5][j] * f8scale, v[6][j] * f8scale, v[7][j] * f8scale);
            *(v2u*)(t.WT + row * t.K + t.k0 + 8 * kb) = o; }
        else { v4u o; o.x = pk2(v[0][j], v[1][j]); o.y = pk2(v[2][j], v[3][j]); o.z = pk2(v[4][j], v[5][j]); o.w = pk2(v[6][j], v[7][j]);
            *(v4u*)(t.WT + (row * t.K + t.k0 + 8 * kb) * 2) = o; }
    }
}
constexpr float WGU_F8_SCALE = 32.0f;
__device__ __forceinline__ TItem p0_item(const Args& a, int it) {
    constexpr int I_IN = 16 * 48, I_GLU = 8 * 16, I_OUT = 16 * 32, I_EXP = 16 * 32;
    TItem t; t.f8 = 0; t.perm = 0; int r = it;
    if (r < I_IN) { const int kb = r / 48, nb = r % 48, n0 = nb * 32; int drow;
        if (n0 < 512) drow = n0; else if (n0 < 1024) { const int j = n0 - 512; drow = 512 + (j >> 7) * 256 + (j & 127); } else { const int j = n0 - 1024; drow = 512 + (j >> 7) * 256 + 128 + (j & 127); }
        t.W = a.in[I_WIN]; t.WT = a.ws + WS_WIN; t.K = D; t.N = DIN; t.k0 = kb * 64; t.n0 = n0; t.drow0 = drow; return t; } r -= I_IN;
    if (r < I_GLU) { const int kb = r / 16, nb = r % 16; t.W = a.in[I_WGLU]; t.WT = a.ws + WS_WGLU; t.K = DSSM; t.N = DSSM; t.k0 = kb * 64; t.n0 = nb * 32; t.drow0 = nb * 32; return t; } r -= I_GLU;
    if (r < I_OUT) { const int kb = r / 32, nb = r % 32; t.W = a.in[I_WOUT]; t.WT = a.ws + WS_WOUT; t.K = D; t.N = D; t.k0 = kb * 64; t.n0 = nb * 32; t.drow0 = nb * 32; return t; } r -= I_OUT;
    const int e = r / (3 * I_EXP), q = r % (3 * I_EXP), which = q / I_EXP, sidx = q % I_EXP, kb = sidx / 32, nb = sidx % 32, n0 = nb * 32;
    t.K = D; t.N = FF; t.k0 = kb * 64; t.n0 = n0;
    if (which == 0) { t.W = a.in[I_WG] + (size_t)e * D * FF; t.WT = a.ws + WS_WGU + (size_t)e * 2048 * D * (MOE1_F8 ? 1 : 2); t.drow0 = (n0 >> 7) * 256 + (n0 & 127); t.f8 = MOE1_F8; t.perm = MOE1_WIDE ? 2 : 0; }
    else if (which == 1) { t.W = a.in[I_WU] + (size_t)e * D * FF; t.WT = a.ws + WS_WGU + (size_t)e * 2048 * D * (MOE1_F8 ? 1 : 2); t.drow0 = (n0 >> 7) * 256 + 128 + (n0 & 127); t.f8 = MOE1_F8; t.perm = MOE1_WIDE ? 2 : 0; }
    else { t.W = a.in[I_WD] + (size_t)e * FF * D; t.WT = a.ws + WS_WD + (size_t)e * D * FF * (MOE2_F8 ? 1 : 2); t.drow0 = n0; t.f8 = MOE2_F8; t.perm = MOE2_WIDE; }
    return t;
}
__device__ __forceinline__ void p0_convert(const Args& a, int gw, int ngw, int lane) {
    constexpr int NITEMS = 16 * 48 + 8 * 16 + 16 * 32 + 3 * NE * 16 * 32;
    const int x = blockIdx.x & 7, lo = (int)(((long)NITEMS * x) >> 3), hi = (int)(((long)NITEMS * (x + 1)) >> 3);
    unsigned* ctr = (unsigned*)(a.ws + WS_CTL) + CW_CONV + 64 * x;
    int it = 0, nleft = 0;
    auto grab = [&]() { if (nleft == 0) { int g0 = 0; if (lane == 0) g0 = (int)atomicAdd(ctr, 8u); it = __builtin_amdgcn_readfirstlane(g0) + lo; nleft = 8; } };
    grab();
    bool have = it < hi; TItem c0{}, c1{}; bool ctwo = false; f32x4 v0[8], v1[8];
    if (have) { c0 = p0_item(a, it); ctwo = it + 1 < hi; c1 = p0_item(a, ctwo ? it + 1 : it); titem_load(c0, lane, v0); titem_load(c1, lane, v1); it += 2; nleft -= 2; }
    while (have) {
        grab();
        const bool hn = it < hi; TItem n0{}, n1{}; bool ntwo = false; f32x4 w0[8], w1[8];
        if (hn) { n0 = p0_item(a, it); ntwo = it + 1 < hi; n1 = p0_item(a, ntwo ? it + 1 : it); titem_load(n0, lane, w0); titem_load(n1, lane, w1); it += 2; nleft -= 2; }
        asm volatile("" ::: "memory");
        titem_store(c0, lane, v0, WGU_F8_SCALE);
        if (ctwo) titem_store(c1, lane, v1, WGU_F8_SCALE);
        asm volatile("" ::: "memory");
        have = hn; c0 = n0; c1 = n1; ctwo = ntwo;
#pragma unroll
        for (int i = 0; i < 8; ++i) { v0[i] = w0[i]; v1[i] = w1[i]; }
    }
}
__device__ __forceinline__ void p0_s5_mats(const Args& a, LAS float* sm) {
    LAS float* Ptau = sm; LAS float* Pt1 = sm + 128; LAS float* Ps = sm + 256; LAS float* LD = sm + 384;
    LAS float* Bb = sm + 512; LAS float* Kt = sm + 512 + 2048; LAS float* Cs = sm + 512 + 2048 + 256;
    bf16* BTS = (bf16*)(a.ws + WS_BTS); bf16* BTY = (bf16*)(a.ws + WS_BTY);
    const int t = threadIdx.x;
    for (int it0 = blockIdx.x * 4; it0 < NG * TCH; it0 += gridDim.x * 4) {
        const int g = it0 >> 5;
        if (t < 64) {
            const int p = t;
            const float lr = a.in[I_LRE][g * NP + p], li = a.in[I_LIM][g * NP + p], dt = expf(a.in[I_LDT][g]);
            const float mag = expf(lr * dt); float sn, cs; sincosf(li * dt, &sn, &cs);
            const float ar = mag * cs, ai = mag * sn, den = lr * lr + li * li, nr = ar - 1.f;
            const float qr = (nr * lr + ai * li) / den, qi = (ai * lr - nr * li) / den;
            LD[2 * p] = lr * dt; LD[2 * p + 1] = li * dt;
#pragma unroll
            for (int h = 0; h < 16; ++h) {
                const float br = a.in[I_BRE][(g * NP + p) * GH + h], bi = a.in[I_BIM][(g * NP + p) * GH + h];
                Bb[(p * 16 + h) * 2] = qr * br - qi * bi; Bb[(p * 16 + h) * 2 + 1] = qr * bi + qi * br;
            }
        }
        for (int i = t; i < GH * NP; i += NTHR) { Cs[2 * i] = a.in[I_CRE][g * GH * NP + i]; Cs[2 * i + 1] = a.in[I_CIM][g * GH * NP + i]; }
        __syncthreads();
        for (int tau = it0 & 31; tau < (it0 & 31) + 4; ++tau) {
        if (t < 192) {
            const int p = t & 63, which = t >> 6; const float e = which == 0 ? (float)tau : which == 1 ? (float)(tau + 1) : (float)(31 - tau);
            const float m = expf(e * LD[2 * p]); float s2, c2; sincosf(e * LD[2 * p + 1], &s2, &c2);
            LAS float* dst = which == 0 ? Ptau : which == 1 ? Pt1 : Ps; dst[2 * p] = m * c2; dst[2 * p + 1] = m * s2;
        }
        __syncthreads();
        if (t < 256) {
            const int h = t >> 4, h2 = t & 15; float s = 0.f;
#pragma unroll 8
            for (int p = 0; p < NP; ++p) {
                const float cr = Cs[(h * NP + p) * 2], ci = Cs[(h * NP + p) * 2 + 1];
                const float pr = Ptau[2 * p], pi = Ptau[2 * p + 1], br = Bb[(p * 16 + h2) * 2], bi = Bb[(p * 16 + h2) * 2 + 1];
                const float xr = pr * br - pi * bi, xi = pr * bi + pi * br;
                s += cr * xr - ci * xi;
            }
            if (tau == 0 && h == h2) s += a.in[I_DSK][g * GH + h];
            Kt[t] = s;
        }
        __syncthreads();
        bf16* by = BTY + (size_t)g * 512 * U2G;
        for (int idx = t; idx < (TCH - tau) * 32; idx += NTHR) {
            const int j = idx >> 5, h = (idx >> 1) & 15, half = idx & 1, tt = tau + j, sidx = j;
            const LAS float* k = Kt + h * 16 + half * 8;
            v4u o; o.x = pk2(k[0], k[1]); o.y = pk2(k[2], k[3]); o.z = pk2(k[4], k[5]); o.w = pk2(k[6], k[7]);
            *(v4u*)(by + (size_t)(tt * 16 + h) * U2G + sidx * 16 + half * 8) = o;
        }
        if (tau >= 1) for (int idx = t; idx < (TCH - tau) * 32; idx += NTHR) {
            const int j = idx >> 5, h = (idx >> 1) & 15, half = idx & 1, tt = j, sidx = tau + j;
            *(v4u*)(by + (size_t)(tt * 16 + h) * U2G + sidx * 16 + half * 8) = (v4u){0u, 0u, 0u, 0u};
        }
        if (t < 256) {
            const int h = t >> 4, piece = t & 15; float v[8];
#pragma unroll
            for (int q = 0; q < 8; ++q) { const int pp = piece * 8 + q, p = pp & 63;
                const float cr = Cs[(h * NP + p) * 2], ci = Cs[(h * NP + p) * 2 + 1], pr = Pt1[2 * p], pi = Pt1[2 * p + 1];
                v[q] = (pp < 64) ? (cr * pr - ci * pi) : -(cr * pi + ci * pr); }
            v4u o; o.x = pk2(v[0], v[1]); o.y = pk2(v[2], v[3]); o.z = pk2(v[4], v[5]); o.w = pk2(v[6], v[7]);
            *(v4u*)(by + (size_t)(tau * 16 + h) * U2G + 512 + piece * 8) = o;
        } else {
            const int u = t - 256, n = u >> 1, half = u & 1, p = n & 63; float v[8];
#pragma unroll
            for (int q = 0; q < 8; ++q) { const int h = half * 8 + q; const float pr = Ps[2 * p], pi = Ps[2 * p + 1], br = Bb[(p * 16 + h) * 2], bi = Bb[(p * 16 + h) * 2 + 1];
                v[q] = (n < 64) ? (pr * br - pi * bi) : (pr * bi + pi * br); }
            v4u o; o.x = pk2(v[0], v[1]); o.y = pk2(v[2], v[3]); o.z = pk2(v[4], v[5]); o.w = pk2(v[6], v[7]);
            bf16* bs = BTS + (size_t)g * 256 * 512;
            *(v4u*)(bs + (size_t)n * 512 + tau * 16 + half * 8) = o;
            *(v4u*)(bs + (size_t)(128 + n) * 512 + tau * 16 + half * 8) = (v4u){0u, 0u, 0u, 0u};
        }
        __syncthreads();
        }
    }
}

using pg8::Unit; using pg8::cvt_pk_bf16;
struct EpiInProj {
    static constexpr bool PERM = true;
    bf16* U2; bf16* Z;
    __device__ __forceinline__ void operator()(const f32x4 (&acc)[2][2][4][2], const Unit& u, int wr, int wc, int fr, int fq) const {
#pragma unroll
        for (int ai = 0; ai < 2; ++ai)
#pragma unroll
            for (int m = 0; m < 4; ++m) {
                const int tok = u.pm * 256 + ai * 128 + wr * 64 + m * 16 + fr;
                if (u.pn < 2) {
                    const int b = tok >> 13, l = tok & 8191;
                    bf16* rowp = U2 + (size_t)(b * NCH + (l >> 5)) * U2LD + (l & 31) * 16;
#pragma unroll
                    for (int bj = 0; bj < 2; ++bj) { const int c0 = u.pn * 256 + bj * 128 + wc * 32 + 8 * fq; const f32x4 v0 = acc[ai][bj][m][0], v1 = acc[ai][bj][m][1];
                        v4u w; w.x = cvt_pk_bf16(v0[0], v0[1]); w.y = cvt_pk_bf16(v0[2], v0[3]); w.z = cvt_pk_bf16(v1[0], v1[1]); w.w = cvt_pk_bf16(v1[2], v1[3]);
                        *(v4u*)(rowp + (c0 >> 4) * U2G + (c0 & 15)) = w; }
                } else {
                    const int j0 = (u.pn - 2) * 128 + wc * 32 + 8 * fq;
                    const f32x4 a0 = acc[ai][0][m][0], a1 = acc[ai][0][m][1], g0 = acc[ai][1][m][0], g1 = acc[ai][1][m][1];
                    constexpr float KS = -1.4426950408889634f;
                    const f32x2 z0 = (f32x2){a0[0], a0[1]} * sig2((f32x2){g0[0], g0[1]}, KS), z1 = (f32x2){a0[2], a0[3]} * sig2((f32x2){g0[2], g0[3]}, KS);
                    const f32x2 z2 = (f32x2){a1[0], a1[1]} * sig2((f32x2){g1[0], g1[1]}, KS), z3 = (f32x2){a1[2], a1[3]} * sig2((f32x2){g1[2], g1[3]}, KS);
                    v4u w; w.x = cvt_pk_bf16(z0.x, z0.y); w.y = cvt_pk_bf16(z1.x, z1.y); w.z = cvt_pk_bf16(z2.x, z2.y); w.w = cvt_pk_bf16(z3.x, z3.y);
                    *(v4u*)(Z + (size_t)tok * DCONV + j0) = w;
                }
            }
    }
};
struct EpiGlu {
    static constexpr bool PERM = true;
    const bf16* YG; bf16* MRG; const float* bias;
    __device__ __forceinline__ void operator()(const f32x4 (&acc)[2][2][4][2], const Unit& u, int wr, int wc, int fr, int fq) const {
#pragma unroll
        for (int bj = 0; bj < 2; ++bj) {
            const int c0 = u.pn * 256 + bj * 128 + wc * 32 + 8 * fq;
            const f32x4 b0 = *(const f32x4*)(bias + c0), b1 = *(const f32x4*)(bias + c0 + 4);
#pragma unroll
            for (int ai = 0; ai < 2; ++ai)
#pragma unroll
                for (int m = 0; m < 4; ++m) {
                    const int tok = u.pm * 256 + ai * 128 + wr * 64 + m * 16 + fr;
                    float y[8]; unpack8(*(const v4u*)(YG + (size_t)tok * DSSM + c0), y);
                    const f32x4 v0 = acc[ai][bj][m][0] + b0, v1 = acc[ai][bj][m][1] + b1;
                    constexpr float KS = -1.4426950408889634f;
                    const f32x2 z0 = (f32x2){y[0], y[1]} * sig2((f32x2){v0[0], v0[1]}, KS), z1 = (f32x2){y[2], y[3]} * sig2((f32x2){v0[2], v0[3]}, KS);
                    const f32x2 z2 = (f32x2){y[4], y[5]} * sig2((f32x2){v1[0], v1[1]}, KS), z3 = (f32x2){y[6], y[7]} * sig2((f32x2){v1[2], v1[3]}, KS);
                    v4u w; w.x = cvt_pk_bf16(z0.x, z0.y); w.y = cvt_pk_bf16(z1.x, z1.y); w.z = cvt_pk_bf16(z2.x, z2.y); w.w = cvt_pk_bf16(z3.x, z3.y);
                    *(v4u*)(MRG + (size_t)tok * D + c0) = w;
                }
        }
    }
};
struct EpiOut {
    static constexpr bool PERM = true;
    const float* x; float* out; const float* mod; float* ssq;
    __device__ __forceinline__ void operator()(const f32x4 (&acc)[2][2][4][2], const Unit& u, int wr, int wc, int fr, int fq) const {
        const int b = (u.pm * 256) >> 13;
        f32x4 g1[2][2];
#pragma unroll
        for (int bj = 0; bj < 2; ++bj)
#pragma unroll
            for (int n = 0; n < 2; ++n) g1[bj][n] = *(const f32x4*)(mod + b * 6 * D + 2 * D + u.pn * 256 + bj * 128 + wc * 32 + 8 * fq + 4 * n);
#pragma unroll
        for (int ai = 0; ai < 2; ++ai)
#pragma unroll
            for (int m = 0; m < 4; ++m) {
                const int row = u.pm * 256 + ai * 128 + wr * 64 + m * 16 + fr; float sq = 0.f;
                bf16* drow = (bf16*)(out + (size_t)row * D);
#pragma unroll
                for (int bj = 0; bj < 2; ++bj) {
                    const int c0 = u.pn * 256 + bj * 128 + wc * 32 + 8 * fq;
                    const f32x4 o0 = *(const f32x4*)(x + (size_t)row * D + c0) + g1[bj][0] * acc[ai][bj][m][0], o1 = *(const f32x4*)(x + (size_t)row * D + c0 + 4) + g1[bj][1] * acc[ai][bj][m][1];
                    sq += ((o0[0] * o0[0] + o0[1] * o0[1]) + (o0[2] * o0[2] + o0[3] * o0[3])) + ((o1[0] * o1[0] + o1[1] * o1[1]) + (o1[2] * o1[2] + o1[3] * o1[3]));
                    v4u hi, lo;
                    hi.x = pk2(o0[0], o0[1]); hi.y = pk2(o0[2], o0[3]); hi.z = pk2(o1[0], o1[1]); hi.w = pk2(o1[2], o1[3]);
#if X1_LO
                    lo.x = pk2(o0[0] - bflo(hi.x), o0[1] - bfhi(hi.x)); lo.y = pk2(o0[2] - bflo(hi.y), o0[3] - bfhi(hi.y));
                    lo.z = pk2(o1[0] - bflo(hi.z), o1[1] - bfhi(hi.z)); lo.w = pk2(o1[2] - bflo(hi.w), o1[3] - bfhi(hi.w));
                    *(v4u*)(drow + c0) = lo;
#else
                    (void)lo;
#endif
                    *(v4u*)(drow + D + c0) = hi;
                }
                sq += __shfl_xor(sq, 16); sq += __shfl_xor(sq, 32);
                if (fq == 0) ssq[row * 16 + u.pn * 4 + wc] = sq;
            }
    }
};

__device__ __forceinline__ void p2_fast(const Args& a, LAS unsigned char* lds) {
    pg8::SchedDense S; S.init((const bf16*)(a.ws + WS_H1), (const bf16*)(a.ws + WS_WIN), NTOK, DIN, D, D, D, gridDim.x, blockIdx.x, (REP_GEMM == 2) ? 2 : 1); S.tstamp = (TSTAMP_GEMM == 2) ? 1 : 0;
    EpiInProj E{(bf16*)(a.ws + WS_U2), (bf16*)(a.ws + WS_Z)};
    pg8::gemm_phase<EpiInProj, pg8::SchedDense, true>(lds, S, E);
}
__device__ __forceinline__ void p3d_fast(const Args& a, LAS unsigned char* lds) {
    pg8::SchedDense S; S.init((const bf16*)(a.ws + WS_YG), (const bf16*)(a.ws + WS_WGLU), NTOK, DSSM, DSSM, DSSM, DSSM, gridDim.x, blockIdx.x, (REP_GEMM == 6) ? 2 : 1);
    EpiGlu E{(const bf16*)(a.ws + WS_YG), (bf16*)(a.ws + WS_MRG), a.in[I_BGLU]};
    pg8::gemm_phase<EpiGlu, pg8::SchedDense, true>(lds, S, E);
}
__device__ __forceinline__ void p4_fast(const Args& a, LAS unsigned char* lds) {
    pg8::SchedDense S; S.init((const bf16*)(a.ws + WS_MRG), (const bf16*)(a.ws + WS_WOUT), NTOK, D, D, D, D, gridDim.x, blockIdx.x, (REP_GEMM == 8) ? 2 : 1);
    EpiOut E{a.in[I_X], a.out, (const float*)(a.ws + WS_MOD), (float*)(a.ws + WS_SSQ)};
    pg8::gemm_phase<EpiOut, pg8::SchedDense, ALIGN_P4>(lds, S, E);
}

template <bool GATHER>
struct SchedMoE {
    const LAS int* T; const char* Abase; const char* Bt; const int* tokk; int K, lda, ldb, nN, G, c; size_t bstride; int rep, eb, scale_a, scale_b, rep_epi, tstamp;
    __device__ __forceinline__ bool next(int i_, Unit& u) const {
        const int i = i_ / rep;
        const int NT = __builtin_amdgcn_readfirstlane(T[98 + NE]); int Tt, pn;
        if ((G & 7) == 0 && ((G >> 3) % nN) == 0) {
            const int x = c & 7, j = c >> 3, rtpr = (G >> 3) / nN, Ts = (x * NT) >> 3, Te = ((x + 1) * NT) >> 3;
            pn = j / rtpr; Tt = Ts + i * rtpr + (j % rtpr); if (Tt >= Te) return false;
            if (!GATHER) Tt = Te - 1 - (Tt - Ts);
        } else { const int L = i * G + c; Tt = L / nN; pn = L % nN; if (Tt >= NT) return false; }
        int e = 0;
        if (GATHER) { e = u.e;
            while (e + 1 < NE && __builtin_amdgcn_readfirstlane(T[98 + e + 1]) <= Tt) ++e; e = __builtin_amdgcn_readfirstlane(e); }
        else e = __builtin_amdgcn_readfirstlane(T[1280 + Tt]);
        u.e = e; u.pn = pn; u.pm = Tt; u.slot0 = __builtin_amdgcn_readfirstlane((Tt - T[98 + e]) * 256); u.row0 = __builtin_amdgcn_readfirstlane(T[32 + e] + u.slot0);
        const int left = __builtin_amdgcn_readfirstlane(T[e] - u.slot0); u.nvalid = left < 256 ? left : 256; return true;
    }
    __device__ __forceinline__ const char* a_base(const Unit& u) const { return GATHER ? Abase : Abase + (size_t)u.row0 * lda * eb; }
    __device__ __forceinline__ const char* b_base(const Unit& u) const { return Bt + ((size_t)u.e * bstride + (size_t)u.pn * 256 * ldb) * eb; }
    __device__ __forceinline__ void a_offsets(const Unit& u, const int (&R)[2], const int (&C)[2], unsigned (&off)[2][2]) const {
#pragma unroll
        for (int h = 0; h < 2; ++h)
#pragma unroll
            for (int i = 0; i < 2; ++i) {
                const int row = R[i] + 128 * h;
                if (GATHER) { int tok = 0; if (row < u.nvalid) tok = tokk[(size_t)u.e * CAP + u.slot0 + row] >> 2; off[h][i] = (unsigned)tok * (unsigned)(lda * eb) + (unsigned)C[i] * 2u; }
                else off[h][i] = (unsigned)(row * lda * eb + C[i] * 2);
            }
    }
};
struct EpiMoe1 {
    static constexpr bool PERM = true;
    bf16* ACT; const float* bg; const float* bu;
#if MOE1_WIDE
    __device__ __forceinline__ void operator()(f32x4 (&acc)[2][2][4][2], const Unit& u, int wr, int wc, int fr, int fq) const {
        asm volatile("" : "+v"(fr), "+v"(fq));
        const int gq = ((fq & 1) << 1) | (fq >> 1);
        const int f0 = u.pn * 128 + wc * 32 + 8 * gq;
        {
            const f32x4 g0 = *(const f32x4*)(bg + u.e * FF + f0), g1 = *(const f32x4*)(bg + u.e * FF + f0 + 4);
            const f32x4 u0 = *(const f32x4*)(bu + u.e * FF + f0) + 1.0f, u1 = *(const f32x4*)(bu + u.e * FF + f0 + 4) + 1.0f;
#pragma unroll
            for (int ai = 0; ai < 2; ++ai)
#pragma unroll
                for (int m = 0; m < 4; ++m) { acc[ai][0][m][0] += g0; acc[ai][0][m][1] += g1; acc[ai][1][m][0] += u0; acc[ai][1][m][1] += u1; }
            __builtin_amdgcn_sched_barrier(0);
        }
        unsigned char* dstu = (unsigned char*)ACT + (size_t)u.row0 * FF + u.pn * 128;
        const unsigned voff = (unsigned)((wr * 64 + (fq >> 1) * 16 + fr) * FF + wc * 32 + 16 * (fq & 1));
#pragma unroll
        for (int ai = 0; ai < 2; ++ai)
#pragma unroll
            for (int mp = 0; mp < 2; ++mp) {
                unsigned w[2][2];
#pragma unroll
                for (int mm = 0; mm < 2; ++mm) {
                    const int m = 2 * mp + mm;
                    float o[8];
#pragma unroll
                    for (int n = 0; n < 2; ++n) {
                        const f32x4 gv = acc[ai][0][m][n], uv = acc[ai][1][m][n];
#pragma unroll
                        for (int q = 0; q < 4; q += 2) {
                            const f32x2 gate = {fminf(gv[q], 7.0f), fminf(gv[q + 1], 7.0f)};
                            const f32x2 up1 = {__builtin_amdgcn_fmed3f(uv[q], -6.0f, 8.0f), __builtin_amdgcn_fmed3f(uv[q + 1], -6.0f, 8.0f)};
                            const f32x2 r = up1 * (gate * sig2(gate, -1.4426950408889634f * 1.702f));
                            o[n * 4 + q] = r.x; o[n * 4 + q + 1] = r.y;
                        }
                    }
                    w[mm][0] = pk_fp8x4(o[0], o[1], o[2], o[3]); w[mm][1] = pk_fp8x4(o[4], o[5], o[6], o[7]);
                    __builtin_amdgcn_sched_barrier(0);
                }
                const auto r0 = __builtin_amdgcn_permlane32_swap(w[0][0], w[1][0], false, false), r1 = __builtin_amdgcn_permlane32_swap(w[0][1], w[1][1], false, false);
                const v4u W = {r0[0], r1[0], r0[1], r1[1]};
                const int rl = ai * 128 + wr * 64 + (2 * mp + (fq >> 1)) * 16 + fr;
                if (rl < u.nvalid) *(v4u*)(dstu + (voff + (unsigned)((ai * 128 + mp * 32) * FF))) = W;
            }
#else
    __device__ __forceinline__ void operator()(const f32x4 (&acc)[2][2][4][2], const Unit& u, int wr, int wc, int fr, int fq) const {
        const int f0 = u.pn * 128 + wc * 32 + 8 * fq;
        const f32x4 g0 = *(const f32x4*)(bg + u.e * FF + f0), g1 = *(const f32x4*)(bg + u.e * FF + f0 + 4), u0 = *(const f32x4*)(bu + u.e * FF + f0), u1 = *(const f32x4*)(bu + u.e * FF + f0 + 4);
#pragma unroll
        for (int ai = 0; ai < 2; ++ai)
#pragma unroll
            for (int m = 0; m < 4; ++m) {
                const int rl = ai * 128 + wr * 64 + m * 16 + fr;
                if (rl < u.nvalid) {
                    float o[8];
#pragma unroll
                    for (int n = 0; n < 2; ++n) {
                        const f32x4 gv = acc[ai][0][m][n] + (n ? g1 : g0), uv = acc[ai][1][m][n] + (n ? u1 : u0);
#pragma unroll
                        for (int q = 0; q < 4; q += 2) {
                            const f32x2 gate = {fminf(gv[q], 7.0f), fminf(gv[q + 1], 7.0f)};
                            const f32x2 up = {__builtin_amdgcn_fmed3f(uv[q], -7.0f, 7.0f), __builtin_amdgcn_fmed3f(uv[q + 1], -7.0f, 7.0f)};
                            const f32x2 r = (up + 1.0f) * (gate * sig2(gate, -1.4426950408889634f * 1.702f));
                            o[n * 4 + q] = r.x; o[n * 4 + q + 1] = r.y;
                        }
                    }
#if MOE2_F8
                    v2u w; w.x = pk_fp8x4(o[0], o[1], o[2], o[3]); w.y = pk_fp8x4(o[4], o[5], o[6], o[7]);
                    *(v2u*)((unsigned char*)ACT + (size_t)(u.row0 + rl) * FF + f0) = w;
#else
                    v4u w; w.x = cvt_pk_bf16(o[0], o[1]); w.y = cvt_pk_bf16(o[2], o[3]); w.z = cvt_pk_bf16(o[4], o[5]); w.w = cvt_pk_bf16(o[6], o[7]);
                    *(v4u*)(ACT + (size_t)(u.row0 + rl) * FF + f0) = w;
#endif
                }
            }
#endif
    }
};
struct EpiMoe2 {
    static constexpr bool PERM = true;
    float* out; unsigned char* ws; const int* tokk; const float* bd;
    __device__ __forceinline__ void operator()(const f32x4 (&acc)[2][2][4][2], const Unit& u, int wr, int wc, int fr, int fq) const {
#if MOE2_WIDE
        const int c0 = u.pn * 256 + wc * 64 + 16 * fq;
#else
        const int c0 = u.pn * 256 + wc * 32 + 8 * fq;
#endif
        f32x4 bv[2][2];
#pragma unroll
        for (int bj = 0; bj < 2; ++bj)
#pragma unroll
            for (int n = 0; n < 2; ++n) bv[bj][n] = *(const f32x4*)(bd + u.e * D + c0 + (MOE2_WIDE ? bj * 8 : bj * 128) + 4 * n);
        int tks[2][4];
#pragma unroll
        for (int ai = 0; ai < 2; ++ai)
#pragma unroll
            for (int m = 0; m < 4; ++m) { const int rl = ai * 128 + wr * 64 + m * 16 + fr; tks[ai][m] = (rl < u.nvalid) ? tokk[(size_t)u.e * CAP + u.slot0 + rl] : 0; }
#pragma unroll
        for (int ai = 0; ai < 2; ++ai)
#pragma unroll
            for (int m = 0; m < 4; ++m) {
                const int rl = ai * 128 + wr * 64 + m * 16 + fr;
                if (rl < u.nvalid) {
                    const int tk = tks[ai][m], tok = tk >> 2, k = tk & 3;
#if YS_F8
                    unsigned char* dst = (k == 0) ? (unsigned char*)(out + (size_t)tok * D) : (k == 3) ? (ws + WS_YS3) + (size_t)tok * D : (ws + WS_YS12) + ((size_t)(k - 1) * NTOK + tok) * D;
#if MOE2_WIDE
                    const f32x4 v0 = acc[ai][0][m][0] + bv[0][0], v1 = acc[ai][0][m][1] + bv[0][1], v2 = acc[ai][1][m][0] + bv[1][0], v3 = acc[ai][1][m][1] + bv[1][1];
                    v4u w; w.x = pk_fp8x4(v0[0], v0[1], v0[2], v0[3]); w.y = pk_fp8x4(v1[0], v1[1], v1[2], v1[3]); w.z = pk_fp8x4(v2[0], v2[1], v2[2], v2[3]); w.w = pk_fp8x4(v3[0], v3[1], v3[2], v3[3]);
                    *(v4u*)(dst + c0) = w;
#else
#pragma unroll
                    for (int bj = 0; bj < 2; ++bj) { const f32x4 v0 = acc[ai][bj][m][0] + bv[bj][0], v1 = acc[ai][bj][m][1] + bv[bj][1];
                        v2u w; w.x = pk_fp8x4(v0[0], v0[1], v0[2], v0[3]); w.y = pk_fp8x4(v1[0], v1[1], v1[2], v1[3]);
                        *(v2u*)(dst + c0 + bj * 128) = w; }
#endif
#else
                    bf16* dst = (k == 0) ? (bf16*)(out + (size_t)tok * D) : (k == 3) ? (bf16*)(ws + WS_YS3) + (size_t)tok * D : (bf16*)(ws + WS_YS12) + ((size_t)(k - 1) * NTOK + tok) * D;
#pragma unroll
                    for (int bj = 0; bj < 2; ++bj) { const f32x4 v0 = acc[ai][bj][m][0] + bv[bj][0], v1 = acc[ai][bj][m][1] + bv[bj][1];
                        v4u w; w.x = cvt_pk_bf16(v0[0], v0[1]); w.y = cvt_pk_bf16(v0[2], v0[3]); w.z = cvt_pk_bf16(v1[0], v1[1]); w.w = cvt_pk_bf16(v1[2], v1[3]);
                        *(v4u*)(dst + c0 + bj * 128) = w; }
#endif
                }
            }
    }
};
__device__ __forceinline__ void p7_fast(const Args& a, LAS unsigned char* lds, LAS int* T) {
    SchedMoE<true> S{T, (const char*)(a.ws + WS_H2), (const char*)(a.ws + WS_WGU), (const int*)(a.ws + WS_TOKK), D, D, D, 8, (int)gridDim.x, (int)blockIdx.x, (size_t)2048 * D, (REP_GEMM == 10) ? 2 : 1, MOE1_F8 ? 1 : 2, 127, 127 - 5, (REP_EPI == 10) ? 1 : 0, (TSTAMP_GEMM == 10) ? 1 : 0};
    EpiMoe1 E{(bf16*)(a.ws + WS_ACT), a.in[I_BG], a.in[I_BU]};
    pg8::gemm_phase<EpiMoe1, SchedMoE<true>, ALIGN_MOE, MOE1_F8 != 0>(lds, S, E);
}
__device__ __forceinline__ void p8_fast(const Args& a, LAS unsigned char* lds, LAS int* T) {
    SchedMoE<false> S{T, (const char*)(a.ws + WS_ACT), (const char*)(a.ws + WS_WD), (const int*)(a.ws + WS_TOKK), FF, FF, FF, 4, (int)gridDim.x, (int)blockIdx.x, (size_t)D * FF, (REP_GEMM == 11) ? 2 : 1, MOE2_F8 ? 1 : 2, 127, MOE2_F8 ? 127 - 5 : 127, (REP_EPI == 11) ? 1 : 0, (TSTAMP_GEMM == 11) ? 1 : 0};
    EpiMoe2 E{a.out, a.ws, (const int*)(a.ws + WS_TOKK), a.in[I_BD]};
    pg8::gemm_phase<EpiMoe2, SchedMoE<false>, ALIGN_MOE, MOE2_F8 != 0>(lds, S, E);
}

struct EpiSloc {
    static constexpr bool PERM = false;
    float* SL;
    __device__ __forceinline__ void operator()(const f32x4 (&acc)[2][2][4][2], const Unit& u, int wr, int wc, int fr, int fq) const {
#pragma unroll
        for (int ai = 0; ai < 2; ++ai)
#pragma unroll
            for (int m = 0; m < 4; ++m) {
                float* rowp = SL + (size_t)(u.pm * 256 + ai * 128 + wr * 64 + m * 16 + fr) * (NG * 128) + u.e * 128 + wc * 32 + 4 * fq;
#pragma unroll
                for (int n = 0; n < 2; ++n) *(f32x4*)(rowp + n * 16) = acc[ai][0][m][n];
            }
    }
};
struct EpiY {
    static constexpr bool PERM = true;
    bf16* YG;
    __device__ __forceinline__ void operator()(const f32x4 (&acc)[2][2][4][2], const Unit& u, int wr, int wc, int fr, int fq) const {
#pragma unroll
        for (int ai = 0; ai < 2; ++ai)
#pragma unroll
            for (int m = 0; m < 4; ++m) {
                const int r = u.pm * 256 + ai * 128 + wr * 64 + m * 16 + fr;
#pragma unroll
                for (int bj = 0; bj < 2; ++bj) {
                    const int c0 = u.pn * 256 + bj * 128 + wc * 32 + 8 * fq, t = c0 >> 4, h0 = c0 & 15;
                    const f32x4 v0 = acc[ai][bj][m][0], v1 = acc[ai][bj][m][1];
                    const f32x2 z0 = gelu2((f32x2){v0[0], v0[1]}), z1 = gelu2((f32x2){v0[2], v0[3]}), z2 = gelu2((f32x2){v1[0], v1[1]}), z3 = gelu2((f32x2){v1[2], v1[3]});
                    v4u w; w.x = cvt_pk_bf16(z0.x, z0.y); w.y = cvt_pk_bf16(z1.x, z1.y); w.z = cvt_pk_bf16(z2.x, z2.y); w.w = cvt_pk_bf16(z3.x, z3.y);
                    *(v4u*)(YG + (size_t)(r * 32 + t) * DSSM + u.e * GH + h0) = w;
                }
            }
    }
};
__device__ __forceinline__ void p3a_fast(const Args& a, LAS unsigned char* lds) {
    pg8::SchedGroup S{(const bf16*)(a.ws + WS_U2), (const bf16*)(a.ws + WS_BTS), 512, U2LD, 512, NROW2 / 256, 1, NG, (int)gridDim.x, (int)blockIdx.x, (size_t)U2G, (size_t)256 * 512, (REP_GEMM == 3) ? 2 : 1, 1 << 30};
    EpiSloc E{(float*)(a.ws + WS_SLOC)};
    pg8::gemm_phase<EpiSloc, pg8::SchedGroup, true>(lds, S, E);
}
__device__ __forceinline__ void p3c_fast(const Args& a, LAS unsigned char* lds) {
    pg8::SchedGroup S{(const bf16*)(a.ws + WS_U2), (const bf16*)(a.ws + WS_BTY), U2G, U2LD, U2G, NROW2 / 256, 2, NG, (int)gridDim.x, (int)blockIdx.x, (size_t)U2G, (size_t)512 * U2G, (REP_GEMM == 5) ? 2 : 1, 1 << 30};
    EpiY E{(bf16*)(a.ws + WS_YG)};
    pg8::gemm_phase<EpiY, pg8::SchedGroup, true>(lds, S, E);
}
__device__ __forceinline__ void p3c_pair(const Args& a, LAS unsigned char* lds, int g, int pm) {
    pg8::SchedGroup S{(const bf16*)(a.ws + WS_U2), (const bf16*)(a.ws + WS_BTY), U2G, U2LD, U2G, NROW2 / 256, 2, NG, NROW2 / 256, g * 2 * (NROW2 / 256) + pm, (size_t)U2G, (size_t)512 * U2G, 1, 2};
    EpiY E{(bf16*)(a.ws + WS_YG)};
    pg8::gemm_phase<EpiY, pg8::SchedGroup, true>(lds, S, E);
}
__device__ __forceinline__ void p3b_scan(const Args& a, LAS float* sm, bool fused) {
    const float* SL = (const float*)(a.ws + WS_SLOC); bf16* U2 = (bf16*)(a.ws + WS_U2);
    const int t = threadIdx.x, p = t & 63, seg = t >> 6;
    for (int task = blockIdx.x; task < NB * NG; task += gridDim.x) {
        const int b = fused ? (task % (NROW2 / 256)) : (task / NG), g = fused ? (task / (NROW2 / 256)) : (task % NG);
        const float lr = a.in[I_LRE][g * NP + p], li = a.in[I_LIM][g * NP + p], dt = expf(a.in[I_LDT][g]);
        float ar, ai, br, bi;
        { const float m = expf(32.f * lr * dt); float s2, c2; sincosf(32.f * li * dt, &s2, &c2); ar = m * c2; ai = m * s2; }
        { const float m = expf(1024.f * lr * dt); float s2, c2; sincosf(1024.f * li * dt, &s2, &c2); br = m * c2; bi = m * s2; }
        const float* sl = SL + (size_t)(b * NCH + seg * 32) * (NG * 128) + g * 128 + p;
        float sr = 0.f, si = 0.f;
        float lre[32], lim[32];
#pragma unroll
        for (int c = 0; c < 32; ++c) { lre[c] = sl[(size_t)c * (NG * 128)]; lim[c] = sl[(size_t)c * (NG * 128) + 64]; }
#pragma unroll
        for (int c = 0; c < 32; ++c) { const float nr = ar * sr - ai * si + lre[c], ni = ar * si + ai * sr + lim[c]; sr = nr; si = ni; }
        sm[(seg * 64 + p) * 2] = sr; sm[(seg * 64 + p) * 2 + 1] = si;
        __syncthreads();
        float cr = 0.f, ci = 0.f;
        for (int s = 0; s < seg; ++s) { const float er = sm[(s * 64 + p) * 2], ei = sm[(s * 64 + p) * 2 + 1]; const float nr = br * cr - bi * ci + er, ni = br * ci + bi * cr + ei; cr = nr; ci = ni; }
        bf16* up = U2 + (size_t)(b * NCH + seg * 32) * U2LD + g * U2G + 512 + p;
        sr = cr; si = ci;
#pragma unroll
        for (int c = 0; c < 32; ++c) {
            up[(size_t)c * U2LD] = (bf16)f2bf(sr); up[(size_t)c * U2LD + 64] = (bf16)f2bf(si);
            const float nr = ar * sr - ai * si + lre[c], ni = ar * si + ai * sr + lim[c]; sr = nr; si = ni;
        }
        __syncthreads();
    }
}


#define XB_TMO      128
#define XB_XCNT(j)  (256  + 64 * (j))
#define XB_XSUB(j)  (1280 + 64 * (j))
#define XB_XGEN(j)  (2304 + 64 * (j))
#define XB_TOP      3328
#define XB_TOPGEN   3392
#define XCD_BAR_WORDS 3456
#define XB_SPIN_CAP (1u << 22)
__device__ __forceinline__ unsigned xb_ld(unsigned* p)              { return __hip_atomic_load(p, __ATOMIC_RELAXED, __HIP_MEMORY_SCOPE_AGENT); }
__device__ __forceinline__ unsigned xb_add(unsigned* p, unsigned v) { return __hip_atomic_fetch_add(p, v, __ATOMIC_RELAXED, __HIP_MEMORY_SCOPE_AGENT); }
__device__ __forceinline__ unsigned xb_xcc_id() { return (unsigned)__builtin_amdgcn_s_getreg((3 << 11) | 20) & 0xFu; }
#define XB_SPIN(cond, bar) do { unsigned _sp = 0; while (cond) { __builtin_amdgcn_s_sleep(1); \
    if ((++_sp & 255u) == 0u) { if (xb_ld(&(bar)[XB_TMO])) break; if (_sp > XB_SPIN_CAP) { atomicAdd(&(bar)[XB_TMO], 1u); break; } } } } while (0)
struct XcdBarrier { unsigned* bar; unsigned x; volatile LAS unsigned* st; };
__device__ __forceinline__ XcdBarrier xcd_barrier_post(unsigned* bar, volatile LAS unsigned* st) {
    XcdBarrier b; b.bar = bar; b.x = xb_xcc_id(); b.st = st;
    if (threadIdx.x == 0) (void)xb_add(&bar[XB_XCNT(b.x)], 1u);
    return b;
}
__device__ __forceinline__ void xcd_barrier_complete(unsigned* bar, unsigned x, unsigned& nloc, unsigned& nx) {
    const unsigned G = gridDim.x * gridDim.y * gridDim.z;
    unsigned sum, cnt, mine, sp = 0u;
    for (;;) {
        sum = 0u; cnt = 0u; mine = 0u;
#pragma unroll
        for (unsigned j = 0; j < 16; ++j) { const unsigned c = xb_ld(&bar[XB_XCNT(j)]); sum += c; cnt += (c > 0u) ? 1u : 0u; mine = (j == x) ? c : mine; }
        if (sum == G) break;
        __builtin_amdgcn_s_sleep(1);
        if ((++sp & 255u) == 0u) { if (xb_ld(&bar[XB_TMO])) break; if (sp > XB_SPIN_CAP) { atomicAdd(&bar[XB_TMO], 1u); break; } }
    }
    nloc = mine > 0u ? mine : 1u; nx = cnt > 0u ? cnt : 1u;
}
__device__ __forceinline__ void xcd_barrier(const XcdBarrier& b) {
    asm volatile("s_waitcnt vmcnt(0)" ::: "memory");
    __syncthreads();
    if (threadIdx.x == 0) {
        unsigned* bar = b.bar;
        __builtin_amdgcn_s_waitcnt(0);
        unsigned nloc = b.st[0], nx = b.st[1];
        if (nloc == 0u) { xcd_barrier_complete(bar, b.x, nloc, nx); b.st[0] = nloc; b.st[1] = nx; }
        const unsigned old = xb_add(&bar[XB_XSUB(b.x)], 1u);
        const unsigned gen = old / nloc;
        if (old + 1u == (gen + 1u) * nloc) {
            __builtin_amdgcn_fence(__ATOMIC_RELEASE, "agent");
            asm volatile("s_waitcnt vmcnt(0)" ::: "memory");
            const unsigned og = xb_add(&bar[XB_TOP], 1u);
            const unsigned tg = og / nx;
            if (og + 1u == (tg + 1u) * nx) xb_add(&bar[XB_TOPGEN], 1u);
            else XB_SPIN(xb_ld(&bar[XB_TOPGEN]) == tg, bar);
            __builtin_amdgcn_fence(__ATOMIC_ACQUIRE, "agent");
            xb_add(&bar[XB_XGEN(b.x)], 1u);
            asm volatile("s_waitcnt vmcnt(0)" ::: "memory");
        } else {
            XB_SPIN(xb_ld(&bar[XB_XGEN(b.x)]) == gen, bar);
            __builtin_amdgcn_fence(__ATOMIC_ACQUIRE, "agent");
            asm volatile("s_waitcnt vmcnt(0)" ::: "memory");
        }
    }
    __syncthreads();
}

__device__ __forceinline__ void p1_router_item(const Args& a, int it, int lane) {
    const float* rw = a.in[I_RW]; const float* g = a.in[I_N2G]; const float* mod = (const float*)(a.ws + WS_MOD);
    bf16* RWH = (bf16*)(a.ws + WS_RWT); bf16* RWL = RWH + NB * NE * D; float* rbias = (float*)(a.ws + WS_RWT + 524288);
    {
        const int b = it >> 5, e = it & 31; float bs = 0.f;
#pragma unroll 4
        for (int j = 0; j < 16; ++j) {
            const int k = lane + 64 * j; const float w = rw[k * NE + e], wp = w * g[k] * (1.0f + mod[b * 6 * D + 4 * D + k]);
            const unsigned hi = f2bf(wp), lo = f2bf(wp - bf2f(hi));
            RWH[(size_t)(b * NE + e) * D + k] = (bf16)hi; RWL[(size_t)(b * NE + e) * D + k] = (bf16)lo;
            bs += mod[b * 6 * D + 3 * D + k] * w;
        }
        bs = wave_sum(bs);
        if (lane == 0) rbias[b * NE + e] = bs + a.in[I_RB][e];
    }
}
__device__ __forceinline__ void top4_of8(float (&v)[8], const int (&e)[8], float (&tv)[4], int (&ti)[4]) {
#pragma unroll
    for (int r = 0; r < 4; ++r) {
        float bv = v[0]; int be = e[0];
#pragma unroll
        for (int i = 1; i < 8; ++i) { const bool t = v[i] > bv || (v[i] == bv && e[i] < be); bv = t ? v[i] : bv; be = t ? e[i] : be; }
        tv[r] = bv; ti[r] = be;
#pragma unroll
        for (int i = 0; i < 8; ++i) v[i] = (e[i] == be) ? -3.0e38f : v[i];
    }
}
__device__ __forceinline__ bf16x8 pack_hi8(const f32x4 x0, const f32x4 x1, bf16x8& lo) {
    const float f[8] = {x0[0], x0[1], x0[2], x0[3], x1[0], x1[1], x1[2], x1[3]};
    v4u h, l;
#pragma unroll
    for (int i = 0; i < 4; ++i) { const unsigned w = pk2(f[2 * i], f[2 * i + 1]); h[i] = w; l[i] = pk2(f[2 * i] - bflo(w), f[2 * i + 1] - bfhi(w)); }
    lo = __builtin_bit_cast(bf16x8, l);
    return __builtin_bit_cast(bf16x8, h);
}
__device__ __forceinline__ void p5_fast(const Args& a, LAS unsigned char* lds, int lane, int wave) {
    LAS unsigned* hist = (LAS unsigned*)(lds + 131072 + 1024);
    LAS unsigned* basearr = hist + 64;
    const bf16* RWH = (const bf16*)(a.ws + WS_RWT); const bf16* RWL = RWH + NB * NE * D; const float* rbias = (const float*)(a.ws + WS_RWT + 524288);
    const float* g = a.in[I_N2G]; const float* mod = (const float*)(a.ws + WS_MOD);
    bf16* H2 = (bf16*)(a.ws + WS_H2); float* topw = (float*)(a.ws + WS_TOPW); int* tokk = (int*)(a.ws + WS_TOKK); unsigned* cnt = (unsigned*)(a.ws + WS_CTL) + CW_CNT;
    const int col = lane & 15, q = lane >> 4;
    LAS float* gam = (LAS float*)(lds + 131072 + 8192); LAS float* bet = gam + D;
    int lds_batch = -1;
    if (threadIdx.x < 96) hist[threadIdx.x] = 0u;
    __syncthreads();
    int iter = 0;
    for (int task0 = blockIdx.x * NWAVES; task0 < NTOK / 16; task0 += gridDim.x * NWAVES, ++iter) {
        const int task = task0 + wave; const bool active = task < NTOK / 16;
        float tv[4] = {0.f, 0.f, 0.f, 0.f}; int ti[4] = {0, 1, 2, 3}; unsigned rank[4] = {0u, 0u, 0u, 0u};
        const int tok = task * 16 + col, b = (task * 16) >> 13;
        LAS unsigned* hcur = hist + (iter & 1) * 32;
        {
            const int bb = (task0 * 16) >> 13;
            if (bb != lds_batch) {
                __syncthreads();
                const v4u* srch = (const v4u*)(RWH + (size_t)bb * NE * D); const v4u* srcl = (const v4u*)(RWL + (size_t)bb * NE * D);
#pragma unroll
                for (int i = 0; i < 8; ++i) { const int ci = threadIdx.x + NTHR * i, e = ci >> 7, c = ci & 127, d = (e * 128 + (c ^ (e & 15))) * 16;
                    *(LAS v4u*)(lds + d) = srch[ci]; *(LAS v4u*)(lds + 65536 + d) = srcl[ci]; }
                for (int k = threadIdx.x; k < D; k += NTHR) { gam[k] = g[k] * (1.0f + mod[bb * 6 * D + 4 * D + k]); bet[k] = mod[bb * 6 * D + 3 * D + k]; }
                lds_batch = bb;
                __syncthreads();
            }
        }
        if (active) {
            float rstd;
            { const f32x4* sp = (const f32x4*)((const float*)(a.ws + WS_SSQ) + (size_t)tok * 16); const f32x4 s0 = sp[0], s1 = sp[1], s2 = sp[2], s3 = sp[3];
              const float ss = (((s0[0] + s0[1]) + (s0[2] + s0[3])) + ((s1[0] + s1[1]) + (s1[2] + s1[3]))) + (((s2[0] + s2[1]) + (s2[2] + s2[3])) + ((s3[0] + s3[1]) + (s3[2] + s3[3])));
              rstd = rsqrtf(ss * (1.f / D) + 1e-6f); }
            f32x4 acc0 = {0.f, 0.f, 0.f, 0.f}, acc1 = {0.f, 0.f, 0.f, 0.f};
            constexpr int RING = 16;
            const bf16* hrow = (const bf16*)(a.out + (size_t)tok * D) + D + 16 * q;
#if X1_LO
            const bf16* lrow = (const bf16*)(a.out + (size_t)tok * D) + 16 * q;
#endif
            v4u rh[RING], rl[RING];
#pragma unroll
            for (int i = 0; i < RING; ++i) { rh[i] = __builtin_nontemporal_load((const v4u*)(hrow + 64 * (i >> 1) + 8 * (i & 1)));
#if X1_LO
                rl[i] = __builtin_nontemporal_load((const v4u*)(lrow + 64 * (i >> 1) + 8 * (i & 1)));
#else
                rl[i] = (v4u){0u, 0u, 0u, 0u};
#endif
            }
            const int e0 = col, e1 = 16 + col;
            v2u hprev = {0u, 0u};
#pragma unroll 1
            for (int so = 0; so < 32; so += RING) {
#pragma unroll
                for (int si = 0; si < RING; ++si) {
                    const int st = so + si, kb = 64 * (st >> 1) + 8 * (st & 1), k = kb + 16 * q, c = 8 * (st >> 1) + 2 * q + (st & 1);
                    const v4u xh = rh[si], xl = rl[si];
                    { const int kn = (st + RING < 32) ? kb + 32 * RING : 0; rh[si] = __builtin_nontemporal_load((const v4u*)(hrow + kn));
#if X1_LO
                      rl[si] = __builtin_nontemporal_load((const v4u*)(lrow + kn));
#endif
                    }
                    asm volatile("" ::: "memory");
                    const bf16x8 a0h = *(const LAS bf16x8*)(lds + (e0 * 128 + (c ^ (e0 & 15))) * 16), a0l = *(const LAS bf16x8*)(lds + 65536 + (e0 * 128 + (c ^ (e0 & 15))) * 16);
                    const bf16x8 a1h = *(const LAS bf16x8*)(lds + (e1 * 128 + (c ^ (e1 & 15))) * 16), a1l = *(const LAS bf16x8*)(lds + 65536 + (e1 * 128 + (c ^ (e1 & 15))) * 16);
                    const f32x4 g0 = *(const LAS f32x4*)(gam + k), g1 = *(const LAS f32x4*)(gam + k + 4), s0 = *(const LAS f32x4*)(bet + k), s1 = *(const LAS f32x4*)(bet + k + 4);
                    const bf16x8 bh = __builtin_bit_cast(bf16x8, xh), bl = __builtin_bit_cast(bf16x8, xl);
                    acc0 = __builtin_amdgcn_mfma_f32_16x16x32_bf16(a0h, bh, acc0, 0, 0, 0); if (X1_LO) acc0 = __builtin_amdgcn_mfma_f32_16x16x32_bf16(a0h, bl, acc0, 0, 0, 0); acc0 = __builtin_amdgcn_mfma_f32_16x16x32_bf16(a0l, bh, acc0, 0, 0, 0);
                    acc1 = __builtin_amdgcn_mfma_f32_16x16x32_bf16(a1h, bh, acc1, 0, 0, 0); if (X1_LO) acc1 = __builtin_amdgcn_mfma_f32_16x16x32_bf16(a1h, bl, acc1, 0, 0, 0); acc1 = __builtin_amdgcn_mfma_f32_16x16x32_bf16(a1l, bh, acc1, 0, 0, 0);
#if X1_LO
                    const f32x4 x0 = {bflo(xh.x) + bflo(xl.x), bfhi(xh.x) + bfhi(xl.x), bflo(xh.y) + bflo(xl.y), bfhi(xh.y) + bfhi(xl.y)};
                    const f32x4 x1 = {bflo(xh.z) + bflo(xl.z), bfhi(xh.z) + bfhi(xl.z), bflo(xh.w) + bflo(xl.w), bfhi(xh.w) + bfhi(xl.w)};
#else
                    const f32x4 x0 = {bflo(xh.x), bfhi(xh.x), bflo(xh.y), bfhi(xh.y)}, x1 = {bflo(xh.z), bfhi(xh.z), bflo(xh.w), bfhi(xh.w)};
#endif
                    const f32x4 h0 = x0 * rstd * g0 + s0, h1 = x1 * rstd * g1 + s1;
#if MOE1_F8
                    v2u hw; hw.x = pk_fp8x4(h0[0], h0[1], h0[2], h0[3]); hw.y = pk_fp8x4(h1[0], h1[1], h1[2], h1[3]);
                    if (st & 1) *(v4u*)((unsigned char*)H2 + (size_t)tok * D + 64 * (st >> 1) + 16 * q) = (v4u){hprev.x, hprev.y, hw.x, hw.y};
                    else hprev = hw;
#else
                    v4u hw; hw.x = pk2(h0[0], h0[1]); hw.y = pk2(h0[2], h0[3]); hw.z = pk2(h1[0], h1[1]); hw.w = pk2(h1[2], h1[3]);
                    *(v4u*)(H2 + (size_t)tok * D + k) = hw;
#endif
                    asm volatile("" ::: "memory");
                }
            }
            STAMP(19);
            float v[8]; int e[8];
#pragma unroll
            for (int j = 0; j < 4; ++j) { e[j] = 4 * q + j; e[4 + j] = 16 + 4 * q + j; v[j] = rstd * acc0[j] + rbias[b * NE + 4 * q + j]; v[4 + j] = rstd * acc1[j] + rbias[b * NE + 16 + 4 * q + j]; }
            top4_of8(v, e, tv, ti);
#pragma unroll
            for (int off = 16; off <= 32; off <<= 1) {
                float v2[8]; int e2[8];
#pragma unroll
                for (int r = 0; r < 4; ++r) { v2[r] = tv[r]; e2[r] = ti[r]; v2[4 + r] = __shfl_xor(tv[r], off); e2[4 + r] = __shfl_xor(ti[r], off); }
                top4_of8(v2, e2, tv, ti);
            }
            if (q == 0) {
#pragma unroll
                for (int r = 0; r < 4; ++r) rank[r] = __hip_atomic_fetch_add(hcur + ti[r], 1u, __ATOMIC_RELAXED, __HIP_MEMORY_SCOPE_WORKGROUP);
            }
        }
        STAMP(20);
        __syncthreads();
        STAMP(21);
        if (threadIdx.x < 32) { const unsigned n = hcur[threadIdx.x]; basearr[threadIdx.x] = n ? atomicAdd(cnt + 32 * threadIdx.x, n) : 0u; hist[((iter + 1) & 1) * 32 + threadIdx.x] = 0u; }
        __syncthreads();
        if (active && q == 0) {
            const float e1 = __expf(tv[1] - tv[0]), e2 = __expf(tv[2] - tv[0]), e3 = __expf(tv[3] - tv[0]), inv = 1.f / (1.f + e1 + e2 + e3);
            const float w[4] = {inv, e1 * inv, e2 * inv, e3 * inv};
#pragma unroll
            for (int r = 0; r < 4; ++r) { const unsigned slot = basearr[ti[r]] + rank[r]; tokk[(size_t)ti[r] * CAP + slot] = tok * 4 + r; }
            *(f32x4*)(topw + tok * 4) = (f32x4){w[0], w[1], w[2], w[3]};
        }
    }
}

constexpr int NPHASE = 13;
__global__ void __launch_bounds__(NTHR, 2) fwd_kernel(Args a) {
    extern __shared__ __attribute__((aligned(16))) unsigned char lds_raw[];
    LAS unsigned char* lds = (LAS unsigned char*)lds_raw;
    LAS float* sm = (LAS float*)lds;
    LAS int* T = (LAS int*)(lds + 131072);
#if USE_CG_SYNC
    cg::grid_group grid = cg::this_grid();
#else
    volatile LAS unsigned* MISC = (volatile LAS unsigned*)(lds + 131072 + 2048);
    if (threadIdx.x < 32) MISC[threadIdx.x] = 0u;
    __syncthreads();
    XcdBarrier xbar = xcd_barrier_post((unsigned*)(a.ws + WS_CTL) + CW_BAR, MISC + 8);
#endif
    const int tid = threadIdx.x, lane = tid & 63, wave = __builtin_amdgcn_readfirstlane(tid >> 6);
    const int gw = blockIdx.x * NWAVES + wave, ngw = gridDim.x * NWAVES;
    const int lo = a.ph_lo, hi = a.ph_hi;
#define IN(k) (lo <= (k) && (k) < hi)
#if TIME_PHASE >= 0
    LAS unsigned long long* TS = (LAS unsigned long long*)(lds + 131072 + 4096);
#endif
#if USE_CG_SYNC
#define SEAM(k) do { if (IN(k) && IN((k) + 1)) grid.sync(); } while (0)
#else
#define SEAM(k) do { if (IN(k) && IN((k) + 1)) xcd_barrier(xbar); } while (0)
#endif
#define REP(k) _Pragma("nounroll") for (int _r = 0; _r < (((REP_MASK >> (k)) & 1) ? a.rep_mask : 1); ++_r)
    STAMP(0); if (IN(0)) { REP(0) { p0_mod(a, sm); STAMP(16); p0_s5_mats(a, sm); __syncthreads(); STAMP(17); p0_convert(a, gw, ngw, lane); __syncthreads(); STAMP(18); } }
    STAMP(1); if (IN(0)) { mod_wait(a); p1_dynamic(a, lane); } SEAM(1);
    STAMP(2); if (IN(2)) { REP(2) { p2_fast(a, lds); } } SEAM(2);
    STAMP(3); if (IN(3)) { p3a_fast(a, lds); if (gridDim.x >= NB * NG) { asm volatile("s_waitcnt vmcnt(0)" ::: "memory"); __syncthreads(); if (blockIdx.x < NB * NG) { p3b_scan(a, sm, true); asm volatile("s_waitcnt vmcnt(0)" ::: "memory"); __syncthreads(); p3c_pair(a, lds, blockIdx.x / (NROW2 / 256), blockIdx.x % (NROW2 / 256)); } __syncthreads(); p3e_conv(a, sm, lane); } else p3e_conv(a, sm, lane); }
    if (gridDim.x < NB * NG) { SEAM(3); if (IN(4)) { p3b_scan(a, sm, false); __syncthreads(); p3e_conv(a, sm, lane); } }
    STAMP(4); if (gridDim.x < NB * NG) SEAM(4);
    STAMP(5); if (IN(5) && gridDim.x < NB * NG) { p3c_fast(a, lds); } SEAM(5);
    STAMP(6); if (IN(6)) { REP(6) { p3d_fast(a, lds); } } SEAM(6);
    STAMP(7); if (IN(7)) { p3e_norm(a, gw, ngw, lane); } SEAM(7);
    STAMP(8); if (IN(8)) { REP(8) { p4_fast(a, lds); } } SEAM(8);
    STAMP(9); if (IN(9)) { p5_fast(a, lds, lane, wave); } SEAM(9);
    STAMP(10); if (IN(10)) { moe_tables(a, T); REP(10) { p7_fast(a, lds, T); } } SEAM(10);
    STAMP(11); if (IN(11)) { moe_tables(a, T); REP(11) { p8_fast(a, lds, T); } } SEAM(11);
    STAMP(12); if (IN(12)) { p9_final(a, gw, ngw, lane); }
#undef REP
    STAMP(13);
#if TIME_PHASE >= 0
    if (blockIdx.x == 0 && threadIdx.x == 0) { const unsigned long long dt = TS[TIME_B] - TS[TIME_A], t1 = TS[13]; while (__builtin_amdgcn_s_memrealtime() - t1 < 8ull * dt) __builtin_amdgcn_s_sleep(8); }
#endif
#undef IN
#undef SEAM
}

#ifndef N_LAUNCHES
#define N_LAUNCHES 1
#endif
extern "C" void kernel_launch(void* const* d_in, const int* in_sizes, int n_in, void* d_out, int out_size, void* d_ws, size_t ws_size, hipStream_t stream) {
    static int grid = 0;
    if (grid == 0) {
        if (n_in != 32 || out_size != NTOK * D || ws_size < WS_END) { fprintf(stderr, "kernel_launch: unexpected problem (n_in %d out %d ws %zu)\n", n_in, out_size, ws_size); grid = -1; return; }
        int dev = 0, cus = 0, per_cu = 0;
        if (hipGetDevice(&dev) != hipSuccess || hipDeviceGetAttribute(&cus, hipDeviceAttributeMultiprocessorCount, dev) != hipSuccess) { grid = -1; return; }
        if (hipFuncSetAttribute((const void*)fwd_kernel, hipFuncAttributeMaxDynamicSharedMemorySize, LDS_BYTES) != hipSuccess) { fprintf(stderr, "kernel_launch: hipFuncSetAttribute failed\n"); grid = -1; return; }
        if (hipOccupancyMaxActiveBlocksPerMultiprocessor(&per_cu, (const void*)fwd_kernel, NTHR, LDS_BYTES) != hipSuccess || per_cu < 1) { fprintf(stderr, "kernel_launch: occupancy query says %d\n", per_cu); (void)hipGetLastError(); per_cu = 1; }
        grid = cus;
    }
    if (grid < 0) return;
    (void)hipMemsetAsync((char*)d_ws + WS_CTL, 0, 65536, stream);
    Args a{};
    for (int i = 0; i < 32; ++i) a.in[i] = (const float*)d_in[i];
    a.out = (float*)d_out; a.ws = (unsigned char*)d_ws; a.rep_mask = 2;
    for (int li = 0; li < N_LAUNCHES; ++li) {
        a.ph_lo = (N_LAUNCHES == 1) ? 0 : li; a.ph_hi = (N_LAUNCHES == 1) ? NPHASE : li + 1;
        void* args[] = {&a};
        hipError_t e = hipLaunchCooperativeKernel((const void*)fwd_kernel, dim3(grid), dim3(NTHR), args, LDS_BYTES, stream);
        if (e != hipSuccess) { fprintf(stderr, "kernel_launch: launch %d failed: %s\n", li, hipGetErrorString(e)); break; }
    }
}
```

```cpp
#include <hip/hip_runtime.h>
#include <hip/hip_cooperative_groups.h>
#include <cstdio>
#include <cstdint>
namespace cg = cooperative_groups;
#define MOE2_WIDE (MOE2_F8 && YS_F8)
#define MOE1_WIDE (MOE1_F8 && MOE2_F8)
#ifndef USE_CG_SYNC
#define USE_CG_SYNC 0
#endif
#ifndef YS_F8
#define YS_F8 1
#endif
#ifndef MOE2_F8
#define MOE2_F8 1
#endif
#ifndef MOE1_F8
#define MOE1_F8 1
#endif
#ifndef TIME_PHASE
#define TIME_PHASE -1
#endif
#ifndef TIME_A
#define TIME_A (TIME_PHASE)
#define TIME_B (TIME_PHASE + 1)
#endif
#ifndef X1_LO
#define X1_LO 0
#endif
#ifndef IN_F8
#define IN_F8 1
#endif
#ifndef FUSE_NORM
#define FUSE_NORM 1
#endif
#ifndef CONV_LDS
#define CONV_LDS 1
#endif
#ifndef MOE_SIDE
#define MOE_SIDE 1
#endif
#ifndef ALIGN_P4
#define ALIGN_P4 true
#endif
#ifndef ALIGN_MOE
#define ALIGN_MOE true
#endif
#ifndef TSTAMP_GEMM
#define TSTAMP_GEMM 0
#endif
#ifndef REP_EPI
#define REP_EPI 0
#endif
#ifndef REP_GEMM
#define REP_GEMM 0
#endif
#ifndef REP_MASK
#define REP_MASK 0
#endif

#define GAS __attribute__((address_space(1)))
#define LAS __attribute__((address_space(3)))
typedef unsigned short bf16;
typedef unsigned v4u __attribute__((ext_vector_type(4)));
typedef unsigned v2u __attribute__((ext_vector_type(2)));
typedef float f32x4 __attribute__((ext_vector_type(4)));
typedef float f32x2 __attribute__((ext_vector_type(2)));
typedef short bf16x8 __attribute__((ext_vector_type(8)));

constexpr int NB = 4, SEQ = 8192, D = 1024, NTOK = NB * SEQ;
constexpr int DSSM = 512, DCONV = 512, NG = 32, GH = 16, NP = 64, DIN = 1536, CW = 31;
constexpr int NE = 32, TOPK = 4, FF = 1024;
constexpr int TCH = 32, NCH = SEQ / TCH, NROW2 = NB * NCH, U2G = 640, U2LD = NG * U2G;
constexpr int NWAVES = 8, NTHR = 512;
constexpr int LDS_BYTES = 147456;
constexpr int CAP = NTOK;

enum { I_X = 0, I_C, I_ADAW, I_ADAB, I_N1G, I_WIN, I_LRE, I_LIM, I_LDT, I_BRE, I_BIM, I_CRE, I_CIM, I_DSK, I_WGLU, I_BGLU, I_CONVW, I_CONVB, I_LNG, I_LNB,
       I_ONG, I_WOUT, I_N2G, I_RW, I_RB, I_WG, I_BG, I_WU, I_BU, I_WD, I_BD, I_FG };

constexpr size_t MiB = 1u << 20;
constexpr size_t WS_WIN = 0 * MiB;
constexpr size_t WS_WGLU = 3 * MiB;
constexpr size_t WS_WOUT = 4 * MiB;
constexpr size_t WS_BTS = 6 * MiB;
constexpr size_t WS_BTY = 14 * MiB;
constexpr size_t WS_H2 = 0 * MiB;
constexpr size_t WS_YS3 = 0 * MiB;
constexpr size_t WS_CTL = 64 * MiB;
constexpr size_t WS_MOD = 64 * MiB + 65536;
constexpr size_t WS_TOPW = 65 * MiB;
constexpr size_t WS_TOKK = 66 * MiB;
constexpr size_t WS_RWT = 70 * MiB;
constexpr size_t WS_ACT = 72 * MiB;
constexpr size_t WS_SSQ = 72 * MiB;
constexpr size_t WS_H1 = 72 * MiB;
constexpr size_t WS_U2 = 136 * MiB;
constexpr size_t WS_SSQ2 = 136 * MiB;
constexpr size_t WS_Z = 176 * MiB;
constexpr size_t WS_SLOC = 208 * MiB;
constexpr size_t WS_YG = 224 * MiB;
constexpr size_t WS_MRG = 256 * MiB;
constexpr size_t WS_WD = 328 * MiB;
constexpr size_t WS_WGU = 392 * MiB;
constexpr size_t WS_YS12 = 392 * MiB;
constexpr size_t WS_END = 520 * MiB;
constexpr int CW_CNT = 8192  , CW_CONV = 64  , CW_MOD = 640, CW_P1 = 4608  , CW_CONVW = 5120  , CW_BAR = 1024, CW_YF = 10240  ;

struct Args { const float* in[32]; float* out; unsigned char* ws; int ph_lo, ph_hi, rep_mask, pad; };

__device__ __forceinline__ float bf2f(unsigned v) { return __builtin_bit_cast(float, v << 16); }
__device__ __forceinline__ unsigned f2bf(float f) { unsigned u = __builtin_bit_cast(unsigned, f); return (u + 0x7fffu + ((u >> 16) & 1u)) >> 16; }
__device__ __forceinline__ unsigned pk2(float lo, float hi) { unsigned r; asm("v_cvt_pk_bf16_f32 %0, %1, %2" : "=v"(r) : "v"(lo), "v"(hi)); return r; }
__device__ __forceinline__ float bflo(unsigned w) { return __builtin_bit_cast(float, w << 16); }
__device__ __forceinline__ float bfhi(unsigned w) { return __builtin_bit_cast(float, w & 0xffff0000u); }
__device__ __forceinline__ float sigmoidf_(float x) { return __builtin_amdgcn_rcpf(1.0f + __expf(-x)); }
__device__ __forceinline__ float siluf_(float x) { return x * sigmoidf_(x); }
__device__ __forceinline__ float gelu_tanh(float x) { const float u = 0.7978845608028654f * (x + 0.044715f * x * x * x); return x * sigmoidf_(2.0f * u); }
__device__ __forceinline__ f32x2 sig2(const f32x2 x, const float k  ) {
    const f32x2 t = x * k; f32x2 e; e.x = __builtin_amdgcn_exp2f(t.x); e.y = __builtin_amdgcn_exp2f(t.y);
    const f32x2 d = e + 1.0f; f32x2 r; r.x = __builtin_amdgcn_rcpf(d.x); r.y = __builtin_amdgcn_rcpf(d.y); return r; }
__device__ __forceinline__ f32x2 gelu2(const f32x2 x) {
    const f32x2 p = (x * x) * 0.044715f + 1.0f; return x * sig2(x * p, -1.4426950408889634f * 2.0f * 0.7978845608028654f); }
#define WS_DPP(v, ctrl, rmask) ((v) + __builtin_bit_cast(float, __builtin_amdgcn_update_dpp(0, __builtin_bit_cast(int, (v)), (ctrl), (rmask), 0xf, false)))
__device__ __forceinline__ unsigned xor16_u(unsigned v) { const auto r = __builtin_amdgcn_permlane16_swap(v, v, false, false); return ((__builtin_amdgcn_mbcnt_hi(~0u, __builtin_amdgcn_mbcnt_lo(~0u, 0u)) >> 4) & 1) ? r[0] : r[1]; }
__device__ __forceinline__ unsigned xor32_u(unsigned v) { const auto r = __builtin_amdgcn_permlane32_swap(v, v, false, false); return (__builtin_amdgcn_mbcnt_hi(~0u, __builtin_amdgcn_mbcnt_lo(~0u, 0u)) >> 5) ? r[0] : r[1]; }
__device__ __forceinline__ float sum_fq(float v) {
    { float a = v, b = v; asm volatile("s_nop 1\n\tv_permlane16_swap_b32 %0, %1" : "+v"(a), "+v"(b)); v = a + b; }
    { float a = v, b = v; asm volatile("s_nop 1\n\tv_permlane32_swap_b32 %0, %1" : "+v"(a), "+v"(b)); v = a + b; }
    return v; }
__device__ __forceinline__ float wave_sum(float v) {
    v = WS_DPP(v, 0x128, 0xf);
    v = WS_DPP(v, 0x124, 0xf);
    v = WS_DPP(v, 0x122, 0xf);
    v = WS_DPP(v, 0x121, 0xf);
    v = WS_DPP(v, 0x142, 0xa);
    v = WS_DPP(v, 0x143, 0xc);
    return __builtin_bit_cast(float, __builtin_amdgcn_readlane(__builtin_bit_cast(int, v), 63));
}
#define LDS_WAIT() asm volatile("s_waitcnt lgkmcnt(0)" ::: "memory")
#ifndef TIME_PHASE
#define TIME_PHASE -1
#endif
#if TIME_PHASE >= 0
extern __shared__ __attribute__((aligned(16))) unsigned char lds_raw_ts[];
#define STAMP(k) do { if (threadIdx.x == 0) ((LAS unsigned long long*)((LAS unsigned char*)lds_raw_ts + 131072 + 4096))[k] = __builtin_amdgcn_s_memrealtime(); } while (0)
#else
#define STAMP(k) do { } while (0)
#endif

__device__ __forceinline__ void p0_mod(const Args& a, LAS float* sm) {
    const float* c = a.in[I_C]; const float* W = a.in[I_ADAW]; const float* bias = a.in[I_ADAB];
    float* mod = (float*)(a.ws + WS_MOD);
    const int t = threadIdx.x, cl = t & 31, kq = t >> 5;
    if (blockIdx.x >= 192) return;
    LAS float* sc = sm + 2048;
    { float cv[NB * D / NTHR];
#pragma unroll
      for (int k = 0; k < NB * D / NTHR; ++k) cv[k] = c[t + NTHR * k];
#pragma unroll
      for (int k = 0; k < NB * D / NTHR; ++k) sc[t + NTHR * k] = siluf_(cv[k]); }
    __syncthreads();
    for (int item = blockIdx.x; item < 192; item += gridDim.x) {
        const int col = item * 32 + cl;
        float a0 = 0.f, a1 = 0.f, a2 = 0.f, a3 = 0.f;
#pragma unroll 16
        for (int k = kq; k < D; k += 16) {
            const float w = W[(size_t)k * (6 * D) + col];
            a0 += sc[k] * w; a1 += sc[D + k] * w; a2 += sc[2 * D + k] * w; a3 += sc[3 * D + k] * w;
        }
        sm[(kq * 32 + cl) * 4 + 0] = a0; sm[(kq * 32 + cl) * 4 + 1] = a1; sm[(kq * 32 + cl) * 4 + 2] = a2; sm[(kq * 32 + cl) * 4 + 3] = a3;
        __syncthreads();
        if (t < 128) { const int b = t >> 5; float s = 0.f;
#pragma unroll
            for (int q = 0; q < 16; ++q) s += sm[(q * 32 + cl) * 4 + b];
            mod[b * 6 * D + col] = s + bias[col]; }
        __syncthreads();
        if (t == 0) {
            __builtin_amdgcn_fence(__ATOMIC_RELEASE, "agent"); asm volatile("s_waitcnt vmcnt(0)" ::: "memory");
            __hip_atomic_fetch_add((unsigned*)(a.ws + WS_CTL) + CW_MOD, 1u, __ATOMIC_RELAXED, __HIP_MEMORY_SCOPE_AGENT);
        }
    }
}
__device__ __forceinline__ void mod_wait(const Args& a) {
    if (threadIdx.x == 0) {
        unsigned* f = (unsigned*)(a.ws + WS_CTL) + CW_MOD; unsigned sp = 0;
        while (__hip_atomic_load(f, __ATOMIC_RELAXED, __HIP_MEMORY_SCOPE_AGENT) < 192u) { __builtin_amdgcn_s_sleep(2); if (++sp > (1u << 24)) break; }
        __builtin_amdgcn_fence(__ATOMIC_ACQUIRE, "agent"); asm volatile("s_waitcnt vmcnt(0)" ::: "memory");
    }
    __syncthreads();
}

__device__ __forceinline__ void p1_router_item(const Args& a, int it, int lane);
__device__ __forceinline__ unsigned pk_fp8x4(float a, float b, float c, float d);
__device__ __forceinline__ void p1_dynamic(const Args& a, int lane) {
    const float* x = a.in[I_X]; const float* g = a.in[I_N1G]; const float* mod = (const float*)(a.ws + WS_MOD); bf16* h1 = (bf16*)(a.ws + WS_H1);
    constexpr int NIT = NB * NE + NTOK / 4;
    const int xq = blockIdx.x & 7, lo = (int)(((long)NIT * xq) >> 3), hi = (int)(((long)NIT * (xq + 1)) >> 3);
    unsigned* ctr = (unsigned*)(a.ws + WS_CTL) + CW_P1 + 64 * xq;
    for (;;) {
        int it0 = 0; if (lane == 0) it0 = (int)atomicAdd(ctr, 2u); it0 = __builtin_amdgcn_readfirstlane(it0) + lo;
        if (it0 >= hi) break;
#pragma unroll 1
        for (int it = it0; it < it0 + 2 && it < hi; ++it) {
        if (it < NB * NE) { p1_router_item(a, it, lane); continue; }
        const int m0 = (it - NB * NE) * 4;
        f32x4 v[4][4];
#pragma unroll
        for (int u = 0; u < 4; ++u)
#pragma unroll
            for (int j = 0; j < 4; ++j) v[u][j] = __builtin_nontemporal_load((const f32x4*)(x + (size_t)(m0 + u) * D) + lane + 64 * j);
        f32x4 pa[4], pb[4];
        { const int b = m0 >> 13;
#pragma unroll
          for (int j = 0; j < 4; ++j) { const int k = 4 * lane + 256 * j;
              const f32x4 gg = *(const f32x4*)(g + k), sh = *(const f32x4*)(mod + b * 6 * D + k), sc = *(const f32x4*)(mod + b * 6 * D + D + k);
              pa[j] = gg * (sc + 1.0f); pb[j] = sh; } }
#pragma unroll
        for (int u = 0; u < 4; ++u) {
            const int m = m0 + u; float s = 0.f;
#pragma unroll
            for (int j = 0; j < 4; ++j) s += (v[u][j].x * v[u][j].x + v[u][j].y * v[u][j].y) + (v[u][j].z * v[u][j].z + v[u][j].w * v[u][j].w);
            const float rstd = rsqrtf(wave_sum(s) * (1.f / D) + 1e-6f);
            unsigned long long* o8 = (unsigned long long*)(h1 + (size_t)m * D) + lane; (void)o8;
#pragma unroll
            for (int j = 0; j < 4; ++j) {
                const f32x4 h = v[u][j] * rstd * pa[j] + pb[j];
#if IN_F8
                ((unsigned*)((unsigned char*)h1 + (size_t)m * D) + lane)[64 * j] = pk_fp8x4(h.x, h.y, h.z, h.w);
#else
                o8[64 * j] = (unsigned long long)pk2(h.x, h.y) | ((unsigned long long)pk2(h.z, h.w) << 32);
#endif
            }
        }
        }
    }
}

__device__ __forceinline__ void unpack8(const v4u w, float (&f)[8]) {
    f[0] = bflo(w.x); f[1] = bfhi(w.x); f[2] = bflo(w.y); f[3] = bfhi(w.y); f[4] = bflo(w.z); f[5] = bfhi(w.z); f[6] = bflo(w.w); f[7] = bfhi(w.w);
}
__device__ __forceinline__ void p3e_conv(const Args& a, LAS float* sm, int lane) {
    constexpr int CT = 4;
    for (int i = threadIdx.x; i < CW * DCONV / 4; i += NTHR) { const int w = i >> 7, c4 = i & 127, ln = c4 >> 1, hf = c4 & 1;
        *(LAS f32x4*)(sm + ((w * 2 + hf) * 64 + ln) * 4) = *(const f32x4*)(a.in[I_CONVW] + w * DCONV + c4 * 4); }
    __syncthreads();
    const bf16* Z = (const bf16*)(a.ws + WS_Z); bf16* MRG = (bf16*)(a.ws + WS_MRG);
    const float* cw = a.in[I_CONVW]; const float* cb = a.in[I_CONVB]; const float* lng = a.in[I_LNG]; const float* lnb = a.in[I_LNB]; const float* ong = a.in[I_ONG];
    const int ch = lane * 8;
    const int xq = blockIdx.x & 7, ilo = (int)(((long)(NTOK / CT) * xq) >> 3), ihi = (int)(((long)(NTOK / CT) * (xq + 1)) >> 3);
    unsigned* ctr = (unsigned*)(a.ws + WS_CTL) + CW_CONVW + 64 * xq;
    for (;;) {
      int it0 = 0; if (lane == 0) it0 = (int)atomicAdd(ctr, 4u); it0 = __builtin_amdgcn_readfirstlane(it0) + ilo;
      if (it0 >= ihi) break;
#pragma unroll 1
      for (int it = it0; it < it0 + 4 && it < ihi; ++it) {
        const int t0 = it * CT, l0 = t0 & (SEQ - 1);
        int chw = ch; asm volatile("" : "+v"(chw));
        const unsigned zo = (unsigned)(((t0 - (CW - 1)) * DCONV + chw) * 2), wo = (unsigned)(chw * 4);
#define ZROW(j) (*(const v4u*)((const char*)Z + (unsigned)(zo + (unsigned)(j) * (DCONV * 2))))
#define WROW(w, q) (*(const LAS f32x4*)(sm + (((w) * 2 + (q)) * 64 + lane) * 4))
        f32x2 acc[CT][4];
        { const f32x4 b0 = *(const f32x4*)(cb + chw), b1 = *(const f32x4*)(cb + chw + 4);
#pragma unroll
          for (int i = 0; i < CT; ++i) { acc[i][0] = (f32x2){b0.x, b0.y}; acc[i][1] = (f32x2){b0.z, b0.w}; acc[i][2] = (f32x2){b1.x, b1.y}; acc[i][3] = (f32x2){b1.z, b1.w}; } }
        f32x2 act[CT][4]; v4u ring[8];
#pragma unroll
        for (int j = 0; j < CT + 8; ++j) { v4u r = (v4u){0u, 0u, 0u, 0u}; if (l0 - (CW - 1) + j >= 0) r = ZROW(j);
            if (j < CT) { act[j][0] = (f32x2){bflo(r.x), bfhi(r.x)}; act[j][1] = (f32x2){bflo(r.y), bfhi(r.y)}; act[j][2] = (f32x2){bflo(r.z), bfhi(r.z)}; act[j][3] = (f32x2){bflo(r.w), bfhi(r.w)}; } else ring[(j - CT) & 7] = r; }
#pragma nounroll
        for (int wq = 0; wq < 4; ++wq) {
#pragma unroll
            for (int r = 0; r < 8; ++r) {
                const int w = wq * 8 + r;
                if (w < CW) {
                    const f32x4 w0 = WROW(w, 0), w1 = WROW(w, 1);
                    const f32x2 wv[4] = {(f32x2){w0.x, w0.y}, (f32x2){w0.z, w0.w}, (f32x2){w1.x, w1.y}, (f32x2){w1.z, w1.w}};
#pragma unroll
                    for (int i = 0; i < CT; ++i) {
#pragma unroll
                        for (int c = 0; c < 4; ++c) acc[i][c] += act[(r + i) % CT][c] * wv[c];
                    }
                    if (w < CW - 1) {
                        const v4u rr = ring[r];
                        act[r % CT][0] = (f32x2){bflo(rr.x), bfhi(rr.x)}; act[r % CT][1] = (f32x2){bflo(rr.y), bfhi(rr.y)}; act[r % CT][2] = (f32x2){bflo(rr.z), bfhi(rr.z)}; act[r % CT][3] = (f32x2){bflo(rr.w), bfhi(rr.w)};
                        if (w + 8 < CW - 1) { const int j = w + CT + 8; ring[r] = (v4u){0u, 0u, 0u, 0u}; if (l0 - (CW - 1) + j >= 0) ring[r] = ZROW(j); }
                    }
                }
            }
        }
#undef ZROW
#undef WROW
        const f32x4 g0 = *(const f32x4*)(lng + chw), g1 = *(const f32x4*)(lng + chw + 4), be0 = *(const f32x4*)(lnb + chw), be1 = *(const f32x4*)(lnb + chw + 4);
        const f32x4 o0 = *(const f32x4*)(ong + DSSM + chw), o1 = *(const f32x4*)(ong + DSSM + chw + 4);
        const float gv[8] = {g0.x, g0.y, g0.z, g0.w, g1.x, g1.y, g1.z, g1.w}, bv[8] = {be0.x, be0.y, be0.z, be0.w, be1.x, be1.y, be1.z, be1.w};
        const float ov[8] = {o0.x, o0.y, o0.z, o0.w, o1.x, o1.y, o1.z, o1.w};
        float mean[CT], rstd[CT];
        { float s[CT];
#pragma unroll
          for (int i = 0; i < CT; ++i) { const f32x2 t = (acc[i][0] + acc[i][1]) + (acc[i][2] + acc[i][3]); s[i] = t.x + t.y; }
#pragma unroll
          for (int i = 0; i < CT; ++i) s[i] = wave_sum(s[i]);
#pragma unroll
          for (int i = 0; i < CT; ++i) mean[i] = s[i] * (1.f / DCONV);
          float q[CT];
#pragma unroll
          for (int i = 0; i < CT; ++i) { f32x2 t = {0.f, 0.f};
#pragma unroll
              for (int c = 0; c < 4; ++c) { const f32x2 d = acc[i][c] - mean[i]; t += d * d; }
              q[i] = t.x + t.y; }
#pragma unroll
          for (int i = 0; i < CT; ++i) q[i] = wave_sum(q[i]);
#pragma unroll
          for (int i = 0; i < CT; ++i) rstd[i] = rsqrtf(q[i] * (1.f / DCONV) + 1e-5f); }
        float ss[CT];
#pragma unroll
        for (int i = 0; i < CT; ++i) { f32x2 t = {0.f, 0.f};
#pragma unroll
            for (int c = 0; c < 4; ++c) { f32x2 v = (acc[i][c] - mean[i]) * rstd[i] * (f32x2){gv[2 * c], gv[2 * c + 1]} + (f32x2){bv[2 * c], bv[2 * c + 1]}; v.x = siluf_(v.x); v.y = siluf_(v.y); acc[i][c] = v; t += v * v; }
            ss[i] = t.x + t.y; }
#pragma unroll
        for (int i = 0; i < CT; ++i) ss[i] = wave_sum(ss[i]);
#pragma unroll
        for (int i = 0; i < CT; ++i) {
            const float r2 = rsqrtf(ss[i] * (1.f / DCONV) + 1e-6f);
            v4u o; o.x = pk2(acc[i][0].x * r2 * ov[0], acc[i][0].y * r2 * ov[1]); o.y = pk2(acc[i][1].x * r2 * ov[2], acc[i][1].y * r2 * ov[3]);
            o.z = pk2(acc[i][2].x * r2 * ov[4], acc[i][2].y * r2 * ov[5]); o.w = pk2(acc[i][3].x * r2 * ov[6], acc[i][3].y * r2 * ov[7]);
            *(v4u*)(MRG + (size_t)(t0 + i) * D + DSSM + chw) = o;
        }
      }
    }
}
__device__ __forceinline__ void p3e_norm(const Args& a, int gw, int ngw, int lane) {
    bf16* MRG = (bf16*)(a.ws + WS_MRG); const float* ong = a.in[I_ONG]; const int ch = lane * 8;
    const f32x4 o0 = *(const f32x4*)(ong + ch), o1 = *(const f32x4*)(ong + ch + 4);
    const float ov[8] = {o0.x, o0.y, o0.z, o0.w, o1.x, o1.y, o1.z, o1.w};
    v4u r[8];
#pragma unroll
    for (int u = 0; u < 8; ++u) { const int m = (gw + u * ngw < NTOK) ? gw + u * ngw : gw; r[u] = *(const v4u*)(MRG + (size_t)m * D + ch); }
    for (int m0 = gw; m0 < NTOK; m0 += 8 * ngw) {
        v4u c[8];
#pragma unroll
        for (int u = 0; u < 8; ++u) c[u] = r[u];
#pragma unroll
        for (int u = 0; u < 8; ++u) { const int mn = m0 + (8 + u) * ngw, m = (mn < NTOK) ? mn : gw; r[u] = *(const v4u*)(MRG + (size_t)m * D + ch); }
        asm volatile("" ::: "memory");
#pragma unroll
        for (int u = 0; u < 8; ++u) {
            const int m = m0 + u * ngw;
            if (m < NTOK) {
                float f[8]; unpack8(c[u], f);
                float ss = 0.f;
#pragma unroll
                for (int q = 0; q < 8; ++q) ss += f[q] * f[q];
                const float r2 = rsqrtf(wave_sum(ss) * (1.f / DSSM) + 1e-6f);
                v4u o; o.x = pk2(f[0] * r2 * ov[0], f[1] * r2 * ov[1]); o.y = pk2(f[2] * r2 * ov[2], f[3] * r2 * ov[3]);
                o.z = pk2(f[4] * r2 * ov[4], f[5] * r2 * ov[5]); o.w = pk2(f[6] * r2 * ov[6], f[7] * r2 * ov[7]);
                *(v4u*)(MRG + (size_t)m * D + ch) = o;
            }
        }
        asm volatile("" ::: "memory");
    }
}

__device__ __forceinline__ void p3c_pair(const Args& a, LAS unsigned char* lds, int g, int pm, int pn0, int n);
__device__ __forceinline__ int p3e_conv2(const Args& a, LAS unsigned char* lds, LAS float* sm, int lane, int pend) {
    constexpr int CT = 4, TC = 32, NR = TC + CW - 1;
    int tid = threadIdx.x; asm volatile("" : "+v"(tid), "+v"(lane));
#define CONV_STAGE_W() do { for (int i = tid; i < CW * DCONV / 4; i += NTHR) { const int w = i >> 7, c4 = i & 127, ln = c4 >> 1, hf = c4 & 1; \
        *(LAS f32x4*)(sm + ((w * 2 + hf) * 64 + ln) * 4) = *(const f32x4*)(a.in[I_CONVW] + w * DCONV + c4 * 4); } } while (0)
    CONV_STAGE_W();
    unsigned* yflag = (unsigned*)(a.ws + WS_CTL) + CW_YF + 32 * (pend >= 0 ? pend : 0);
    LAS unsigned char* RB = lds + 65536;
    volatile LAS int* slot = (volatile LAS int*)(lds + 131072 + 2048 + 64);
    const bf16* Z = (const bf16*)(a.ws + WS_Z); bf16* MRG = (bf16*)(a.ws + WS_MRG);
    const float* cb = a.in[I_CONVB]; const float* lng = a.in[I_LNG]; const float* lnb = a.in[I_LNB]; const float* ong = a.in[I_ONG];
    const int ch = lane * 8, wave = __builtin_amdgcn_readfirstlane(tid >> 6);
    const int xq = blockIdx.x & 7, ilo = (int)(((long)(NTOK / TC) * xq) >> 3), ihi = (int)(((long)(NTOK / TC) * (xq + 1)) >> 3);
    unsigned* ctr = (unsigned*)(a.ws + WS_CTL) + CW_CONVW + 64 * xq;
#define CONV_STAGE(itx) do { const int _t0 = (itx) * TC, _l0 = _t0 & (SEQ - 1); for (int j = wave; j < NR; j += NWAVES) { \
            if (_l0 - (CW - 1) + j >= 0) __builtin_amdgcn_global_load_lds((const unsigned*)((const char*)Z + ((size_t)(_t0 - (CW - 1) + j) * DCONV + ch) * 2), (LAS unsigned*)(RB + j * 1024), 16, 0, 0); \
            else *(LAS v4u*)(RB + j * 1024 + lane * 16) = (v4u){0u, 0u, 0u, 0u}; } } while (0)
    constexpr int PFM = 40;
    __syncthreads();
    if (tid == 0) { const int rdy0 = (pend >= 0) ? (int)__hip_atomic_load(yflag, __ATOMIC_RELAXED, __HIP_MEMORY_SCOPE_AGENT) : 0; slot[1] = rdy0; if (!rdy0) slot[0] = (int)atomicAdd(ctr, 1u) + ilo; }
    __syncthreads();
    if (__builtin_amdgcn_readfirstlane(slot[1])) return 1;
    int it = __builtin_amdgcn_readfirstlane(slot[0]);
    if (it >= ihi) return 0;
    CONV_STAGE(it);
    for (;;) {
        asm volatile("s_waitcnt vmcnt(0)" ::: "memory");
        __syncthreads();
        int nreq = -1, rdyv = 0;
        if (tid == 0) { rdyv = (pend >= 0) ? (int)__hip_atomic_load(yflag, __ATOMIC_RELAXED, __HIP_MEMORY_SCOPE_AGENT) : 0;
            if (!rdyv && ihi - it > PFM) nreq = (int)atomicAdd(ctr, 1u) + ilo; }
        const int t0 = it * TC;
        int chw = ch; asm volatile("" : "+v"(chw));
        const LAS unsigned char* rb = RB + (CT * wave) * 1024 + lane * 16;
        const f32x4 g0 = *(const f32x4*)(lng + chw), g1 = *(const f32x4*)(lng + chw + 4), be0 = *(const f32x4*)(lnb + chw), be1 = *(const f32x4*)(lnb + chw + 4);
        const f32x4 o0 = *(const f32x4*)(ong + DSSM + chw), o1 = *(const f32x4*)(ong + DSSM + chw + 4);
#define LROW(j) (*(const LAS v4u*)(rb + (j) * 1024))
#define WROW(w, q) (*(const LAS f32x4*)(sm + (((w) * 2 + (q)) * 64 + lane) * 4))
        f32x2 acc[CT][4];
        { const f32x4 b0 = *(const f32x4*)(cb + chw), b1 = *(const f32x4*)(cb + chw + 4);
#pragma unroll
          for (int i = 0; i < CT; ++i) { acc[i][0] = (f32x2){b0.x, b0.y}; acc[i][1] = (f32x2){b0.z, b0.w}; acc[i][2] = (f32x2){b1.x, b1.y}; acc[i][3] = (f32x2){b1.z, b1.w}; } }
        f32x2 act[CT][4];
#pragma unroll
        for (int j = 0; j < CT; ++j) { const v4u r = LROW(j); act[j][0] = (f32x2){bflo(r.x), bfhi(r.x)}; act[j][1] = (f32x2){bflo(r.y), bfhi(r.y)}; act[j][2] = (f32x2){bflo(r.z), bfhi(r.z)}; act[j][3] = (f32x2){bflo(r.w), bfhi(r.w)}; }
#pragma nounroll
        for (int wq = 0; wq < 4; ++wq) {
#pragma unroll
            for (int r = 0; r < 8; ++r) {
                const int w = wq * 8 + r;
                if (w < CW) {
                    const f32x4 w0 = WROW(w, 0), w1 = WROW(w, 1);
                    const f32x2 wv[4] = {(f32x2){w0.x, w0.y}, (f32x2){w0.z, w0.w}, (f32x2){w1.x, w1.y}, (f32x2){w1.z, w1.w}};
#pragma unroll
                    for (int i = 0; i < CT; ++i) {
#pragma unroll
                        for (int c = 0; c < 4; ++c) acc[i][c] += act[(r + i) % CT][c] * wv[c];
                    }
                    if (w < CW - 1) {
                        const v4u rr = LROW(w + CT);
                        act[r % CT][0] = (f32x2){bflo(rr.x), bfhi(rr.x)}; act[r % CT][1] = (f32x2){bflo(rr.y), bfhi(rr.y)}; act[r % CT][2] = (f32x2){bflo(rr.z), bfhi(rr.z)}; act[r % CT][3] = (f32x2){bflo(rr.w), bfhi(rr.w)};
                    }
                }
            }
        }
#undef LROW
#undef WROW
        if (tid == 0) { slot[0] = nreq; slot[1] = rdyv; }
        __syncthreads();
        const int itn = __builtin_amdgcn_readfirstlane(slot[0]), rdy = __builtin_amdgcn_readfirstlane(slot[1]);
        if (itn >= 0 && itn < ihi) CONV_STAGE(itn);
        const float gv[8] = {g0.x, g0.y, g0.z, g0.w, g1.x, g1.y, g1.z, g1.w}, bv[8] = {be0.x, be0.y, be0.z, be0.w, be1.x, be1.y, be1.z, be1.w};
        const float ov[8] = {o0.x, o0.y, o0.z, o0.w, o1.x, o1.y, o1.z, o1.w};
        float mean[CT], rstd[CT];
        { float sv[CT];
#pragma unroll
          for (int i = 0; i < CT; ++i) { const f32x2 t = (acc[i][0] + acc[i][1]) + (acc[i][2] + acc[i][3]); sv[i] = t.x + t.y; }
#pragma unroll
          for (int i = 0; i < CT; ++i) sv[i] = wave_sum(sv[i]);
#pragma unroll
          for (int i = 0; i < CT; ++i) mean[i] = sv[i] * (1.f / DCONV);
          float q[CT];
#pragma unroll
          for (int i = 0; i < CT; ++i) { f32x2 t = {0.f, 0.f};
#pragma unroll
              for (int c = 0; c < 4; ++c) { const f32x2 d = acc[i][c] - mean[i]; t += d * d; }
              q[i] = t.x + t.y; }
#pragma unroll
          for (int i = 0; i < CT; ++i) q[i] = wave_sum(q[i]);
#pragma unroll
          for (int i = 0; i < CT; ++i) rstd[i] = rsqrtf(q[i] * (1.f / DCONV) + 1e-5f); }
        float ss[CT];
#pragma unroll
        for (int i = 0; i < CT; ++i) { f32x2 t = {0.f, 0.f};
#pragma unroll
            for (int c = 0; c < 4; ++c) { f32x2 v = (acc[i][c] - mean[i]) * rstd[i] * (f32x2){gv[2 * c], gv[2 * c + 1]} + (f32x2){bv[2 * c], bv[2 * c + 1]}; v.x = siluf_(v.x); v.y = siluf_(v.y); acc[i][c] = v; t += v * v; }
            ss[i] = t.x + t.y; }
#pragma unroll
        for (int i = 0; i < CT; ++i) ss[i] = wave_sum(ss[i]);
#pragma unroll
        for (int i = 0; i < CT; ++i) {
            const float r2 = rsqrtf(ss[i] * (1.f / DCONV) + 1e-6f);
            v4u o; o.x = pk2(acc[i][0].x * r2 * ov[0], acc[i][0].y * r2 * ov[1]); o.y = pk2(acc[i][1].x * r2 * ov[2], acc[i][1].y * r2 * ov[3]);
            o.z = pk2(acc[i][2].x * r2 * ov[4], acc[i][2].y * r2 * ov[5]); o.w = pk2(acc[i][3].x * r2 * ov[6], acc[i][3].y * r2 * ov[7]);
            *(v4u*)(MRG + (size_t)(t0 + CT * wave + i) * D + DSSM + chw) = o;
        }
        if (itn >= 0) { if (itn >= ihi) return 0; it = itn; continue; }
        if (rdy) return 1;
        __syncthreads();
        if (tid == 0) { const int rdy0 = (pend >= 0) ? (int)__hip_atomic_load(yflag, __ATOMIC_RELAXED, __HIP_MEMORY_SCOPE_AGENT) : 0; slot[1] = rdy0; if (!rdy0) slot[0] = (int)atomicAdd(ctr, 1u) + ilo; }
        __syncthreads();
        if (__builtin_amdgcn_readfirstlane(slot[1])) return 1;
        it = __builtin_amdgcn_readfirstlane(slot[0]);
        if (it >= ihi) return 0;
        CONV_STAGE(it);
    }
#undef CONV_STAGE
    return 0;
}

__device__ __forceinline__ void moe_tables(const Args& a, LAS int* T) {
    const unsigned* cnt = (const unsigned*)(a.ws + WS_CTL) + CW_CNT;
    if (threadIdx.x < 64) {
        const int l = threadIdx.x, e = l & 31;
        const int c = (int)__hip_atomic_load(cnt + 32 * e, __ATOMIC_RELAXED, __HIP_MEMORY_SCOPE_AGENT);
        int rb = c, t64 = (c + 63) >> 6, t256 = (c + 255) >> 8;
#pragma unroll
        for (int d = 1; d < 32; d <<= 1) {
            const int r0 = __shfl_up(rb, d, 32), r1 = __shfl_up(t64, d, 32), r2 = __shfl_up(t256, d, 32);
            if (e >= d) { rb += r0; t64 += r1; t256 += r2; }
        }
        if (l < 32) { T[e] = c; T[32 + e + 1] = rb; T[65 + e + 1] = t64; T[98 + e + 1] = t256; if (e == 0) { T[32] = 0; T[65] = 0; T[98] = 0; } }
    }
    __syncthreads();
    { const int e = threadIdx.x >> 4, k = threadIdx.x & 15, t0 = T[98 + e], t1 = T[98 + e + 1];
      for (int t = t0 + k; t < t1; t += 16) T[1280 + t] = e;
      const int tend = T[98 + NE]; if (e == NE - 1) for (int t = tend + k; t < 640; t += 16) T[1280 + t] = NE - 1; }
    __syncthreads();
}

__device__ __forceinline__ bf16* ys_ptr(const Args& a, int tok, int k) {
    if (k == 0) return (bf16*)(a.out + (size_t)tok * D);
    if (k == 3) return (bf16*)(a.ws + WS_YS3) + (size_t)tok * D;
    return (bf16*)(a.ws + WS_YS12) + ((size_t)(k - 1) * NTOK + tok) * D;
}

#if YS_F8
typedef v2u ys8_t;
__device__ __forceinline__ void unpack_ys(const ys8_t w, float (&f)[8]) {
    const f32x2 a = __builtin_amdgcn_cvt_pk_f32_fp8(w.x, false), b = __builtin_amdgcn_cvt_pk_f32_fp8(w.x, true), c = __builtin_amdgcn_cvt_pk_f32_fp8(w.y, false), d = __builtin_amdgcn_cvt_pk_f32_fp8(w.y, true);
    f[0] = a.x; f[1] = a.y; f[2] = b.x; f[3] = b.y; f[4] = c.x; f[5] = c.y; f[6] = d.x; f[7] = d.y; }
__device__ __forceinline__ ys8_t load_ys(const Args& a, int tok, int k, int ch) {
    const unsigned char* p = (k == 0) ? (const unsigned char*)(a.out + (size_t)tok * D) : (k == 3) ? (a.ws + WS_YS3) + (size_t)tok * D : (a.ws + WS_YS12) + ((size_t)(k - 1) * NTOK + tok) * D;
    return __builtin_nontemporal_load((const ys8_t*)(p + ch)); }
#else
typedef v4u ys8_t;
__device__ __forceinline__ void unpack_ys(const ys8_t w, float (&f)[8]) { unpack8(w, f); }
__device__ __forceinline__ ys8_t load_ys(const Args& a, int tok, int k, int ch) { return *(const ys8_t*)(ys_ptr(a, tok, k) + ch); }
#endif
struct P9Ld { v4u x[2]; ys8_t y[4][2]; f32x4 w; };
__device__ __forceinline__ P9Ld p9_load(const Args& a, int tok, int lane) {
    P9Ld r; r.w = *(const f32x4*)((const float*)(a.ws + WS_TOPW) + tok * 4);
#pragma unroll
    for (int q = 0; q < 2; ++q) {
        const int ch = lane * 8 + 512 * q;
        r.x[q] = __builtin_nontemporal_load((const v4u*)((const bf16*)(a.out + (size_t)tok * D) + D + ch));
#pragma unroll
        for (int k = 0; k < 4; ++k) r.y[k][q] = load_ys(a, tok, k, ch);
    }
    return r;
}
__device__ __forceinline__ void p9_token(const Args& a, const P9Ld& r, int tok, int lane) {
    const float* mod = (const float*)(a.ws + WS_MOD); const float* fg = a.in[I_FG];
    const int b = tok >> 13;
    float xo[2][8], ss = 0.f;
#pragma unroll
    for (int q = 0; q < 2; ++q) {
        const int ch = lane * 8 + 512 * q;
        float x1[8], y0[8], y1[8], y2[8], y3[8];
        unpack8(r.x[q], x1); unpack_ys(r.y[0][q], y0); unpack_ys(r.y[1][q], y1); unpack_ys(r.y[2][q], y2); unpack_ys(r.y[3][q], y3);
        const f32x4 g0 = *(const f32x4*)(mod + b * 6 * D + 5 * D + ch), g1 = *(const f32x4*)(mod + b * 6 * D + 5 * D + ch + 4);
        const float g2[8] = {g0.x, g0.y, g0.z, g0.w, g1.x, g1.y, g1.z, g1.w};
#pragma unroll
        for (int c = 0; c < 8; ++c) { xo[q][c] = x1[c] + g2[c] * (((r.w.x * y0[c] + r.w.y * y1[c]) + r.w.z * y2[c]) + r.w.w * y3[c]); ss += xo[q][c] * xo[q][c]; }
    }
    const float rstd = rsqrtf(wave_sum(ss) * (1.f / D) + 1e-6f);
#pragma unroll
    for (int q = 0; q < 2; ++q) {
        const int ch = lane * 8 + 512 * q;
        const f32x4 f0 = *(const f32x4*)(fg + ch), f1 = *(const f32x4*)(fg + ch + 4);
        f32x4 o0, o1;
        o0.x = xo[q][0] * rstd * f0.x; o0.y = xo[q][1] * rstd * f0.y; o0.z = xo[q][2] * rstd * f0.z; o0.w = xo[q][3] * rstd * f0.w;
        o1.x = xo[q][4] * rstd * f1.x; o1.y = xo[q][5] * rstd * f1.y; o1.z = xo[q][6] * rstd * f1.z; o1.w = xo[q][7] * rstd * f1.w;
        f32x4* op = (f32x4*)(a.out + (size_t)tok * D + ch);
        __builtin_nontemporal_store(o0, op); __builtin_nontemporal_store(o1, op + 1);
    }
}
__device__ __forceinline__ void p9_final(const Args& a, int gw, int ngw, int lane) {
    P9Ld r0 = p9_load(a, gw < NTOK ? gw : 0, lane), r1 = p9_load(a, gw + ngw < NTOK ? gw + ngw : 0, lane);
    for (int tok = gw; tok < NTOK; tok += 2 * ngw) {
        { const P9Ld cu = r0; const int tn = tok + 2 * ngw; r0 = p9_load(a, tn < NTOK ? tn : tok, lane);
          asm volatile("" ::: "memory"); p9_token(a, cu, tok, lane); asm volatile("" ::: "memory"); }
        if (tok + ngw < NTOK) { const P9Ld cu = r1; const int tn = tok + 3 * ngw; r1 = p9_load(a, tn < NTOK ? tn : tok + ngw, lane);
          asm volatile("" ::: "memory"); p9_token(a, cu, tok + ngw, lane); asm volatile("" ::: "memory"); }
    }
}

namespace pg8 {
constexpr int BM = 256, BK = 64, HALF = 128, HTB = HALF * BK * 2  , STAGE_BYTES = 8 * HTB, NXCD = 8, WGM = 8;
__host__ __device__ __forceinline__ int lds_byte(int r, int c) { const int st = (r >> 4) * 2 + (c >> 5), rr = r & 15, cc = c & 31, ob = rr * 64 + cc * 2; return st * 1024 + (ob ^ (((ob >> 9) & 1) << 5)); }
__host__ __device__ __forceinline__ void stage_rc(int b, int& R, int& C) { const int st = b / 1024, sb = b % 1024, swz = sb ^ (((sb >> 9) & 1) << 5); R = (st >> 1) * 16 + swz / 64; C = (st & 1) * 32 + (swz % 64) / 2; }
__host__ __device__ __forceinline__ int perm32(int rho) { const int n = rho >> 4, i = rho & 15; return 8 * (i >> 2) + 4 * n + (i & 3); }
struct Unit { int pm, pn, e, row0, slot0, nvalid, sb; };
typedef int v8i __attribute__((ext_vector_type(8)));
__device__ __forceinline__ v8i cat8(const bf16x8 lo, const bf16x8 hi) { typedef int v4i __attribute__((ext_vector_type(4))); const v4i a = __builtin_bit_cast(v4i, lo), b = __builtin_bit_cast(v4i, hi); return (v8i){a[0], a[1], a[2], a[3], b[0], b[1], b[2], b[3]}; }
__device__ __forceinline__ bf16x8 lo8(const v8i v) { typedef int v4i __attribute__((ext_vector_type(4))); return __builtin_bit_cast(bf16x8, __builtin_shufflevector(v, v, 0, 1, 2, 3)); }
__device__ __forceinline__ bf16x8 hi8(const v8i v) { typedef int v4i __attribute__((ext_vector_type(4))); return __builtin_bit_cast(bf16x8, __builtin_shufflevector(v, v, 4, 5, 6, 7)); }
__device__ __forceinline__ unsigned cvt_pk_bf16(float lo, float hi) { unsigned r; asm volatile("v_cvt_pk_bf16_f32 %0, %1, %2" : "=v"(r) : "v"(lo), "v"(hi)); return r; }

template <class Epi, class Sched, bool ALIGN_EPI, bool F8 = false>
__device__ __forceinline__ void gemm_phase(LAS unsigned char* lds, const Sched& S, const Epi& E) {
    int tid = threadIdx.x; asm volatile("" : "+v"(tid));
    const int wid = __builtin_amdgcn_readfirstlane(tid >> 6), lane = tid & 63, wr = wid >> 2, wc = wid & 3, fr = lane & 15, fq = lane >> 4;
    constexpr int EB = F8 ? 1 : 2;
    const int nt = S.K / (128 / EB);
    int R[2], C[2]; unsigned voffB[2];
#pragma unroll
    for (int i = 0; i < 2; ++i) { stage_rc(tid * 16 + i * 8192, R[i], C[i]); const int Rb = Epi::PERM ? ((R[i] & ~31) + perm32(R[i] & 31)) : R[i]; voffB[i] = (unsigned)(Rb * S.ldb * EB + C[i] * 2); }
    const size_t kstep = (size_t)(BK * 2);
    const size_t bhstep = (size_t)HALF * S.ldb * EB;
    const unsigned ldsw = (unsigned)wid * 1024u;
    const int aoff = lds_byte(wr * 64 + fr, fq * 8), boff = lds_byte(wc * 32 + fr, fq * 8);
#define PG8_SA(b, h) (((b) * 2 + (h)) * HTB)
#define PG8_SB(b, h) ((4 + (b) * 2 + (h)) * HTB)
#define PG8_STAGE(bufoff, gbase, voff) do { _Pragma("unroll") for (int _i = 0; _i < 2; ++_i) \
        __builtin_amdgcn_global_load_lds((const unsigned*)((const char*)(gbase) + (voff)[_i]), (LAS unsigned*)(lds + (bufoff) + ldsw + _i * 8192), 16, 0, 0); } while (0)
#define PG8_LDA(dst, b, h) do { _Pragma("unroll") for (int m = 0; m < 4; ++m) dst[m] = cat8(*(const LAS bf16x8*)(lds + PG8_SA(b, h) + aoff + m * 2048), *(const LAS bf16x8*)(lds + PG8_SA(b, h) + aoff + m * 2048 + 1024)); } while (0)
#define PG8_LDB(dst, b, h) do { _Pragma("unroll") for (int n = 0; n < 2; ++n) dst[n] = cat8(*(const LAS bf16x8*)(lds + PG8_SB(b, h) + boff + n * 2048), *(const LAS bf16x8*)(lds + PG8_SB(b, h) + boff + n * 2048 + 1024)); } while (0)
#define PG8_MMA(ai, bj, At, Bt) do { __builtin_amdgcn_s_setprio(1); \
        if constexpr (F8) { _Pragma("unroll") for (int m = 0; m < 4; ++m) _Pragma("unroll") for (int n = 0; n < 2; ++n) \
            asm volatile(".p2align 3\n\tv_mfma_scale_f32_16x16x128_f8f6f4 %0, %1, %2, %0, %3, %4 op_sel_hi:[0,0,0]" : "+v"(acc[ai][bj][m][n]) : "v"(Bt[n]), "v"(At[m]), "v"(f8sb), "v"(f8sa)); } \
        else { _Pragma("unroll") for (int m = 0; m < 4; ++m) _Pragma("unroll") for (int n = 0; n < 2; ++n) \
                asm volatile(".p2align 3\n\tv_mfma_f32_16x16x32_bf16 %0, %1, %2, %0" : "+v"(acc[ai][bj][m][n]) : "v"(lo8(Bt[n])), "v"(lo8(At[m]))); \
            _Pragma("unroll") for (int m = 0; m < 4; ++m) _Pragma("unroll") for (int n = 0; n < 2; ++n) \
                asm volatile(".p2align 3\n\tv_mfma_f32_16x16x32_bf16 %0, %1, %2, %0" : "+v"(acc[ai][bj][m][n]) : "v"(hi8(Bt[n])), "v"(hi8(At[m]))); } \
        __builtin_amdgcn_s_setprio(0); } while (0)
#define PG8_WAIT_V(n) asm volatile("s_waitcnt vmcnt(" #n ")" ::: "memory")
#define PG8_WAIT_L(n) asm volatile("s_waitcnt lgkmcnt(" #n ")" ::: "memory")
#define PG8_BAR __builtin_amdgcn_s_barrier()
#define PG8_SCHED __builtin_amdgcn_sched_barrier(0)
    Unit cur, nxt; int ui = 0; cur.e = 0;
    int tside = Epi::SIDE ? 4 : -1; asm volatile("" : "+s"(tside));
    int tmid = Epi::HAS_MID ? nt / 2 : -1; asm volatile("" : "+s"(tmid));
    if (!S.next(0, cur)) return;
    nxt = cur;
    f32x4 acc[2][2][4][2];
#pragma unroll
    for (int a = 0; a < 2; ++a)
#pragma unroll
        for (int b = 0; b < 2; ++b)
#pragma unroll
            for (int m = 0; m < 4; ++m)
#pragma unroll
                for (int n = 0; n < 2; ++n) acc[a][b][m][n] = (f32x4){0.f, 0.f, 0.f, 0.f};
    const int f8sa = S.scale_a, f8sb = S.scale_b;
    v8i At[4], B0[2], B1[2];
    unsigned ao[2][2], an[2][2];
    S.a_offsets(cur, R, C, ao);
    const char* cA = S.a_base(cur); const char* cB = S.b_base(cur);
    PG8_STAGE(PG8_SB(0, 0), cB, voffB); PG8_STAGE(PG8_SB(0, 1), cB + bhstep, voffB); PG8_STAGE(PG8_SA(0, 0), cA, ao[0]); PG8_STAGE(PG8_SA(0, 1), cA, ao[1]);
    if (wr == 1) PG8_BAR;
    PG8_WAIT_V(2); PG8_BAR;
    PG8_STAGE(PG8_SB(1, 0), cB + kstep, voffB); PG8_STAGE(PG8_SA(1, 0), cA + kstep, ao[0]); PG8_STAGE(PG8_SB(1, 1), cB + bhstep + kstep, voffB);
    PG8_WAIT_V(6); PG8_BAR;
#if TIME_PHASE >= 0
    unsigned long long tk0 = 0, tk1 = 0, tacc_k = 0, tacc_e = 0;
#endif
    for (;;) {
#if TIME_PHASE >= 0
        if (S.tstamp) tk0 = __builtin_amdgcn_s_memrealtime();
#endif
        const bool has_next = S.next(ui + 1, nxt);
        const char* nA = cA; const char* nB = cB;
#pragma unroll
        for (int h = 0; h < 2; ++h)
#pragma unroll
            for (int i = 0; i < 2; ++i) an[h][i] = ao[h][i];
        if (has_next) { nA = S.a_base(nxt); nB = S.b_base(nxt); S.a_offsets(nxt, R, C, an); }
        for (int t = 0; t < nt; t += 2) {
            const bool last = (t == nt - 2);
            if constexpr (Epi::HAS_MID) { if (t == tmid) E.mid(acc, cur, wr, fr); }
            if constexpr (Epi::SIDE) {
                if (t == tside && has_next) { nxt.sb = ((ui + 1) & 1) * 2048; E.side(nxt, wid, lane); }
                if (t + ui == tside - 4) { cur.sb = 0; E.side(cur, wid, lane); }
            }
            const char* a1 = cA + (size_t)(t + 1) * kstep;
            const char* a2 = last ? nA : cA + (size_t)(t + 2) * kstep; const char* b2 = last ? nB : cB + (size_t)(t + 2) * kstep;
            const char* a3 = a2 + kstep; const char* b3 = b2 + kstep;
            unsigned o2[2][2];
#pragma unroll
            for (int h = 0; h < 2; ++h)
#pragma unroll
                for (int i = 0; i < 2; ++i) o2[h][i] = last ? an[h][i] : ao[h][i];
            PG8_LDB(B0, 0, 0); PG8_LDB(B1, 0, 1); PG8_SCHED; PG8_LDA(At, 0, 0); PG8_STAGE(PG8_SA(1, 1), a1, ao[1]);
            PG8_WAIT_V(8); PG8_WAIT_L(0); PG8_BAR; PG8_MMA(0, 0, At, B0); PG8_MMA(0, 1, At, B1); PG8_BAR; PG8_SCHED;
            PG8_LDA(At, 0, 1); PG8_STAGE(PG8_SB(0, 0), b2, voffB); PG8_STAGE(PG8_SB(0, 1), b2 + bhstep, voffB); PG8_STAGE(PG8_SA(0, 0), a2, o2[0]);
            PG8_WAIT_V(8); PG8_WAIT_L(0); PG8_BAR; PG8_MMA(1, 0, At, B0); PG8_MMA(1, 1, At, B1); PG8_BAR; PG8_SCHED;
            PG8_LDB(B0, 1, 0); PG8_LDB(B1, 1, 1); PG8_SCHED; PG8_LDA(At, 1, 0); PG8_STAGE(PG8_SA(0, 1), a2, o2[1]);
            PG8_WAIT_V(8); PG8_WAIT_L(0); PG8_BAR; PG8_MMA(0, 0, At, B0); PG8_MMA(0, 1, At, B1); PG8_BAR; PG8_SCHED;
            PG8_LDA(At, 1, 1); PG8_STAGE(PG8_SB(1, 0), b3, voffB); PG8_STAGE(PG8_SB(1, 1), b3 + bhstep, voffB); PG8_STAGE(PG8_SA(1, 0), a3, o2[0]);
            PG8_WAIT_V(8); PG8_WAIT_L(0); PG8_BAR; PG8_MMA(1, 0, At, B0); PG8_MMA(1, 1, At, B1); PG8_BAR; PG8_SCHED;
        }
#if TIME_PHASE >= 0
        if (S.tstamp) { tk1 = __builtin_amdgcn_s_memrealtime(); tacc_k += tk1 - tk0; }
#endif
        if constexpr (ALIGN_EPI) { if (wr == 0) PG8_BAR; }
        asm volatile("s_nop 15\n\ts_nop 15" ::: "memory");
        E(acc, cur, wr, wc, fr, fq);
        if (S.rep_epi) { asm volatile("" ::: "memory"); E(acc, cur, wr, wc, fr, fq); }
#if TIME_PHASE >= 0
        if (S.tstamp) { tacc_e += __builtin_amdgcn_s_memrealtime() - tk1; }
#endif
        if (!has_next) break;
#pragma unroll
        for (int a = 0; a < 2; ++a)
#pragma unroll
            for (int b = 0; b < 2; ++b)
#pragma unroll
                for (int m = 0; m < 4; ++m)
#pragma unroll
                    for (int n = 0; n < 2; ++n) acc[a][b][m][n] = (f32x4){0.f, 0.f, 0.f, 0.f};
        cur = nxt; cA = nA; cB = nB; ++ui;
#pragma unroll
        for (int h = 0; h < 2; ++h)
#pragma unroll
            for (int i = 0; i < 2; ++i) ao[h][i] = an[h][i];
        if constexpr (ALIGN_EPI) { if (wr == 1) PG8_BAR; }
    }
    PG8_WAIT_V(0);
    if constexpr (!ALIGN_EPI) { if (wr == 0) PG8_BAR; }
    PG8_BAR;
#if TIME_PHASE >= 0
    if (S.tstamp && threadIdx.x == 0) { LAS unsigned long long* TSg = (LAS unsigned long long*)(lds + 131072 + 4096); TSg[24] = 0; TSg[25] = tacc_k; TSg[26] = tacc_k + tacc_e; }
#endif
#undef PG8_SA
#undef PG8_SB
#undef PG8_STAGE
#undef PG8_LDA
#undef PG8_LDB
#undef PG8_MMA
#undef PG8_WAIT_V
#undef PG8_WAIT_L
#undef PG8_BAR
#undef PG8_SCHED
}

struct SchedDense {
    static constexpr int rep_epi = 0;
    const bf16* A; const bf16* Bt; int K, lda, ldb; int nM, nN, nwg, G, c, rep, tstamp = 0, eb = 2, scale_a = 127, scale_b = 127;
    __device__ __forceinline__ void init(const bf16* A_, const bf16* Bt_, int M, int N, int K_, int lda_, int ldb_, int G_, int c_, int rep_ = 1) { A = A_; Bt = Bt_; K = K_; lda = lda_; ldb = ldb_; nM = M / BM; nN = N / BM; nwg = nM * nN; G = G_; c = c_; rep = rep_; }
    __device__ __forceinline__ bool next(int i, Unit& u) const {
        const long L = (long)(i / rep) * G + c; if (L >= nwg) return false;
        int wgid = (int)L; { const int q = nwg / NXCD, r = nwg % NXCD, xcd = wgid % NXCD, off = wgid / NXCD; wgid = (xcd < r ? xcd * (q + 1) : r * (q + 1) + (xcd - r) * q) + off; }
        const int nig = WGM * nN, gid = wgid / nig, fm = gid * WGM, gsz = (nM - fm) < WGM ? (nM - fm) : WGM;
        u.pm = fm + ((wgid % nig) % gsz); u.pn = (wgid % nig) / gsz; u.e = 0; u.row0 = u.pm * BM; u.slot0 = 0; u.nvalid = BM; return true;
    }
    __device__ __forceinline__ const char* a_base(const Unit& u) const { return (const char*)A + (size_t)u.pm * BM * lda * eb; }
    __device__ __forceinline__ const char* b_base(const Unit& u) const { return (const char*)Bt + (size_t)u.pn * BM * ldb * eb; }
    __device__ __forceinline__ void a_offsets(const Unit&, const int (&R)[2], const int (&C)[2], unsigned (&off)[2][2]) const {
#pragma unroll
        for (int h = 0; h < 2; ++h)
#pragma unroll
            for (int i = 0; i < 2; ++i) off[h][i] = (unsigned)((R[i] + HALF * h) * lda * eb + C[i] * 2);
    }
};
struct SchedGroup {
    static constexpr int scale_a = 127, scale_b = 127, rep_epi = 0, tstamp = 0;
    const bf16* A; const bf16* Bt; int K, lda, ldb; int nM, nN, ng, G, c; size_t astride, bstride; int rep, nmax;
    __device__ __forceinline__ bool next(int i, Unit& u) const {
        const int L = (i / rep) * G + c; if (L >= ng * nM * nN || i >= nmax) return false;
        const int g = L / (nM * nN), rem = L % (nM * nN);
        u.e = g; u.pm = rem % nM; u.pn = rem / nM; u.row0 = u.pm * BM; u.slot0 = 0; u.nvalid = BM; return true;
    }
    __device__ __forceinline__ const char* a_base(const Unit& u) const { return (const char*)(A + (size_t)u.e * astride) + (size_t)u.pm * BM * lda * 2; }
    __device__ __forceinline__ const char* b_base(const Unit& u) const { return (const char*)(Bt + (size_t)u.e * bstride) + (size_t)u.pn * BM * ldb * 2; }
    __device__ __forceinline__ void a_offsets(const Unit&, const int (&R)[2], const int (&C)[2], unsigned (&off)[2][2]) const {
#pragma unroll
        for (int h = 0; h < 2; ++h)
#pragma unroll
            for (int i = 0; i < 2; ++i) off[h][i] = (unsigned)((R[i] + HALF * h) * lda + C[i]) * 2u;
    }
};
}

__device__ __forceinline__ unsigned pk_fp8x4(float a, float b, float c, float d) { unsigned r = __builtin_amdgcn_cvt_pk_fp8_f32(a, b, 0u, false); return __builtin_amdgcn_cvt_pk_fp8_f32(c, d, r, true); }
struct TItem { const float* W; unsigned char* WT; int K, N, k0, n0, drow0, f8, perm; };
__device__ __forceinline__ int wd_perm_row(int c) { return (c & ~255) + ((c >> 3) & 1) * 128 + ((c >> 6) & 3) * 32 + ((c >> 4) & 3) * 8 + (c & 7); }
__device__ __forceinline__ void titem_load(const TItem& t, int lane, f32x4 (&v)[8]) {
    const float* p = t.W + (size_t)(t.k0 + 8 * (lane >> 3)) * t.N + t.n0 + 4 * (lane & 7);
#pragma unroll
    for (int i = 0; i < 8; ++i) v[i] = __builtin_nontemporal_load((const f32x4*)(p + (size_t)i * t.N));
}
__device__ __forceinline__ void titem_store(const TItem& t, int lane, const f32x4 (&v)[8], float f8scale) {
    const int n4 = lane & 7, kb = lane >> 3;
#pragma unroll
    for (int j = 0; j < 4; ++j) {
        const int cc = 4 * n4 + j;
        const size_t row = (size_t)(t.perm == 1 ? wd_perm_row(t.drow0 + cc) : t.perm == 2 ? t.drow0 + 8 * ((((cc >> 3) & 1) << 1) | (cc >> 4)) + (cc & 7) : t.drow0 + cc);
        if (t.f8) { v2u o; o.x = pk_fp8x4(v[0][j] * f8scale, v[1][j] * f8scale, v[2][j] * f8scale, v[3][j] * f8scale); o.y = pk_fp8x4(v[4][j] * f8scale, v[5][j] * f8scale, v[6][j] * f8scale, v[7][j] * f8scale);
            *(v2u*)(t.WT + row * t.K + t.k0 + 8 * kb) = o; }
        else { v4u o; o.x = pk2(v[0][j], v[1][j]); o.y = pk2(v[2][j], v[3][j]); o.z = pk2(v[4][j], v[5][j]); o.w = pk2(v[6][j], v[7][j]);
            *(v4u*)(t.WT + (row * t.K + t.k0 + 8 * kb) * 2) = o; }
    }
}
constexpr float WGU_F8_SCALE = 32.0f;
__device__ __forceinline__ TItem p0_item(const Args& a, int it) {
    constexpr int I_IN = 16 * 48, I_GLU = 8 * 16, I_OUT = 16 * 32, I_EXP = 16 * 32;
    TItem t; t.f8 = 0; t.perm = 0; int r = it;
    if (r < I_IN) { const int kb = r / 48, nb = r % 48, n0 = nb * 32; int drow;
        if (n0 < 512) drow = n0; else if (n0 < 1024) { const int j = n0 - 512; drow = 512 + (j >> 7) * 256 + (j & 127); } else { const int j = n0 - 1024; drow = 512 + (j >> 7) * 256 + 128 + (j & 127); }
        t.W = a.in[I_WIN]; t.WT = a.ws + WS_WIN; t.K = D; t.N = DIN; t.k0 = kb * 64; t.n0 = n0; t.drow0 = drow; t.f8 = IN_F8; return t; } r -= I_IN;
    if (r < I_GLU) { const int kb = r / 16, nb = r % 16; t.W = a.in[I_WGLU]; t.WT = a.ws + WS_WGLU; t.K = DSSM; t.N = DSSM; t.k0 = kb * 64; t.n0 = nb * 32; t.drow0 = nb * 32; return t; } r -= I_GLU;
    if (r < I_OUT) { const int kb = r / 32, nb = r % 32; t.W = a.in[I_WOUT]; t.WT = a.ws + WS_WOUT; t.K = D; t.N = D; t.k0 = kb * 64; t.n0 = nb * 32; t.drow0 = nb * 32; return t; } r -= I_OUT;
    const int e = r / (3 * I_EXP), q = r % (3 * I_EXP), which = q / I_EXP, sidx = q % I_EXP, kb = sidx / 32, nb = sidx % 32, n0 = nb * 32;
    t.K = D; t.N = FF; t.k0 = kb * 64; t.n0 = n0;
    if (which == 0) { t.W = a.in[I_WG] + (size_t)e * D * FF; t.WT = a.ws + WS_WGU + (size_t)e * 2048 * D * (MOE1_F8 ? 1 : 2); t.drow0 = (n0 >> 7) * 256 + (n0 & 127); t.f8 = MOE1_F8; t.perm = MOE1_WIDE ? 2 : 0; }
    else if (which == 1) { t.W = a.in[I_WU] + (size_t)e * D * FF; t.WT = a.ws + WS_WGU + (size_t)e * 2048 * D * (MOE1_F8 ? 1 : 2); t.drow0 = (n0 >> 7) * 256 + 128 + (n0 & 127); t.f8 = MOE1_F8; t.perm = MOE1_WIDE ? 2 : 0; }
    else { t.W = a.in[I_WD] + (size_t)e * FF * D; t.WT = a.ws + WS_WD + (size_t)e * D * FF * (MOE2_F8 ? 1 : 2); t.drow0 = n0; t.f8 = MOE2_F8; t.perm = MOE2_WIDE; }
    return t;
}
__device__ __forceinline__ void p0_convert(const Args& a, int gw, int ngw, int lane) {
    constexpr int NITEMS = 16 * 48 + 8 * 16 + 16 * 32 + 3 * NE * 16 * 32;
    const int x = blockIdx.x & 7, lo = (int)(((long)NITEMS * x) >> 3), hi = (int)(((long)NITEMS * (x + 1)) >> 3);
    unsigned* ctr = (unsigned*)(a.ws + WS_CTL) + CW_CONV + 64 * x;
    int it = 0, nleft = 0;
    auto grab = [&]() { if (nleft == 0) { int g0 = 0; if (lane == 0) g0 = (int)atomicAdd(ctr, 8u); it = __builtin_amdgcn_readfirstlane(g0) + lo; nleft = 8; } };
    grab();
    bool have = it < hi; TItem c0{}, c1{}; bool ctwo = false; f32x4 v0[8], v1[8];
    if (have) { c0 = p0_item(a, it); ctwo = it + 1 < hi; c1 = p0_item(a, ctwo ? it + 1 : it); titem_load(c0, lane, v0); titem_load(c1, lane, v1); it += 2; nleft -= 2; }
    while (have) {
        grab();
        const bool hn = it < hi; TItem n0{}, n1{}; bool ntwo = false; f32x4 w0[8], w1[8];
        if (hn) { n0 = p0_item(a, it); ntwo = it + 1 < hi; n1 = p0_item(a, ntwo ? it + 1 : it); titem_load(n0, lane, w0); titem_load(n1, lane, w1); it += 2; nleft -= 2; }
        asm volatile("" ::: "memory");
        titem_store(c0, lane, v0, WGU_F8_SCALE);
        if (ctwo) titem_store(c1, lane, v1, WGU_F8_SCALE);
        asm volatile("" ::: "memory");
        have = hn; c0 = n0; c1 = n1; ctwo = ntwo;
#pragma unroll
        for (int i = 0; i < 8; ++i) { v0[i] = w0[i]; v1[i] = w1[i]; }
    }
}
__device__ __forceinline__ void p0_s5_mats(const Args& a, LAS float* sm) {
    const int t = threadIdx.x, tl = __builtin_amdgcn_readfirstlane(t >> 7), tt = t & 127;
    LAS float* Ptau = sm + tl * 384; LAS float* Pt1 = Ptau + 128; LAS float* Ps = Ptau + 256;
    LAS float* LD = sm + 1536;
    LAS float* Bb = sm + 1664; LAS float* Kt = sm + 3712 + tl * 256; LAS float* Cs = sm + 4736;
    bf16* BTS = (bf16*)(a.ws + WS_BTS); bf16* BTY = (bf16*)(a.ws + WS_BTY);
    for (int it0 = blockIdx.x * 4; it0 < NG * TCH; it0 += gridDim.x * 4) {
        const int g = it0 >> 5, tau = (it0 & 31) + tl;
        if (t < 64) {
            const int p = t;
            const float lr = a.in[I_LRE][g * NP + p], li = a.in[I_LIM][g * NP + p], dt = expf(a.in[I_LDT][g]);
            const float mag = expf(lr * dt); float sn, cs; sincosf(li * dt, &sn, &cs);
            const float ar = mag * cs, ai = mag * sn, den = lr * lr + li * li, nr = ar - 1.f;
            const float qr = (nr * lr + ai * li) / den, qi = (ai * lr - nr * li) / den;
            LD[2 * p] = lr * dt; LD[2 * p + 1] = li * dt;
#pragma unroll
            for (int h = 0; h < 16; ++h) {
                const float br = a.in[I_BRE][(g * NP + p) * GH + h], bi = a.in[I_BIM][(g * NP + p) * GH + h];
                Bb[(p * 16 + h) * 2] = qr * br - qi * bi; Bb[(p * 16 + h) * 2 + 1] = qr * bi + qi * br;
            }
        }
        for (int i = t; i < GH * NP; i += NTHR) { Cs[2 * i] = a.in[I_CRE][g * GH * NP + i]; Cs[2 * i + 1] = a.in[I_CIM][g * GH * NP + i]; }
        __syncthreads();
        for (int q = tt; q < 192; q += 128) {
            const int p = q & 63, which = q >> 6; const float e = which == 0 ? (float)tau : which == 1 ? (float)(tau + 1) : (float)(31 - tau);
            const float m = expf(e * LD[2 * p]); float s2, c2; sincosf(e * LD[2 * p + 1], &s2, &c2);
            LAS float* dst = which == 0 ? Ptau : which == 1 ? Pt1 : Ps; dst[2 * p] = m * c2; dst[2 * p + 1] = m * s2;
        }
        __syncthreads();
#pragma unroll 1
        for (int q = tt; q < 256; q += 128) {
            const int h = q >> 4, h2 = q & 15; float s = 0.f;
#pragma unroll 8
            for (int p = 0; p < NP; ++p) {
                const float cr = Cs[(h * NP + p) * 2], ci = Cs[(h * NP + p) * 2 + 1];
                const float pr = Ptau[2 * p], pi = Ptau[2 * p + 1], br = Bb[(p * 16 + h2) * 2], bi = Bb[(p * 16 + h2) * 2 + 1];
                const float xr = pr * br - pi * bi, xi = pr * bi + pi * br;
                s += cr * xr - ci * xi;
            }
            if (tau == 0 && h == h2) s += a.in[I_DSK][g * GH + h];
            Kt[q] = s;
        }
        __syncthreads();
        bf16* by = BTY + (size_t)g * 512 * U2G;
        for (int idx = tt; idx < (TCH - tau) * 32; idx += 128) {
            const int j = idx >> 5, h = (idx >> 1) & 15, half = idx & 1, trow = tau + j, sidx = j;
            const LAS float* k = Kt + h * 16 + half * 8;
            v4u o; o.x = pk2(k[0], k[1]); o.y = pk2(k[2], k[3]); o.z = pk2(k[4], k[5]); o.w = pk2(k[6], k[7]);
            *(v4u*)(by + (size_t)(trow * 16 + h) * U2G + sidx * 16 + half * 8) = o;
        }
        if (tau >= 1) for (int idx = tt; idx < (TCH - tau) * 32; idx += 128) {
            const int j = idx >> 5, h = (idx >> 1) & 15, half = idx & 1, trow = j, sidx = tau + j;
            *(v4u*)(by + (size_t)(trow * 16 + h) * U2G + sidx * 16 + half * 8) = (v4u){0u, 0u, 0u, 0u};
        }
#pragma unroll 1
        for (int q = tt; q < 256; q += 128) {
            const int h = q >> 4, piece = q & 15; float v[8];
#pragma unroll
            for (int r = 0; r < 8; ++r) { const int pp = piece * 8 + r, p = pp & 63;
                const float cr = Cs[(h * NP + p) * 2], ci = Cs[(h * NP + p) * 2 + 1], pr = Pt1[2 * p], pi = Pt1[2 * p + 1];
                v[r] = (pp < 64) ? (cr * pr - ci * pi) : -(cr * pi + ci * pr); }
            v4u o; o.x = pk2(v[0], v[1]); o.y = pk2(v[2], v[3]); o.z = pk2(v[4], v[5]); o.w = pk2(v[6], v[7]);
            *(v4u*)(by + (size_t)(tau * 16 + h) * U2G + 512 + piece * 8) = o;
        }
#pragma unroll 1
        for (int u = tt; u < 256; u += 128) {
            const int n = u >> 1, half = u & 1, p = n & 63; float v[8];
#pragma unroll
            for (int r = 0; r < 8; ++r) { const int h = half * 8 + r; const float pr = Ps[2 * p], pi = Ps[2 * p + 1], br = Bb[(p * 16 + h) * 2], bi = Bb[(p * 16 + h) * 2 + 1];
                v[r] = (n < 64) ? (pr * br - pi * bi) : (pr * bi + pi * br); }
            v4u o; o.x = pk2(v[0], v[1]); o.y = pk2(v[2], v[3]); o.z = pk2(v[4], v[5]); o.w = pk2(v[6], v[7]);
            bf16* bs = BTS + (size_t)g * 256 * 512;
            *(v4u*)(bs + (size_t)n * 512 + tau * 16 + half * 8) = o;
            *(v4u*)(bs + (size_t)(128 + n) * 512 + tau * 16 + half * 8) = (v4u){0u, 0u, 0u, 0u};
        }
        __syncthreads();
    }
}

using pg8::Unit; using pg8::cvt_pk_bf16;
struct EpiInProj {
    static constexpr bool PERM = true; static constexpr bool HAS_MID = false; static constexpr bool SIDE = false;
    bf16* U2; bf16* Z;
    __device__ __forceinline__ void operator()(const f32x4 (&acc)[2][2][4][2], const Unit& u, int wr, int wc, int fr, int fq) const {
#pragma unroll
        for (int ai = 0; ai < 2; ++ai)
#pragma unroll
            for (int m = 0; m < 4; ++m) {
                const int tok = u.pm * 256 + ai * 128 + wr * 64 + m * 16 + fr;
                if (u.pn < 2) {
                    const int b = tok >> 13, l = tok & 8191;
                    bf16* rowp = U2 + (size_t)(b * NCH + (l >> 5)) * U2LD + (l & 31) * 16;
#pragma unroll
                    for (int bj = 0; bj < 2; ++bj) { const int c0 = u.pn * 256 + bj * 128 + wc * 32 + 8 * fq; const f32x4 v0 = acc[ai][bj][m][0], v1 = acc[ai][bj][m][1];
                        v4u w; w.x = cvt_pk_bf16(v0[0], v0[1]); w.y = cvt_pk_bf16(v0[2], v0[3]); w.z = cvt_pk_bf16(v1[0], v1[1]); w.w = cvt_pk_bf16(v1[2], v1[3]);
                        *(v4u*)(rowp + (c0 >> 4) * U2G + (c0 & 15)) = w; }
                } else {
                    const int j0 = (u.pn - 2) * 128 + wc * 32 + 8 * fq;
                    const f32x4 a0 = acc[ai][0][m][0], a1 = acc[ai][0][m][1], g0 = acc[ai][1][m][0], g1 = acc[ai][1][m][1];
                    constexpr float KS = -1.4426950408889634f;
                    const f32x2 z0 = (f32x2){a0[0], a0[1]} * sig2((f32x2){g0[0], g0[1]}, KS), z1 = (f32x2){a0[2], a0[3]} * sig2((f32x2){g0[2], g0[3]}, KS);
                    const f32x2 z2 = (f32x2){a1[0], a1[1]} * sig2((f32x2){g1[0], g1[1]}, KS), z3 = (f32x2){a1[2], a1[3]} * sig2((f32x2){g1[2], g1[3]}, KS);
                    v4u w; w.x = cvt_pk_bf16(z0.x, z0.y); w.y = cvt_pk_bf16(z1.x, z1.y); w.z = cvt_pk_bf16(z2.x, z2.y); w.w = cvt_pk_bf16(z3.x, z3.y);
                    *(v4u*)(Z + (size_t)tok * DCONV + j0) = w;
                }
            }
    }
};
struct EpiGlu {
    static constexpr bool PERM = true; static constexpr bool HAS_MID = false; static constexpr bool SIDE = false;
    const bf16* YG; bf16* MRG; const float* bias; const float* ong; float* ssq2;
    __device__ __forceinline__ void operator()(const f32x4 (&acc)[2][2][4][2], const Unit& u, int wr, int wc, int fr, int fq) const {
        f32x4 bb[2][2], gg[2][2];
#pragma unroll
        for (int bj = 0; bj < 2; ++bj)
#pragma unroll
            for (int n = 0; n < 2; ++n) { const int c = u.pn * 256 + bj * 128 + wc * 32 + 8 * fq + 4 * n; bb[bj][n] = *(const f32x4*)(bias + c); gg[bj][n] = FUSE_NORM ? *(const f32x4*)(ong + c) : (f32x4){1.f, 1.f, 1.f, 1.f}; }
#pragma unroll
        for (int ai = 0; ai < 2; ++ai)
#pragma unroll
            for (int m = 0; m < 4; ++m) {
                const int tok = u.pm * 256 + ai * 128 + wr * 64 + m * 16 + fr; f32x2 sq = {0.f, 0.f};
#pragma unroll
                for (int bj = 0; bj < 2; ++bj) {
                    const int c0 = u.pn * 256 + bj * 128 + wc * 32 + 8 * fq;
                    float y[8]; unpack8(*(const v4u*)(YG + (size_t)tok * DSSM + c0), y);
                    const f32x4 v0 = acc[ai][bj][m][0] + bb[bj][0], v1 = acc[ai][bj][m][1] + bb[bj][1];
                    constexpr float KS = -1.4426950408889634f;
                    f32x2 z0 = (f32x2){y[0], y[1]} * sig2((f32x2){v0[0], v0[1]}, KS), z1 = (f32x2){y[2], y[3]} * sig2((f32x2){v0[2], v0[3]}, KS);
                    f32x2 z2 = (f32x2){y[4], y[5]} * sig2((f32x2){v1[0], v1[1]}, KS), z3 = (f32x2){y[6], y[7]} * sig2((f32x2){v1[2], v1[3]}, KS);
#if FUSE_NORM
                    sq += z0 * z0 + z1 * z1; sq += z2 * z2 + z3 * z3;
                    z0 *= (f32x2){gg[bj][0][0], gg[bj][0][1]}; z1 *= (f32x2){gg[bj][0][2], gg[bj][0][3]}; z2 *= (f32x2){gg[bj][1][0], gg[bj][1][1]}; z3 *= (f32x2){gg[bj][1][2], gg[bj][1][3]};
#endif
                    v4u w; w.x = cvt_pk_bf16(z0.x, z0.y); w.y = cvt_pk_bf16(z1.x, z1.y); w.z = cvt_pk_bf16(z2.x, z2.y); w.w = cvt_pk_bf16(z3.x, z3.y);
                    *(v4u*)(MRG + (size_t)tok * D + c0) = w;
                }
#if FUSE_NORM
                float sr = sum_fq(sq.x + sq.y);
                if (fq == 0) ssq2[tok * 8 + u.pn * 4 + wc] = sr;
#endif
            }
    }
};
struct EpiOut {
    static constexpr bool PERM = true; static constexpr bool HAS_MID = FUSE_NORM != 0; static constexpr bool SIDE = false;
    const float* x; float* out; const float* mod; float* ssq; const float* ssq2;
    __device__ __forceinline__ void mid(f32x4 (&acc)[2][2][4][2], const Unit& u, int wr, int fr) const {
#pragma unroll
        for (int ai = 0; ai < 2; ++ai)
#pragma unroll
            for (int m = 0; m < 4; ++m) {
                const int row = u.pm * 256 + ai * 128 + wr * 64 + m * 16 + fr;
                const f32x4 p0 = *(const f32x4*)(ssq2 + (size_t)row * 8), p1 = *(const f32x4*)(ssq2 + (size_t)row * 8 + 4);
                const float r2 = rsqrtf((((p0[0] + p0[1]) + (p0[2] + p0[3])) + ((p1[0] + p1[1]) + (p1[2] + p1[3]))) * (1.f / DSSM) + 1e-6f);
#pragma unroll
                for (int bj = 0; bj < 2; ++bj)
#pragma unroll
                    for (int n = 0; n < 2; ++n) acc[ai][bj][m][n] *= r2;
            }
    }
    __device__ __forceinline__ void operator()(const f32x4 (&acc)[2][2][4][2], const Unit& u, int wr, int wc, int fr, int fq) const {
        const int b = (u.pm * 256) >> 13;
        f32x4 g1[2][2];
#pragma unroll
        for (int bj = 0; bj < 2; ++bj)
#pragma unroll
            for (int n = 0; n < 2; ++n) g1[bj][n] = *(const f32x4*)(mod + b * 6 * D + 2 * D + u.pn * 256 + bj * 128 + wc * 32 + 8 * fq + 4 * n);
#pragma unroll
        for (int ai = 0; ai < 2; ++ai)
#pragma unroll
            for (int m = 0; m < 4; ++m) {
                const int row = u.pm * 256 + ai * 128 + wr * 64 + m * 16 + fr; float sq = 0.f;
                bf16* drow = (bf16*)(out + (size_t)row * D);
#pragma unroll
                for (int bj = 0; bj < 2; ++bj) {
                    const int c0 = u.pn * 256 + bj * 128 + wc * 32 + 8 * fq;
                    const f32x4 o0 = *(const f32x4*)(x + (size_t)row * D + c0) + g1[bj][0] * acc[ai][bj][m][0], o1 = *(const f32x4*)(x + (size_t)row * D + c0 + 4) + g1[bj][1] * acc[ai][bj][m][1];
                    sq += ((o0[0] * o0[0] + o0[1] * o0[1]) + (o0[2] * o0[2] + o0[3] * o0[3])) + ((o1[0] * o1[0] + o1[1] * o1[1]) + (o1[2] * o1[2] + o1[3] * o1[3]));
                    v4u hi, lo;
                    hi.x = pk2(o0[0], o0[1]); hi.y = pk2(o0[2], o0[3]); hi.z = pk2(o1[0], o1[1]); hi.w = pk2(o1[2], o1[3]);
#if X1_LO
                    lo.x = pk2(o0[0] - bflo(hi.x), o0[1] - bfhi(hi.x)); lo.y = pk2(o0[2] - bflo(hi.y), o0[3] - bfhi(hi.y));
                    lo.z = pk2(o1[0] - bflo(hi.z), o1[1] - bfhi(hi.z)); lo.w = pk2(o1[2] - bflo(hi.w), o1[3] - bfhi(hi.w));
                    *(v4u*)(drow + c0) = lo;
#else
                    (void)lo;
#endif
                    *(v4u*)(drow + D + c0) = hi;
                }
                sq = sum_fq(sq);
                if (fq == 0) ssq[row * 16 + u.pn * 4 + wc] = sq;
            }
    }
};

__device__ __forceinline__ void p2_fast(const Args& a, LAS unsigned char* lds) {
    pg8::SchedDense S; S.init((const bf16*)(a.ws + WS_H1), (const bf16*)(a.ws + WS_WIN), NTOK, DIN, D, D, D, gridDim.x, blockIdx.x, (REP_GEMM == 2) ? 2 : 1); S.tstamp = (TSTAMP_GEMM == 2) ? 1 : 0;
    EpiInProj E{(bf16*)(a.ws + WS_U2), (bf16*)(a.ws + WS_Z)};
#if IN_F8
    S.eb = 1; S.scale_b = 127 - 5;
    pg8::gemm_phase<EpiInProj, pg8::SchedDense, true, true>(lds, S, E);
#else
    pg8::gemm_phase<EpiInProj, pg8::SchedDense, true>(lds, S, E);
#endif
}
__device__ __forceinline__ void p3d_fast(const Args& a, LAS unsigned char* lds) {
    pg8::SchedDense S; S.init((const bf16*)(a.ws + WS_YG), (const bf16*)(a.ws + WS_WGLU), NTOK, DSSM, DSSM, DSSM, DSSM, gridDim.x, blockIdx.x, (REP_GEMM == 6) ? 2 : 1);
    EpiGlu E{(const bf16*)(a.ws + WS_YG), (bf16*)(a.ws + WS_MRG), a.in[I_BGLU], a.in[I_ONG], (float*)(a.ws + WS_SSQ2)};
    pg8::gemm_phase<EpiGlu, pg8::SchedDense, true>(lds, S, E);
}
__device__ __forceinline__ void p4_fast(const Args& a, LAS unsigned char* lds) {
    pg8::SchedDense S; S.init((const bf16*)(a.ws + WS_MRG), (const bf16*)(a.ws + WS_WOUT), NTOK, D, D, D, D, gridDim.x, blockIdx.x, (REP_GEMM == 8) ? 2 : 1);
    EpiOut E{a.in[I_X], a.out, (const float*)(a.ws + WS_MOD), (float*)(a.ws + WS_SSQ), (const float*)(a.ws + WS_SSQ2)};
    pg8::gemm_phase<EpiOut, pg8::SchedDense, ALIGN_P4>(lds, S, E);
}

template <bool GATHER>
struct SchedMoE {
    const LAS int* T; const char* Abase; const char* Bt; const int* tokk; int K, lda, ldb, nN, G, c; size_t bstride; int rep, eb, scale_a, scale_b, rep_epi, tstamp;
    __device__ __forceinline__ bool next(int i_, Unit& u) const {
        const int i = i_ / rep;
        const int NT = __builtin_amdgcn_readfirstlane(T[98 + NE]); int Tt, pn;
        if ((G & 7) == 0 && ((G >> 3) % nN) == 0) {
            const int x = c & 7, j = c >> 3, rtpr = (G >> 3) / nN, Ts = (x * NT) >> 3, Te = ((x + 1) * NT) >> 3;
            pn = j / rtpr; Tt = Ts + i * rtpr + (j % rtpr); if (Tt >= Te) return false;
            if (!GATHER) Tt = Te - 1 - (Tt - Ts);
        } else { const int L = i * G + c; Tt = L / nN; pn = L % nN; if (Tt >= NT) return false; }
        int e = 0;
        if (GATHER) { e = u.e;
            while (e + 1 < NE && __builtin_amdgcn_readfirstlane(T[98 + e + 1]) <= Tt) ++e; e = __builtin_amdgcn_readfirstlane(e); }
        else e = __builtin_amdgcn_readfirstlane(T[1280 + Tt]);
        u.e = e; u.pn = pn; u.pm = Tt; u.slot0 = __builtin_amdgcn_readfirstlane((Tt - T[98 + e]) * 256); u.row0 = __builtin_amdgcn_readfirstlane(T[32 + e] + u.slot0);
        const int left = __builtin_amdgcn_readfirstlane(T[e] - u.slot0); u.nvalid = left < 256 ? left : 256; return true;
    }
    __device__ __forceinline__ const char* a_base(const Unit& u) const { return GATHER ? Abase : Abase + (size_t)u.row0 * lda * eb; }
    __device__ __forceinline__ const char* b_base(const Unit& u) const { return Bt + ((size_t)u.e * bstride + (size_t)u.pn * 256 * ldb) * eb; }
    __device__ __forceinline__ void a_offsets(const Unit& u, const int (&R)[2], const int (&C)[2], unsigned (&off)[2][2]) const {
#pragma unroll
        for (int h = 0; h < 2; ++h)
#pragma unroll
            for (int i = 0; i < 2; ++i) {
                const int row = R[i] + 128 * h;
                if (GATHER) { int tok = 0; if (row < u.nvalid) tok = tokk[(size_t)u.e * CAP + u.slot0 + row] >> 2; off[h][i] = (unsigned)tok * (unsigned)(lda * eb) + (unsigned)C[i] * 2u; }
                else off[h][i] = (unsigned)(row * lda * eb + C[i] * 2);
            }
    }
};
struct EpiMoe1 {
    static constexpr bool PERM = true; static constexpr bool HAS_MID = false; static constexpr bool SIDE = (MOE_SIDE && MOE1_WIDE);
    bf16* ACT; const float* bg; const float* bu; LAS unsigned char* lds;
    __device__ __forceinline__ void side(const Unit& u, int wid, int lane) const {
        if (wid == 0) __builtin_amdgcn_global_load_lds((const unsigned*)((lane < 32 ? bg : bu) + u.e * FF + u.pn * 128 + (lane & 31) * 4), (LAS unsigned*)(lds + 131072 + 8192 + u.sb), 16, 0, 0);
    }
#if MOE1_WIDE
    __device__ __forceinline__ void operator()(f32x4 (&acc)[2][2][4][2], const Unit& u, int wr, int wc, int fr, int fq) const {
        asm volatile("" : "+v"(fr), "+v"(fq));
        const int gq = ((fq & 1) << 1) | (fq >> 1);
        const int f0 = u.pn * 128 + wc * 32 + 8 * gq;
        {
#if MOE_SIDE
            const LAS float* sbp = (const LAS float*)(lds + 131072 + 8192 + u.sb) + wc * 32 + 8 * gq;
            const f32x4 g0 = *(const LAS f32x4*)sbp, g1 = *(const LAS f32x4*)(sbp + 4);
            const f32x4 u0 = *(const LAS f32x4*)(sbp + 128) + 1.0f, u1 = *(const LAS f32x4*)(sbp + 132) + 1.0f;
#else
            const f32x4 g0 = *(const f32x4*)(bg + u.e * FF + f0), g1 = *(const f32x4*)(bg + u.e * FF + f0 + 4);
            const f32x4 u0 = *(const f32x4*)(bu + u.e * FF + f0) + 1.0f, u1 = *(const f32x4*)(bu + u.e * FF + f0 + 4) + 1.0f;
#endif
#pragma unroll
            for (int ai = 0; ai < 2; ++ai)
#pragma unroll
                for (int m = 0; m < 4; ++m) { acc[ai][0][m][0] += g0; acc[ai][0][m][1] += g1; acc[ai][1][m][0] += u0; acc[ai][1][m][1] += u1; }
            __builtin_amdgcn_sched_barrier(0);
        }
        unsigned char* dstu = (unsigned char*)ACT + (size_t)u.row0 * FF + u.pn * 128;
        const unsigned voff = (unsigned)((wr * 64 + (fq >> 1) * 16 + fr) * FF + wc * 32 + 16 * (fq & 1));
#pragma unroll
        for (int ai = 0; ai < 2; ++ai)
#pragma unroll
            for (int mp = 0; mp < 2; ++mp) {
                unsigned w[2][2];
#pragma unroll
                for (int mm = 0; mm < 2; ++mm) {
                    const int m = 2 * mp + mm;
                    float o[8];
#pragma unroll
                    for (int n = 0; n < 2; ++n) {
                        const f32x4 gv = acc[ai][0][m][n], uv = acc[ai][1][m][n];
#pragma unroll
                        for (int q = 0; q < 4; q += 2) {
                            const f32x2 gate = {fminf(gv[q], 7.0f), fminf(gv[q + 1], 7.0f)};
                            const f32x2 up1 = {__builtin_amdgcn_fmed3f(uv[q], -6.0f, 8.0f), __builtin_amdgcn_fmed3f(uv[q + 1], -6.0f, 8.0f)};
                            const f32x2 r = up1 * (gate * sig2(gate, -1.4426950408889634f * 1.702f));
                            o[n * 4 + q] = r.x; o[n * 4 + q + 1] = r.y;
                        }
                    }
                    w[mm][0] = pk_fp8x4(o[0], o[1], o[2], o[3]); w[mm][1] = pk_fp8x4(o[4], o[5], o[6], o[7]);
                }
                const auto r0 = __builtin_amdgcn_permlane32_swap(w[0][0], w[1][0], false, false), r1 = __builtin_amdgcn_permlane32_swap(w[0][1], w[1][1], false, false);
                const v4u W = {r0[0], r1[0], r0[1], r1[1]};
                const int rl = ai * 128 + wr * 64 + (2 * mp + (fq >> 1)) * 16 + fr;
                if (rl < u.nvalid) *(v4u*)(dstu + (voff + (unsigned)((ai * 128 + mp * 32) * FF))) = W;
            }
#else
    __device__ __forceinline__ void operator()(const f32x4 (&acc)[2][2][4][2], const Unit& u, int wr, int wc, int fr, int fq) const {
        const int f0 = u.pn * 128 + wc * 32 + 8 * fq;
        const f32x4 g0 = *(const f32x4*)(bg + u.e * FF + f0), g1 = *(const f32x4*)(bg + u.e * FF + f0 + 4), u0 = *(const f32x4*)(bu + u.e * FF + f0), u1 = *(const f32x4*)(bu + u.e * FF + f0 + 4);
#pragma unroll
        for (int ai = 0; ai < 2; ++ai)
#pragma unroll
            for (int m = 0; m < 4; ++m) {
                const int rl = ai * 128 + wr * 64 + m * 16 + fr;
                if (rl < u.nvalid) {
                    float o[8];
#pragma unroll
                    for (int n = 0; n < 2; ++n) {
                        const f32x4 gv = acc[ai][0][m][n] + (n ? g1 : g0), uv = acc[ai][1][m][n] + (n ? u1 : u0);
#pragma unroll
                        for (int q = 0; q < 4; q += 2) {
                            const f32x2 gate = {fminf(gv[q], 7.0f), fminf(gv[q + 1], 7.0f)};
                            const f32x2 up = {__builtin_amdgcn_fmed3f(uv[q], -7.0f, 7.0f), __builtin_amdgcn_fmed3f(uv[q + 1], -7.0f, 7.0f)};
                            const f32x2 r = (up + 1.0f) * (gate * sig2(gate, -1.4426950408889634f * 1.702f));
                            o[n * 4 + q] = r.x; o[n * 4 + q + 1] = r.y;
                        }
                    }
#if MOE2_F8
                    v2u w; w.x = pk_fp8x4(o[0], o[1], o[2], o[3]); w.y = pk_fp8x4(o[4], o[5], o[6], o[7]);
                    *(v2u*)((unsigned char*)ACT + (size_t)(u.row0 + rl) * FF + f0) = w;
#else
                    v4u w; w.x = cvt_pk_bf16(o[0], o[1]); w.y = cvt_pk_bf16(o[2], o[3]); w.z = cvt_pk_bf16(o[4], o[5]); w.w = cvt_pk_bf16(o[6], o[7]);
                    *(v4u*)(ACT + (size_t)(u.row0 + rl) * FF + f0) = w;
#endif
                }
            }
#endif
    }
};
struct EpiMoe2 {
    static constexpr bool PERM = true; static constexpr bool HAS_MID = false; static constexpr bool SIDE = (MOE_SIDE && MOE2_WIDE);
    float* out; unsigned char* ws; const int* tokk; const float* bd; LAS unsigned char* lds;
    __device__ __forceinline__ void side(const Unit& u, int wid, int lane) const {
        if (wid == 0) __builtin_amdgcn_global_load_lds((const unsigned*)(bd + u.e * D + u.pn * 256 + lane * 4), (LAS unsigned*)(lds + 131072 + 8192 + u.sb), 16, 0, 0);
        if (wid == 1) __builtin_amdgcn_global_load_lds((const unsigned*)(tokk + (size_t)u.e * CAP + u.slot0 + lane * 4), (LAS unsigned*)(lds + 131072 + 8192 + u.sb + 1024), 16, 0, 0);
    }
    __device__ __forceinline__ void operator()(const f32x4 (&acc)[2][2][4][2], const Unit& u, int wr, int wc, int fr, int fq) const {
#if MOE2_WIDE
        const int c0 = u.pn * 256 + wc * 64 + 16 * fq;
#else
        const int c0 = u.pn * 256 + wc * 32 + 8 * fq;
#endif
        f32x4 bv[2][2];
#pragma unroll
        for (int bj = 0; bj < 2; ++bj)
#pragma unroll
            for (int n = 0; n < 2; ++n) bv[bj][n] = (MOE_SIDE && MOE2_WIDE) ? *(const LAS f32x4*)((const LAS float*)(lds + 131072 + 8192 + u.sb) + wc * 64 + 16 * fq + bj * 8 + 4 * n)
                                                                            : *(const f32x4*)(bd + u.e * D + c0 + (MOE2_WIDE ? bj * 8 : bj * 128) + 4 * n);
        int tks[2][4];
#pragma unroll
        for (int ai = 0; ai < 2; ++ai)
#pragma unroll
            for (int m = 0; m < 4; ++m) { const int rl = ai * 128 + wr * 64 + m * 16 + fr; tks[ai][m] = (rl < u.nvalid) ? ((MOE_SIDE && MOE2_WIDE) ? ((const LAS int*)(lds + 131072 + 8192 + u.sb + 1024))[rl] : tokk[(size_t)u.e * CAP + u.slot0 + rl]) : 0; }
#pragma unroll
        for (int ai = 0; ai < 2; ++ai)
#pragma unroll
            for (int m = 0; m < 4; ++m) {
                const int rl = ai * 128 + wr * 64 + m * 16 + fr;
                if (rl < u.nvalid) {
                    const int tk = tks[ai][m], tok = tk >> 2, k = tk & 3;
#if YS_F8
                    unsigned char* dst = (k == 0) ? (unsigned char*)(out + (size_t)tok * D) : (k == 3) ? (ws + WS_YS3) + (size_t)tok * D : (ws + WS_YS12) + ((size_t)(k - 1) * NTOK + tok) * D;
#if MOE2_WIDE
                    const f32x4 v0 = acc[ai][0][m][0] + bv[0][0], v1 = acc[ai][0][m][1] + bv[0][1], v2 = acc[ai][1][m][0] + bv[1][0], v3 = acc[ai][1][m][1] + bv[1][1];
                    v4u w; w.x = pk_fp8x4(v0[0], v0[1], v0[2], v0[3]); w.y = pk_fp8x4(v1[0], v1[1], v1[2], v1[3]); w.z = pk_fp8x4(v2[0], v2[1], v2[2], v2[3]); w.w = pk_fp8x4(v3[0], v3[1], v3[2], v3[3]);
                    __builtin_nontemporal_store(w, (v4u*)(dst + c0));
#else
#pragma unroll
                    for (int bj = 0; bj < 2; ++bj) { const f32x4 v0 = acc[ai][bj][m][0] + bv[bj][0], v1 = acc[ai][bj][m][1] + bv[bj][1];
                        v2u w; w.x = pk_fp8x4(v0[0], v0[1], v0[2], v0[3]); w.y = pk_fp8x4(v1[0], v1[1], v1[2], v1[3]);
                        *(v2u*)(dst + c0 + bj * 128) = w; }
#endif
#else
                    bf16* dst = (k == 0) ? (bf16*)(out + (size_t)tok * D) : (k == 3) ? (bf16*)(ws + WS_YS3) + (size_t)tok * D : (bf16*)(ws + WS_YS12) + ((size_t)(k - 1) * NTOK + tok) * D;
#pragma unroll
                    for (int bj = 0; bj < 2; ++bj) { const f32x4 v0 = acc[ai][bj][m][0] + bv[bj][0], v1 = acc[ai][bj][m][1] + bv[bj][1];
                        v4u w; w.x = cvt_pk_bf16(v0[0], v0[1]); w.y = cvt_pk_bf16(v0[2], v0[3]); w.z = cvt_pk_bf16(v1[0], v1[1]); w.w = cvt_pk_bf16(v1[2], v1[3]);
                        *(v4u*)(dst + c0 + bj * 128) = w; }
#endif
                }
            }
    }
};
__device__ __forceinline__ void p7_fast(const Args& a, LAS unsigned char* lds, LAS int* T) {
    SchedMoE<true> S{T, (const char*)(a.ws + WS_H2), (const char*)(a.ws + WS_WGU), (const int*)(a.ws + WS_TOKK), D, D, D, 8, (int)gridDim.x, (int)blockIdx.x, (size_t)2048 * D, (REP_GEMM == 10) ? 2 : 1, MOE1_F8 ? 1 : 2, 127, 127 - 5, (REP_EPI == 10) ? 1 : 0, (TSTAMP_GEMM == 10) ? 1 : 0};
    EpiMoe1 E{(bf16*)(a.ws + WS_ACT), a.in[I_BG], a.in[I_BU], lds};
    pg8::gemm_phase<EpiMoe1, SchedMoE<true>, ALIGN_MOE, MOE1_F8 != 0>(lds, S, E);
}
__device__ __forceinline__ void p8_fast(const Args& a, LAS unsigned char* lds, LAS int* T) {
    SchedMoE<false> S{T, (const char*)(a.ws + WS_ACT), (const char*)(a.ws + WS_WD), (const int*)(a.ws + WS_TOKK), FF, FF, FF, 4, (int)gridDim.x, (int)blockIdx.x, (size_t)D * FF, (REP_GEMM == 11) ? 2 : 1, MOE2_F8 ? 1 : 2, 127, MOE2_F8 ? 127 - 5 : 127, (REP_EPI == 11) ? 1 : 0, (TSTAMP_GEMM == 11) ? 1 : 0};
    EpiMoe2 E{a.out, a.ws, (const int*)(a.ws + WS_TOKK), a.in[I_BD], lds};
    pg8::gemm_phase<EpiMoe2, SchedMoE<false>, ALIGN_MOE, MOE2_F8 != 0>(lds, S, E);
}

struct EpiSloc {
    static constexpr bool PERM = false; static constexpr bool HAS_MID = false; static constexpr bool SIDE = false;
    float* SL;
    __device__ __forceinline__ void operator()(const f32x4 (&acc)[2][2][4][2], const Unit& u, int wr, int wc, int fr, int fq) const {
#pragma unroll
        for (int ai = 0; ai < 2; ++ai)
#pragma unroll
            for (int m = 0; m < 4; ++m) {
                float* rowp = SL + (size_t)(u.pm * 256 + ai * 128 + wr * 64 + m * 16 + fr) * (NG * 128) + u.e * 128 + wc * 32 + 4 * fq;
#pragma unroll
                for (int n = 0; n < 2; ++n) *(f32x4*)(rowp + n * 16) = acc[ai][0][m][n];
            }
    }
};
struct EpiY {
    static constexpr bool PERM = true; static constexpr bool HAS_MID = false; static constexpr bool SIDE = false;
    bf16* YG;
    __device__ __forceinline__ void operator()(const f32x4 (&acc)[2][2][4][2], const Unit& u, int wr, int wc, int fr, int fq) const {
#pragma unroll
        for (int ai = 0; ai < 2; ++ai)
#pragma unroll
            for (int m = 0; m < 4; ++m) {
                const int r = u.pm * 256 + ai * 128 + wr * 64 + m * 16 + fr;
#pragma unroll
                for (int bj = 0; bj < 2; ++bj) {
                    const int c0 = u.pn * 256 + bj * 128 + wc * 32 + 8 * fq, t = c0 >> 4, h0 = c0 & 15;
                    const f32x4 v0 = acc[ai][bj][m][0], v1 = acc[ai][bj][m][1];
                    const f32x2 z0 = gelu2((f32x2){v0[0], v0[1]}), z1 = gelu2((f32x2){v0[2], v0[3]}), z2 = gelu2((f32x2){v1[0], v1[1]}), z3 = gelu2((f32x2){v1[2], v1[3]});
                    v4u w; w.x = cvt_pk_bf16(z0.x, z0.y); w.y = cvt_pk_bf16(z1.x, z1.y); w.z = cvt_pk_bf16(z2.x, z2.y); w.w = cvt_pk_bf16(z3.x, z3.y);
                    *(v4u*)(YG + (size_t)(r * 32 + t) * DSSM + u.e * GH + h0) = w;
                }
            }
    }
};
__device__ __forceinline__ void p3a_fast(const Args& a, LAS unsigned char* lds) {
    pg8::SchedGroup S{(const bf16*)(a.ws + WS_U2), (const bf16*)(a.ws + WS_BTS), 512, U2LD, 512, NROW2 / 256, 1, NG, (int)gridDim.x, (int)blockIdx.x, (size_t)U2G, (size_t)256 * 512, (REP_GEMM == 3) ? 2 : 1, 1 << 30};
    EpiSloc E{(float*)(a.ws + WS_SLOC)};
    pg8::gemm_phase<EpiSloc, pg8::SchedGroup, true>(lds, S, E);
}
__device__ __forceinline__ void p3c_fast(const Args& a, LAS unsigned char* lds) {
    pg8::SchedGroup S{(const bf16*)(a.ws + WS_U2), (const bf16*)(a.ws + WS_BTY), U2G, U2LD, U2G, NROW2 / 256, 2, NG, (int)gridDim.x, (int)blockIdx.x, (size_t)U2G, (size_t)512 * U2G, (REP_GEMM == 5) ? 2 : 1, 1 << 30};
    EpiY E{(bf16*)(a.ws + WS_YG)};
    pg8::gemm_phase<EpiY, pg8::SchedGroup, true>(lds, S, E);
}
__device__ __forceinline__ void p3c_pair(const Args& a, LAS unsigned char* lds, int g, int pm, int pn0, int n) {
    pg8::SchedGroup S{(const bf16*)(a.ws + WS_U2), (const bf16*)(a.ws + WS_BTY), U2G, U2LD, U2G, NROW2 / 256, 2, NG, NROW2 / 256, g * 2 * (NROW2 / 256) + pn0 * (NROW2 / 256) + pm, (size_t)U2G, (size_t)512 * U2G, 1, n};
    EpiY E{(bf16*)(a.ws + WS_YG)};
    pg8::gemm_phase<EpiY, pg8::SchedGroup, true>(lds, S, E);
}
__device__ __forceinline__ void p3b_scan(const Args& a, LAS float* sm, bool fused) {
    const float* SL = (const float*)(a.ws + WS_SLOC); bf16* U2 = (bf16*)(a.ws + WS_U2);
    LAS unsigned char* lds = (LAS unsigned char*)sm;
    const int t = threadIdx.x, p = t & 63, seg = __builtin_amdgcn_readfirstlane(t >> 6);
    LAS float* LT = (LAS float*)(lds + seg * 16384);
    LAS float* carry = (LAS float*)(lds + 131072 + 8192);
    for (int task = blockIdx.x; task < NB * NG; task += gridDim.x) {
        const int b = fused ? (task % (NROW2 / 256)) : (task / NG), g = fused ? (task / (NROW2 / 256)) : (task % NG);
        const float* slw = SL + (size_t)(b * NCH + seg * 32) * (NG * 128) + g * 128;
#pragma unroll
        for (int i = 0; i < 16; ++i)
            __builtin_amdgcn_global_load_lds((const unsigned*)(slw + (size_t)(2 * i + (p >> 5)) * (NG * 128) + (p & 31) * 4), (LAS unsigned*)((LAS unsigned char*)LT + i * 1024), 16, 0, 0);
        const float lr = a.in[I_LRE][g * NP + p], li = a.in[I_LIM][g * NP + p], dt = expf(a.in[I_LDT][g]);
        float ar, ai, br, bi;
        { const float m = expf(32.f * lr * dt); float s2, c2; sincosf(32.f * li * dt, &s2, &c2); ar = m * c2; ai = m * s2; }
        { const float m = expf(1024.f * lr * dt); float s2, c2; sincosf(1024.f * li * dt, &s2, &c2); br = m * c2; bi = m * s2; }
        asm volatile("s_waitcnt vmcnt(0)" ::: "memory");
        float sr = 0.f, si = 0.f;
        float lre[32], lim[32];
#pragma unroll
        for (int c = 0; c < 32; ++c) { lre[c] = LT[c * 128 + p]; lim[c] = LT[c * 128 + 64 + p]; }
#pragma unroll
        for (int c = 0; c < 32; ++c) { const float nr = ar * sr - ai * si + lre[c], ni = ar * si + ai * sr + lim[c]; sr = nr; si = ni; }
        carry[(seg * 64 + p) * 2] = sr; carry[(seg * 64 + p) * 2 + 1] = si;
        __syncthreads();
        float cr = 0.f, ci = 0.f;
        for (int s = 0; s < seg; ++s) { const float er = carry[(s * 64 + p) * 2], ei = carry[(s * 64 + p) * 2 + 1]; const float nr = br * cr - bi * ci + er, ni = br * ci + bi * cr + ei; cr = nr; ci = ni; }
        LAS bf16* OT = (LAS bf16*)LT;
        sr = cr; si = ci;
#pragma unroll
        for (int c = 0; c < 32; ++c) {
            OT[c * 128 + p] = (bf16)f2bf(sr); OT[c * 128 + 64 + p] = (bf16)f2bf(si);
            const float nr = ar * sr - ai * si + lre[c], ni = ar * si + ai * sr + lim[c]; sr = nr; si = ni;
        }
        bf16* up = U2 + (size_t)(b * NCH + seg * 32) * U2LD + g * U2G + 512;
#pragma unroll
        for (int i = 0; i < 8; ++i) { const int row = 4 * i + (p >> 4), piece = p & 15;
            *(v4u*)(up + (size_t)row * U2LD + piece * 8) = *(const LAS v4u*)((LAS unsigned char*)OT + row * 256 + piece * 16); }
        __syncthreads();
    }
}


#define XB_TMO      128
#define XB_XCNT(j)  (256  + 64 * (j))
#define XB_XSUB(j)  (1280 + 64 * (j))
#define XB_XGEN(j)  (2304 + 64 * (j))
#define XB_TOP      3328
#define XB_TOPGEN   3392
#define XCD_BAR_WORDS 3456
#define XB_SPIN_CAP (1u << 22)
__device__ __forceinline__ unsigned xb_ld(unsigned* p)              { return __hip_atomic_load(p, __ATOMIC_RELAXED, __HIP_MEMORY_SCOPE_AGENT); }
__device__ __forceinline__ unsigned xb_add(unsigned* p, unsigned v) { return __hip_atomic_fetch_add(p, v, __ATOMIC_RELAXED, __HIP_MEMORY_SCOPE_AGENT); }
__device__ __forceinline__ unsigned xb_xcc_id() { return (unsigned)__builtin_amdgcn_s_getreg((3 << 11) | 20) & 0xFu; }
#define XB_SPIN(cond, bar) do { unsigned _sp = 0; while (cond) { __builtin_amdgcn_s_sleep(1); \
    if ((++_sp & 255u) == 0u) { if (xb_ld(&(bar)[XB_TMO])) break; if (_sp > XB_SPIN_CAP) { atomicAdd(&(bar)[XB_TMO], 1u); break; } } } } while (0)
struct XcdBarrier { unsigned* bar; unsigned x; volatile LAS unsigned* st; };
__device__ __forceinline__ XcdBarrier xcd_barrier_post(unsigned* bar, volatile LAS unsigned* st) {
    XcdBarrier b; b.bar = bar; b.x = xb_xcc_id(); b.st = st;
    if (threadIdx.x == 0) (void)xb_add(&bar[XB_XCNT(b.x)], 1u);
    return b;
}
__device__ __forceinline__ void xcd_barrier_complete(unsigned* bar, unsigned x, unsigned& nloc, unsigned& nx) {
    const unsigned G = gridDim.x * gridDim.y * gridDim.z;
    unsigned sum, cnt, mine, sp = 0u;
    for (;;) {
        sum = 0u; cnt = 0u; mine = 0u;
#pragma unroll
        for (unsigned j = 0; j < 16; ++j) { const unsigned c = xb_ld(&bar[XB_XCNT(j)]); sum += c; cnt += (c > 0u) ? 1u : 0u; mine = (j == x) ? c : mine; }
        if (sum == G) break;
        __builtin_amdgcn_s_sleep(1);
        if ((++sp & 255u) == 0u) { if (xb_ld(&bar[XB_TMO])) break; if (sp > XB_SPIN_CAP) { atomicAdd(&bar[XB_TMO], 1u); break; } }
    }
    nloc = mine > 0u ? mine : 1u; nx = cnt > 0u ? cnt : 1u;
}
__device__ __forceinline__ void xcd_barrier(const XcdBarrier& b) {
    asm volatile("s_waitcnt vmcnt(0)" ::: "memory");
    __syncthreads();
    if (threadIdx.x == 0) {
        unsigned* bar = b.bar;
        __builtin_amdgcn_s_waitcnt(0);
        unsigned nloc = b.st[0], nx = b.st[1];
        if (nloc == 0u) { xcd_barrier_complete(bar, b.x, nloc, nx); b.st[0] = nloc; b.st[1] = nx; }
        const unsigned old = xb_add(&bar[XB_XSUB(b.x)], 1u);
        const unsigned gen = old / nloc;
        if (old + 1u == (gen + 1u) * nloc) {
            __builtin_amdgcn_fence(__ATOMIC_RELEASE, "agent");
            asm volatile("s_waitcnt vmcnt(0)" ::: "memory");
            const unsigned og = xb_add(&bar[XB_TOP], 1u);
            const unsigned tg = og / nx;
            if (og + 1u == (tg + 1u) * nx) xb_add(&bar[XB_TOPGEN], 1u);
            else XB_SPIN(xb_ld(&bar[XB_TOPGEN]) == tg, bar);
            xb_add(&bar[XB_XGEN(b.x)], 1u);
            __builtin_amdgcn_fence(__ATOMIC_ACQUIRE, "agent");
            asm volatile("s_waitcnt vmcnt(0)" ::: "memory");
        } else {
            XB_SPIN(xb_ld(&bar[XB_XGEN(b.x)]) == gen, bar);
            __builtin_amdgcn_fence(__ATOMIC_ACQUIRE, "agent");
            asm volatile("s_waitcnt vmcnt(0)" ::: "memory");
        }
    }
    __syncthreads();
}

__device__ __forceinline__ void p1_router_item(const Args& a, int it, int lane) {
    const float* rw = a.in[I_RW]; const float* g = a.in[I_N2G]; const float* mod = (const float*)(a.ws + WS_MOD);
    bf16* RWH = (bf16*)(a.ws + WS_RWT); bf16* RWL = RWH + NB * NE * D; float* rbias = (float*)(a.ws + WS_RWT + 524288);
    {
        const int b = it >> 5, e = it & 31; float bs = 0.f;
#pragma unroll 4
        for (int j = 0; j < 16; ++j) {
            const int k = lane + 64 * j; const float w = rw[k * NE + e], wp = w * g[k] * (1.0f + mod[b * 6 * D + 4 * D + k]);
            const unsigned hi = f2bf(wp), lo = f2bf(wp - bf2f(hi));
            RWH[(size_t)(b * NE + e) * D + k] = (bf16)hi; RWL[(size_t)(b * NE + e) * D + k] = (bf16)lo;
            bs += mod[b * 6 * D + 3 * D + k] * w;
        }
        bs = wave_sum(bs);
        if (lane == 0) rbias[b * NE + e] = bs + a.in[I_RB][e];
    }
}
__device__ __forceinline__ void top4_of8(float (&v)[8], const int (&e)[8], float (&tv)[4], int (&ti)[4]) {
#pragma unroll
    for (int r = 0; r < 4; ++r) {
        float bv = v[0]; int be = e[0];
#pragma unroll
        for (int i = 1; i < 8; ++i) { const bool t = v[i] > bv || (v[i] == bv && e[i] < be); bv = t ? v[i] : bv; be = t ? e[i] : be; }
        tv[r] = bv; ti[r] = be;
#pragma unroll
        for (int i = 0; i < 8; ++i) v[i] = (e[i] == be) ? -3.0e38f : v[i];
    }
}
__device__ __forceinline__ bf16x8 pack_hi8(const f32x4 x0, const f32x4 x1, bf16x8& lo) {
    const float f[8] = {x0[0], x0[1], x0[2], x0[3], x1[0], x1[1], x1[2], x1[3]};
    v4u h, l;
#pragma unroll
    for (int i = 0; i < 4; ++i) { const unsigned w = pk2(f[2 * i], f[2 * i + 1]); h[i] = w; l[i] = pk2(f[2 * i] - bflo(w), f[2 * i + 1] - bfhi(w)); }
    lo = __builtin_bit_cast(bf16x8, l);
    return __builtin_bit_cast(bf16x8, h);
}
__device__ __forceinline__ void p5_fast(const Args& a, LAS unsigned char* lds, int lane, int wave) {
    LAS unsigned* hist = (LAS unsigned*)(lds + 131072 + 1024);
    LAS unsigned* basearr = hist + 64;
    const bf16* RWH = (const bf16*)(a.ws + WS_RWT); const bf16* RWL = RWH + NB * NE * D; const float* rbias = (const float*)(a.ws + WS_RWT + 524288);
    const float* g = a.in[I_N2G]; const float* mod = (const float*)(a.ws + WS_MOD);
    bf16* H2 = (bf16*)(a.ws + WS_H2); float* topw = (float*)(a.ws + WS_TOPW); int* tokk = (int*)(a.ws + WS_TOKK); unsigned* cnt = (unsigned*)(a.ws + WS_CTL) + CW_CNT;
    const int col = lane & 15, q = lane >> 4;
    LAS float* gam = (LAS float*)(lds + 131072 + 8192); LAS float* bet = gam + D;
    int lds_batch = -1;
    if (threadIdx.x < 96) hist[threadIdx.x] = 0u;
    __syncthreads();
    int iter = 0;
    for (int task0 = blockIdx.x * NWAVES; task0 < NTOK / 16; task0 += gridDim.x * NWAVES, ++iter) {
        const int task = task0 + wave; const bool active = task < NTOK / 16;
        float tv[4] = {0.f, 0.f, 0.f, 0.f}; int ti[4] = {0, 1, 2, 3}; unsigned rank[4] = {0u, 0u, 0u, 0u};
        const int tok = task * 16 + col, b = (task * 16) >> 13;
        LAS unsigned* hcur = hist + (iter & 1) * 32;
        {
            const int bb = (task0 * 16) >> 13;
            if (bb != lds_batch) {
                __syncthreads();
                const v4u* srch = (const v4u*)(RWH + (size_t)bb * NE * D); const v4u* srcl = (const v4u*)(RWL + (size_t)bb * NE * D);
#pragma unroll
                for (int i = 0; i < 8; ++i) { const int ci = threadIdx.x + NTHR * i, e = ci >> 7, c = ci & 127, d = (e * 128 + (c ^ (e & 15))) * 16;
                    *(LAS v4u*)(lds + d) = srch[ci]; *(LAS v4u*)(lds + 65536 + d) = srcl[ci]; }
                for (int k = threadIdx.x; k < D; k += NTHR) { gam[k] = g[k] * (1.0f + mod[bb * 6 * D + 4 * D + k]); bet[k] = mod[bb * 6 * D + 3 * D + k]; }
                lds_batch = bb;
                __syncthreads();
            }
        }
        if (active) {
            float rstd;
            { const f32x4* sp = (const f32x4*)((const float*)(a.ws + WS_SSQ) + (size_t)tok * 16); const f32x4 s0 = sp[0], s1 = sp[1], s2 = sp[2], s3 = sp[3];
              const float ss = (((s0[0] + s0[1]) + (s0[2] + s0[3])) + ((s1[0] + s1[1]) + (s1[2] + s1[3]))) + (((s2[0] + s2[1]) + (s2[2] + s2[3])) + ((s3[0] + s3[1]) + (s3[2] + s3[3])));
              rstd = rsqrtf(ss * (1.f / D) + 1e-6f); }
            f32x4 acc0 = {0.f, 0.f, 0.f, 0.f}, acc1 = {0.f, 0.f, 0.f, 0.f};
            constexpr int RING = 16;
            const bf16* hrow = (const bf16*)(a.out + (size_t)tok * D) + D + 16 * q;
#if X1_LO
            const bf16* lrow = (const bf16*)(a.out + (size_t)tok * D) + 16 * q;
#endif
            v4u rh[RING], rl[RING];
#pragma unroll
            for (int i = 0; i < RING; ++i) { rh[i] = __builtin_nontemporal_load((const v4u*)(hrow + 64 * (i >> 1) + 8 * (i & 1)));
#if X1_LO
                rl[i] = __builtin_nontemporal_load((const v4u*)(lrow + 64 * (i >> 1) + 8 * (i & 1)));
#else
                rl[i] = (v4u){0u, 0u, 0u, 0u};
#endif
            }
            const int e0 = col, e1 = 16 + col;
            v2u hprev = {0u, 0u};
#pragma unroll 1
            for (int so = 0; so < 32; so += RING) {
#pragma unroll
                for (int si = 0; si < RING; ++si) {
                    const int st = so + si, kb = 64 * (st >> 1) + 8 * (st & 1), k = kb + 16 * q, c = 8 * (st >> 1) + 2 * q + (st & 1);
                    const v4u xh = rh[si], xl = rl[si];
                    { const int kn = (st + RING < 32) ? kb + 32 * RING : 0; rh[si] = __builtin_nontemporal_load((const v4u*)(hrow + kn));
#if X1_LO
                      rl[si] = __builtin_nontemporal_load((const v4u*)(lrow + kn));
#endif
                    }
                    asm volatile("" ::: "memory");
                    const bf16x8 a0h = *(const LAS bf16x8*)(lds + (e0 * 128 + (c ^ (e0 & 15))) * 16), a0l = *(const LAS bf16x8*)(lds + 65536 + (e0 * 128 + (c ^ (e0 & 15))) * 16);
                    const bf16x8 a1h = *(const LAS bf16x8*)(lds + (e1 * 128 + (c ^ (e1 & 15))) * 16), a1l = *(const LAS bf16x8*)(lds + 65536 + (e1 * 128 + (c ^ (e1 & 15))) * 16);
                    const f32x4 g0 = *(const LAS f32x4*)(gam + k), g1 = *(const LAS f32x4*)(gam + k + 4), s0 = *(const LAS f32x4*)(bet + k), s1 = *(const LAS f32x4*)(bet + k + 4);
                    const bf16x8 bh = __builtin_bit_cast(bf16x8, xh), bl = __builtin_bit_cast(bf16x8, xl);
                    acc0 = __builtin_amdgcn_mfma_f32_16x16x32_bf16(a0h, bh, acc0, 0, 0, 0); if (X1_LO) acc0 = __builtin_amdgcn_mfma_f32_16x16x32_bf16(a0h, bl, acc0, 0, 0, 0); acc0 = __builtin_amdgcn_mfma_f32_16x16x32_bf16(a0l, bh, acc0, 0, 0, 0);
                    acc1 = __builtin_amdgcn_mfma_f32_16x16x32_bf16(a1h, bh, acc1, 0, 0, 0); if (X1_LO) acc1 = __builtin_amdgcn_mfma_f32_16x16x32_bf16(a1h, bl, acc1, 0, 0, 0); acc1 = __builtin_amdgcn_mfma_f32_16x16x32_bf16(a1l, bh, acc1, 0, 0, 0);
#if X1_LO
                    const f32x4 x0 = {bflo(xh.x) + bflo(xl.x), bfhi(xh.x) + bfhi(xl.x), bflo(xh.y) + bflo(xl.y), bfhi(xh.y) + bfhi(xl.y)};
                    const f32x4 x1 = {bflo(xh.z) + bflo(xl.z), bfhi(xh.z) + bfhi(xl.z), bflo(xh.w) + bflo(xl.w), bfhi(xh.w) + bfhi(xl.w)};
#else
                    const f32x4 x0 = {bflo(xh.x), bfhi(xh.x), bflo(xh.y), bfhi(xh.y)}, x1 = {bflo(xh.z), bfhi(xh.z), bflo(xh.w), bfhi(xh.w)};
#endif
                    const f32x4 h0 = x0 * rstd * g0 + s0, h1 = x1 * rstd * g1 + s1;
#if MOE1_F8
                    v2u hw; hw.x = pk_fp8x4(h0[0], h0[1], h0[2], h0[3]); hw.y = pk_fp8x4(h1[0], h1[1], h1[2], h1[3]);
                    if (st & 1) *(v4u*)((unsigned char*)H2 + (size_t)tok * D + 64 * (st >> 1) + 16 * q) = (v4u){hprev.x, hprev.y, hw.x, hw.y};
                    else hprev = hw;
#else
                    v4u hw; hw.x = pk2(h0[0], h0[1]); hw.y = pk2(h0[2], h0[3]); hw.z = pk2(h1[0], h1[1]); hw.w = pk2(h1[2], h1[3]);
                    *(v4u*)(H2 + (size_t)tok * D + k) = hw;
#endif
                    asm volatile("" ::: "memory");
                }
            }
            STAMP(19);
            float v[8]; int e[8];
#pragma unroll
            for (int j = 0; j < 4; ++j) { e[j] = 4 * q + j; e[4 + j] = 16 + 4 * q + j; v[j] = rstd * acc0[j] + rbias[b * NE + 4 * q + j]; v[4 + j] = rstd * acc1[j] + rbias[b * NE + 16 + 4 * q + j]; }
            top4_of8(v, e, tv, ti);
#pragma unroll
            for (int off = 16; off <= 32; off <<= 1) {
                float v2[8]; int e2[8];
#pragma unroll
                for (int r = 0; r < 4; ++r) { v2[r] = tv[r]; e2[r] = ti[r]; v2[4 + r] = __shfl_xor(tv[r], off); e2[4 + r] = __shfl_xor(ti[r], off); }
                top4_of8(v2, e2, tv, ti);
            }
            if (q == 0) {
#pragma unroll
                for (int r = 0; r < 4; ++r) rank[r] = __hip_atomic_fetch_add(hcur + ti[r], 1u, __ATOMIC_RELAXED, __HIP_MEMORY_SCOPE_WORKGROUP);
            }
        }
        STAMP(20);
        __syncthreads();
        STAMP(21);
        if (threadIdx.x < 32) { const unsigned n = hcur[threadIdx.x]; basearr[threadIdx.x] = n ? atomicAdd(cnt + 32 * threadIdx.x, n) : 0u; hist[((iter + 1) & 1) * 32 + threadIdx.x] = 0u; }
        __syncthreads();
        if (active && q == 0) {
            const float e1 = __expf(tv[1] - tv[0]), e2 = __expf(tv[2] - tv[0]), e3 = __expf(tv[3] - tv[0]), inv = 1.f / (1.f + e1 + e2 + e3);
            const float w[4] = {inv, e1 * inv, e2 * inv, e3 * inv};
#pragma unroll
            for (int r = 0; r < 4; ++r) { const unsigned slot = basearr[ti[r]] + rank[r]; tokk[(size_t)ti[r] * CAP + slot] = tok * 4 + r; }
            *(f32x4*)(topw + tok * 4) = (f32x4){w[0], w[1], w[2], w[3]};
        }
    }
}

constexpr int NPHASE = 13;
__global__ void __launch_bounds__(NTHR, 2) fwd_kernel(Args a) {
    extern __shared__ __attribute__((aligned(16))) unsigned char lds_raw[];
    LAS unsigned char* lds = (LAS unsigned char*)lds_raw;
    LAS float* sm = (LAS float*)lds;
    LAS int* T = (LAS int*)(lds + 131072);
#if USE_CG_SYNC
    cg::grid_group grid = cg::this_grid();
#else
    volatile LAS unsigned* MISC = (volatile LAS unsigned*)(lds + 131072 + 2048);
    if (threadIdx.x < 32) MISC[threadIdx.x] = 0u;
    __syncthreads();
    XcdBarrier xbar = xcd_barrier_post((unsigned*)(a.ws + WS_CTL) + CW_BAR, MISC + 8);
#endif
    const int tid = threadIdx.x, lane = tid & 63, wave = __builtin_amdgcn_readfirstlane(tid >> 6);
    const int gw = blockIdx.x * NWAVES + wave, ngw = gridDim.x * NWAVES;
    const int lo = a.ph_lo, hi = a.ph_hi;
#define IN(k) (lo <= (k) && (k) < hi)
#if TIME_PHASE >= 0
    LAS unsigned long long* TS = (LAS unsigned long long*)(lds + 131072 + 4096);
#endif
#if USE_CG_SYNC
#define SEAM(k) do { if (IN(k) && IN((k) + 1)) grid.sync(); } while (0)
#else
#define SEAM(k) do { if (IN(k) && IN((k) + 1)) xcd_barrier(xbar); } while (0)
#endif
#define REP(k) _Pragma("nounroll") for (int _r = 0; _r < (((REP_MASK >> (k)) & 1) ? a.rep_mask : 1); ++_r)
    STAMP(0); if (IN(0)) { REP(0) { p0_mod(a, sm); STAMP(16); p0_s5_mats(a, sm); __syncthreads(); STAMP(17); p0_convert(a, gw, ngw, lane); __syncthreads(); STAMP(18); } }
    STAMP(1); if (IN(0)) { mod_wait(a); p1_dynamic(a, lane); } SEAM(1);
    STAMP(2); if (IN(2)) { REP(2) { p2_fast(a, lds); } } SEAM(2);
    STAMP(3); if (IN(3)) { p3a_fast(a, lds); if (gridDim.x >= NB * NG) { asm volatile("s_waitcnt vmcnt(0)" ::: "memory"); __syncthreads(); {
#define P3_CHAIN   (blockIdx.x < NB * NG)
#define P3_PARTNER (CONV_LDS && blockIdx.x + NB * NG < gridDim.x)
#define P3_OWES    (CONV_LDS && blockIdx.x >= NB * NG && blockIdx.x < 2 * NB * NG)
#define P3_CIDX    ((int)blockIdx.x - (P3_CHAIN ? 0 : NB * NG))
          int st = P3_CHAIN ? 0 : (P3_OWES ? 1 : 2);
          if (P3_CHAIN) { p3b_scan(a, sm, true); asm volatile("s_waitcnt vmcnt(0)" ::: "memory"); __syncthreads();
            if (P3_PARTNER && threadIdx.x == 0) { __builtin_amdgcn_fence(__ATOMIC_RELEASE, "agent"); asm volatile("s_waitcnt vmcnt(0)" ::: "memory");
                __hip_atomic_store((unsigned*)(a.ws + WS_CTL) + CW_YF + 32 * blockIdx.x, 1u, __ATOMIC_RELAXED, __HIP_MEMORY_SCOPE_AGENT); } }
          __syncthreads();
          if (!CONV_LDS) { if (P3_CHAIN) p3c_pair(a, lds, P3_CIDX / (NROW2 / 256), P3_CIDX % (NROW2 / 256), 0, 2); __syncthreads(); p3e_conv(a, sm, lane); }
          else for (;;) {
            if (st == 1 || st == 2) {
                const int r = p3e_conv2(a, lds, sm, lane, st == 1 ? P3_CIDX : -1);
                if (st == 2) break;
                if (threadIdx.x == 0) { unsigned* yf = (unsigned*)(a.ws + WS_CTL) + CW_YF + 32 * P3_CIDX; unsigned sp = 0;
                    while (!__hip_atomic_load(yf, __ATOMIC_RELAXED, __HIP_MEMORY_SCOPE_AGENT)) { __builtin_amdgcn_s_sleep(8); if (++sp > (1u << 24)) break; }
                    __builtin_amdgcn_fence(__ATOMIC_ACQUIRE, "agent"); asm volatile("s_waitcnt vmcnt(0)" ::: "memory"); }
                __syncthreads();
                st = r ? 0 : 3;
            }
            p3c_pair(a, lds, P3_CIDX / (NROW2 / 256), P3_CIDX % (NROW2 / 256), P3_CHAIN ? 0 : 1, (P3_CHAIN && !P3_PARTNER) ? 2 : 1); __syncthreads();
            if (st == 3) break;
            st = 2;
          } } } else p3e_conv(a, sm, lane); }
    if (gridDim.x < NB * NG) { SEAM(3); if (IN(4)) { p3b_scan(a, sm, false); __syncthreads(); p3e_conv(a, sm, lane); } }
    STAMP(4); if (gridDim.x < NB * NG) SEAM(4);
    STAMP(5); if (IN(5) && gridDim.x < NB * NG) { p3c_fast(a, lds); } SEAM(5);
    STAMP(6); if (IN(6)) { REP(6) { p3d_fast(a, lds); } } SEAM(6);
    STAMP(7); if (!FUSE_NORM) { if (IN(7)) { p3e_norm(a, gw, ngw, lane); } SEAM(7); }
    STAMP(8); if (IN(8)) { REP(8) { p4_fast(a, lds); } } SEAM(8);
    STAMP(9); if (IN(9)) { p5_fast(a, lds, lane, wave); } SEAM(9);
    STAMP(10); if (IN(10)) { moe_tables(a, T); REP(10) { p7_fast(a, lds, T); } } SEAM(10);
    STAMP(11); if (IN(11)) { if (!IN(10)) moe_tables(a, T); REP(11) { p8_fast(a, lds, T); } } SEAM(11);
    STAMP(12); if (IN(12)) { p9_final(a, gw, ngw, lane); }
#undef REP
    STAMP(13);
#if TIME_PHASE >= 0
    if (blockIdx.x == 0 && threadIdx.x == 0) { const unsigned long long dt = TS[TIME_B] - TS[TIME_A], t1 = TS[13]; while (__builtin_amdgcn_s_memrealtime() - t1 < 8ull * dt) __builtin_amdgcn_s_sleep(8); }
#endif
#undef IN
#undef SEAM
}

#ifndef N_LAUNCHES
#define N_LAUNCHES 1
#endif
extern "C" void kernel_launch(void* const* d_in, const int* in_sizes, int n_in, void* d_out, int out_size, void* d_ws, size_t ws_size, hipStream_t stream) {
    static int grid = 0;
    if (grid == 0) {
        if (n_in != 32 || out_size != NTOK * D || ws_size < WS_END) { fprintf(stderr, "kernel_launch: unexpected problem (n_in %d out %d ws %zu)\n", n_in, out_size, ws_size); grid = -1; return; }
        int dev = 0, cus = 0, per_cu = 0;
        if (hipGetDevice(&dev) != hipSuccess || hipDeviceGetAttribute(&cus, hipDeviceAttributeMultiprocessorCount, dev) != hipSuccess) { grid = -1; return; }
        if (hipFuncSetAttribute((const void*)fwd_kernel, hipFuncAttributeMaxDynamicSharedMemorySize, LDS_BYTES) != hipSuccess) { fprintf(stderr, "kernel_launch: hipFuncSetAttribute failed\n"); grid = -1; return; }
        if (hipOccupancyMaxActiveBlocksPerMultiprocessor(&per_cu, (const void*)fwd_kernel, NTHR, LDS_BYTES) != hipSuccess || per_cu < 1) { fprintf(stderr, "kernel_launch: occupancy query says %d\n", per_cu); (void)hipGetLastError(); per_cu = 1; }
        grid = cus;
    }
    if (grid < 0) return;
    (void)hipMemsetAsync((char*)d_ws + WS_CTL, 0, 65536, stream);
    Args a{};
    for (int i = 0; i < 32; ++i) a.in[i] = (const float*)d_in[i];
    a.out = (float*)d_out; a.ws = (unsigned char*)d_ws; a.rep_mask = 2;
    for (int li = 0; li < N_LAUNCHES; ++li) {
        a.ph_lo = (N_LAUNCHES == 1) ? 0 : li; a.ph_hi = (N_LAUNCHES == 1) ? NPHASE : li + 1;
        void* args[] = {&a};
        hipError_t e = hipLaunchCooperativeKernel((const void*)fwd_kernel, dim3(grid), dim3(NTHR), args, LDS_BYTES, stream);
        if (e != hipSuccess) { fprintf(stderr, "kernel_launch: launch %d failed: %s\n", li, hipGetErrorString(e)); break; }
    }
}
```
